# Optimizing an MI355X kernel written in HIP

```python
import math
import jax
import jax.numpy as jnp
from jax import lax
import numpy as np

D_MODEL = 2048
BATCH = 2
SEQ = 8192
DEPTH = 2

ATT_HEADS = 8
ATT_KV_HEADS = 2
ATT_HEAD_DIM = 128
IDX_HEADS = 8
IDX_DIM = 64
TOPK_MAX = 256
Q_BLOCK = 128
REL_BUCKETS = 32
REL_MAX_DIST = 128
RWKV_HEAD = 64
RWKV_HEADS = 16
DECAY_RANK = 64
ICLR_RANK = 64
GATE_RANK = 160
D_FF = 5632
N_EXPERTS = 8
TOP_K_EXPERTS = 2
D_FF_EXPERT = 7168
PLE_DIM = 256
RMS_EPS = 1e-6
GN_EPS = 64e-5

ATT_WIDTH = ATT_HEADS * ATT_HEAD_DIM
KV_WIDTH = ATT_KV_HEADS * ATT_HEAD_DIM
RWKV_WIDTH = RWKV_HEADS * RWKV_HEAD
RWKV_SIZES = (RWKV_WIDTH, RWKV_WIDTH, RWKV_WIDTH, DECAY_RANK, ICLR_RANK, GATE_RANK)
RWKV_SLAB = 3 * RWKV_WIDTH + DECAY_RANK + ICLR_RANK + GATE_RANK
IN_SIZES = (ATT_WIDTH, KV_WIDTH, KV_WIDTH, IDX_HEADS * IDX_DIM, IDX_DIM, IDX_HEADS, RWKV_SLAB, D_MODEL, D_MODEL)
IN_WIDTH = ATT_WIDTH + 2 * KV_WIDTH + IDX_HEADS * IDX_DIM + IDX_DIM + IDX_HEADS + RWKV_SLAB + 2 * D_MODEL
N_DENSE = (DEPTH + 1) // 2
N_MOE = DEPTH // 2

kernel_name = 'hybrid_dsa_rwkv7_gated_moe'


def _split(z, sizes):
    return jnp.split(z, np.cumsum(sizes)[:-1].tolist(), axis=-1)


def rms_norm(x, g):
    xf = x.astype(jnp.float32)
    y = xf * lax.rsqrt(jnp.mean(xf * xf, axis=-1, keepdims=True) + RMS_EPS)
    return (y * g.astype(jnp.float32)).astype(x.dtype)


def rel_bucket(dist):
    max_exact = REL_BUCKETS // 2
    dist = jnp.maximum(dist, 0)
    d_f = jnp.maximum(dist, 1).astype(jnp.float32)
    large = max_exact + (jnp.log(d_f / max_exact) / math.log(REL_MAX_DIST / max_exact)
                         * (REL_BUCKETS - max_exact)).astype(jnp.int32)
    large = jnp.minimum(large, REL_BUCKETS - 1)
    return jnp.where(dist < max_exact, dist, large)


def dsa_attention(q, k, v, qi, ki, wi, rel_bias):
    B, S = q.shape[0], q.shape[1]
    n_sel = min(TOPK_MAX, S // 4)
    nb = S // Q_BLOCK
    G = ATT_HEADS // ATT_KV_HEADS
    idx_scale = (IDX_HEADS ** -0.5) * (IDX_DIM ** -0.5)
    key_pos = jnp.arange(S, dtype=jnp.int32)

    def to_blocks(z):
        return z.reshape((B, nb, Q_BLOCK) + z.shape[2:]).swapaxes(0, 1)

    def block(args):
        qb, qib, wib, start = args
        t_pos = start + jnp.arange(Q_BLOCK, dtype=jnp.int32)
        dots = jnp.einsum('bthd,bsd->bths', qib, ki, preferred_element_type=jnp.float32)
        score = jnp.einsum('bth,bths->bts', wib.astype(jnp.float32), jax.nn.relu(dots)) * idx_scale
        causal = key_pos[None, :] <= t_pos[:, None]
        score = jnp.where(causal[None], score, -jnp.inf)
        _, idx = lax.top_k(score, n_sel)
        valid = idx <= t_pos[None, :, None]
        k_sel = jax.vmap(lambda kb, ib: kb[ib])(k, idx)
        v_sel = jax.vmap(lambda vb, ib: vb[ib])(v, idx)
        qg = qb.reshape(B, Q_BLOCK, ATT_KV_HEADS, G, ATT_HEAD_DIM)
        logits = jnp.einsum('btcgd,btjcd->btcgj', qg, k_sel,
                            preferred_element_type=jnp.float32) * (ATT_HEAD_DIM ** -0.5)
        bias = rel_bias[rel_bucket(t_pos[None, :, None] - idx)]
        bias = bias.reshape(B, Q_BLOCK, n_sel, ATT_KV_HEADS, G).transpose(0, 1, 3, 4, 2)
        logits = jnp.where(valid[:, :, None, None, :], logits + bias.astype(jnp.float32), -jnp.inf)
        probs = jax.nn.softmax(logits, axis=-1).astype(v.dtype)
        out = jnp.einsum('btcgj,btjcd->btcgd', probs, v_sel)
        return out.reshape(B, Q_BLOCK, ATT_WIDTH)

    starts = jnp.arange(nb, dtype=jnp.int32) * Q_BLOCK
    out = lax.map(block, (to_blocks(q), to_blocks(qi), to_blocks(wi), starts))
    return out.swapaxes(0, 1).reshape(B, S, ATT_WIDTH)


def token_shift(z):
    return jnp.pad(z, ((0, 0), (1, 0), (0, 0)))[:, :-1]


def rwkv7_mix(slab, mu, w0, w_up, a0, a_up, g_up, k_k, k_a, r_k, gn_w, gn_b):
    B, S = slab.shape[0], slab.shape[1]
    xs = slab + (token_shift(slab) - slab) * mu
    r, k, v, xw, xa, xg = _split(xs, RWKV_SIZES)
    d = (w0 + jnp.tanh(xw) @ w_up).astype(jnp.float32)
    decay = jnp.exp(-math.exp(-0.5) * jax.nn.sigmoid(d))
    a = jax.nn.sigmoid((a0 + xa @ a_up).astype(jnp.float32))
    g = jax.nn.sigmoid(xg) @ g_up

    def heads(z):
        return z.astype(jnp.float32).reshape(B, S, RWKV_HEADS, RWKV_HEAD)

    kk = heads(k * k_k)
    kk = kk * lax.rsqrt(jnp.maximum(jnp.sum(kk * kk, axis=-1, keepdims=True), 1e-24))
    kt = heads(k.astype(jnp.float32) * (1.0 + (a - 1.0) * k_a.astype(jnp.float32)))
    r_h = heads(r)
    v_h = heads(v)
    w_h = heads(decay)
    b_h = kk * heads(a)

    def step(state, inp):
        r_t, w_t, k_t, v_t, kk_t, b_t = inp
        sk = jnp.einsum('bhvk,bhk->bhv', state, kk_t)
        state = (state * w_t[:, :, None, :] - sk[..., None] * b_t[:, :, None, :]
                 + v_t[..., None] * k_t[:, :, None, :])
        y = jnp.einsum('bhvk,bhk->bhv', state, r_t)
        return state, y

    s0 = jnp.zeros((B, RWKV_HEADS, RWKV_HEAD, RWKV_HEAD), jnp.float32)
    xs_seq = (r_h.swapaxes(0, 1), w_h.swapaxes(0, 1), kt.swapaxes(0, 1),
              v_h.swapaxes(0, 1), kk.swapaxes(0, 1), b_h.swapaxes(0, 1))
    _, y = lax.scan(step, s0, xs_seq)
    y = y.swapaxes(0, 1)
    mean = jnp.mean(y, axis=-1, keepdims=True)
    var = jnp.mean(jnp.square(y - mean), axis=-1, keepdims=True)
    y = ((y - mean) * lax.rsqrt(var + GN_EPS)).reshape(B, S, RWKV_WIDTH)
    y = y * gn_w.astype(jnp.float32) + gn_b.astype(jnp.float32)
    bonus = jnp.sum(r_h * kt * r_k.astype(jnp.float32).reshape(RWKV_HEADS, RWKV_HEAD),
                    axis=-1, keepdims=True) * v_h
    y = (y + bonus.reshape(B, S, RWKV_WIDTH)) * g.astype(jnp.float32)
    return y.astype(slab.dtype)


def swiglu(x, w1, w3, w2):
    return (jax.nn.silu(x @ w1) * (x @ w3)) @ w2


def moe_swiglu(x, router, w1, w3, w2):
    B, S, D = x.shape
    xf = x.reshape(B * S, D)
    logits = (xf @ router).astype(jnp.float32)
    top_vals, top_idx = lax.top_k(logits, TOP_K_EXPERTS)
    gates = jax.nn.softmax(top_vals, axis=-1)
    combine = jnp.sum(jax.nn.one_hot(top_idx, N_EXPERTS, dtype=jnp.float32) * gates[..., None], axis=1)
    out = jnp.zeros((B * S, D), jnp.float32)
    for e in range(N_EXPERTS):
        out = out + combine[:, e:e + 1] * swiglu(xf, w1[e], w3[e], w2[e]).astype(jnp.float32)
    return out.astype(x.dtype).reshape(B, S, D)


def setup_inputs(seed: int = 0):
    key = jax.random.key(seed)
    ks = iter(jax.random.split(key, 40))

    def nrm(shape, scale):
        return jax.random.normal(next(ks), shape, jnp.float32) * scale

    def gain(shape):
        return 1.0 + nrm(shape, 0.02)

    L = DEPTH
    return {
        'x': nrm((BATCH, SEQ, D_MODEL), 1.0),
        'p': nrm((DEPTH, BATCH, SEQ, PLE_DIM), 1.0),
        'w_in': nrm((L, D_MODEL, IN_WIDTH), D_MODEL ** -0.5),
        'att_up': nrm((L, ATT_WIDTH, D_MODEL), ATT_WIDTH ** -0.5),
        'rwkv_up': nrm((L, RWKV_WIDTH, D_MODEL), RWKV_WIDTH ** -0.5),
        'w_out': nrm((L, D_MODEL, D_MODEL), D_MODEL ** -0.5),
        'rel_bias': nrm((REL_BUCKETS, ATT_HEADS), 0.5),
        'rwkv_mu': jax.random.uniform(next(ks), (L, RWKV_SLAB), jnp.float32),
        'rwkv_w0': nrm((L, RWKV_WIDTH), 1.0),
        'rwkv_w_up': nrm((L, DECAY_RANK, RWKV_WIDTH), DECAY_RANK ** -0.5),
        'rwkv_a0': nrm((L, RWKV_WIDTH), 0.5),
        'rwkv_a_up': nrm((L, ICLR_RANK, RWKV_WIDTH), ICLR_RANK ** -0.5),
        'rwkv_g_up': nrm((L, GATE_RANK, RWKV_WIDTH), GATE_RANK ** -0.5),
        'rwkv_k_k': 0.85 + nrm((L, RWKV_WIDTH), 0.05),
        'rwkv_k_a': 1.0 + nrm((L, RWKV_WIDTH), 0.05),
        'rwkv_r_k': nrm((L, RWKV_WIDTH), 0.1),
        'rwkv_gn_w': gain((L, RWKV_WIDTH)),
        'rwkv_gn_b': nrm((L, RWKV_WIDTH), 0.02),
        'norm_mix': gain((L, D_MODEL)),
        'norm_ffn': gain((L, D_MODEL)),
        'norm_ple': gain((L, D_MODEL)),
        'ple_proj': nrm((L, PLE_DIM, D_MODEL), PLE_DIM ** -0.5),
        'ple_gate': nrm((L, D_MODEL, D_MODEL), D_MODEL ** -0.5),
        'ffn_w1': nrm((N_DENSE, D_MODEL, D_FF), D_MODEL ** -0.5),
        'ffn_w3': nrm((N_DENSE, D_MODEL, D_FF), D_MODEL ** -0.5),
        'ffn_w2': nrm((N_DENSE, D_FF, D_MODEL), D_FF ** -0.5),
        'moe_router': nrm((N_MOE, D_MODEL, N_EXPERTS), D_MODEL ** -0.5),
        'moe_w1': nrm((N_MOE, N_EXPERTS, D_MODEL, D_FF_EXPERT), D_MODEL ** -0.5),
        'moe_w3': nrm((N_MOE, N_EXPERTS, D_MODEL, D_FF_EXPERT), D_MODEL ** -0.5),
        'moe_w2': nrm((N_MOE, N_EXPERTS, D_FF_EXPERT, D_MODEL), D_FF_EXPERT ** -0.5),
        'final_norm': gain((D_MODEL,)),
    }


def reference(x, p, w_in, att_up, rwkv_up, w_out, rel_bias, rwkv_mu, rwkv_w0, rwkv_w_up,
              rwkv_a0, rwkv_a_up, rwkv_g_up, rwkv_k_k, rwkv_k_a, rwkv_r_k, rwkv_gn_w, rwkv_gn_b,
              norm_mix, norm_ffn, norm_ple, ple_proj, ple_gate, ffn_w1, ffn_w3, ffn_w2,
              moe_router, moe_w1, moe_w3, moe_w2, final_norm):
    B, S = x.shape[0], x.shape[1]
    h = x
    for i in range(DEPTH):
        a = rms_norm(h, norm_mix[i])
        q, k, v, qi, ki, wi, slab, gate_a, gate_b = _split(a @ w_in[i], IN_SIZES)
        att = dsa_attention(q.reshape(B, S, ATT_HEADS, ATT_HEAD_DIM),
                            k.reshape(B, S, ATT_KV_HEADS, ATT_HEAD_DIM),
                            v.reshape(B, S, ATT_KV_HEADS, ATT_HEAD_DIM),
                            qi.reshape(B, S, IDX_HEADS, IDX_DIM), ki, wi, rel_bias)
        rw = rwkv7_mix(slab, rwkv_mu[i], rwkv_w0[i], rwkv_w_up[i], rwkv_a0[i], rwkv_a_up[i],
                       rwkv_g_up[i], rwkv_k_k[i], rwkv_k_a[i], rwkv_r_k[i], rwkv_gn_w[i], rwkv_gn_b[i])
        merged = jax.nn.sigmoid(gate_a) * (att @ att_up[i]) + jax.nn.sigmoid(gate_b) * (rw @ rwkv_up[i])
        h = h + merged @ w_out[i]
        f_in = rms_norm(h, norm_ffn[i])
        if i % 2 == 0:
            f = swiglu(f_in, ffn_w1[i // 2], ffn_w3[i // 2], ffn_w2[i // 2])
        else:
            f = moe_swiglu(f_in, moe_router[i // 2], moe_w1[i // 2], moe_w3[i // 2], moe_w2[i // 2])
        h = h + f
        ple_g = jax.nn.sigmoid(rms_norm(h, norm_ple[i]) @ ple_gate[i])
        h = h + ple_g * (p[i] @ ple_proj[i])
    return rms_norm(h, final_norm)
```

```cpp
#include <hip/hip_runtime.h>
#include <cstdio>
#include <cstdint>

#ifndef MK_ONE_LAUNCH
#define MK_ONE_LAUNCH 1
#endif

namespace pg8 {
#define PG8_LAS __attribute__((address_space(3)))
typedef unsigned short bf16_t;
typedef short bf16x8 __attribute__((ext_vector_type(8)));
typedef float f32x4 __attribute__((ext_vector_type(4)));
typedef unsigned u32x4 __attribute__((ext_vector_type(4)));
typedef unsigned u32x2 __attribute__((ext_vector_type(2)));
constexpr int BM = 256, BK = 64, HALF = 128, HTB = HALF * BK * 2, STAGE_BYTES = 8 * HTB, NXCD = 8, WGM = 8;

__host__ __device__ __forceinline__ int lds_byte(int r, int c) { const int st = (r >> 4) * 2 + (c >> 5), rr = r & 15, cc = c & 31, ob = rr * 64 + cc * 2; return st * 1024 + (ob ^ (((ob >> 9) & 1) << 5)); }
__host__ __device__ __forceinline__ void stage_rc(int b, int& R, int& C) { const int st = b / 1024, sb = b % 1024, swz = sb ^ (((sb >> 9) & 1) << 5); R = (st >> 1) * 16 + swz / 64; C = (st & 1) * 32 + (swz % 64) / 2; }
__host__ __device__ __forceinline__ int perm32(int rho) { const int n = rho >> 4, i = rho & 15; return 8 * (i >> 2) + 4 * n + (i & 3); }

struct Unit { int pm, pn, po; };
struct Gemm { const bf16_t* A; const bf16_t* Bt; int M, N, K; int lda = 0, ldb = 0; };

struct StaticOrder {
    int nM, nN, nwg, G, c;
    __device__ void init(int M, int N, int G_, int c_) { nM = M / BM; nN = N / BM; nwg = nM * nN; G = G_; c = c_; }
    __device__ bool next(int i, Unit& u) const {
        const long L = (long)i * G + c; if (L >= nwg) return false;
        int wgid = (int)L; { const int q = nwg / NXCD, r = nwg % NXCD, xcd = wgid % NXCD, off = wgid / NXCD; wgid = (xcd < r ? xcd * (q + 1) : r * (q + 1) + (xcd - r) * q) + off; }
        const int nig = WGM * nN, gid = wgid / nig, fm = gid * WGM, gsz = (nM - fm) < WGM ? (nM - fm) : WGM;
        u.pm = fm + ((wgid % nig) % gsz); u.pn = (wgid % nig) / gsz; u.po = u.pn; return true;
    }
    __device__ __forceinline__ void a_ready(const Unit&) const {}
    __device__ __forceinline__ void done(const Unit&) const {}
};
struct MoeOrder {
    const PG8_LAS int* tab; int NT, G, c;
    __device__ bool next(int i, Unit& u) const {
        const int L = i * G + c; if (L >= tab[17]) return false;
        int e = 0;
#pragma unroll
        for (int j = 1; j < 8; ++j) e += (L >= tab[9 + j]) ? 1 : 0;
        const int l = L - tab[9 + e], tiles = tab[e + 1] - tab[e];
        const int mt = l % tiles, pl = l / tiles;
        u.pm = tab[e] + mt; u.pn = e * NT + pl; u.po = pl; return true;
    }
    __device__ __forceinline__ void a_ready(const Unit&) const {}
    __device__ __forceinline__ void done(const Unit&) const {}
};

typedef float f32x2cv __attribute__((ext_vector_type(2))); typedef __bf16 bf16x2cv __attribute__((ext_vector_type(2)));
__device__ __forceinline__ unsigned cvt_pk_bf16(float lo, float hi) { const f32x2cv v = {lo, hi}; const bf16x2cv b = __builtin_convertvector(v, bf16x2cv); return __builtin_bit_cast(unsigned, b); }
typedef int i32x8 __attribute__((ext_vector_type(8)));
__device__ __forceinline__ i32x8 cat8(bf16x8 a, bf16x8 b) { const u32x4 x = __builtin_bit_cast(u32x4, a), y = __builtin_bit_cast(u32x4, b); return (i32x8){(int)x.x, (int)x.y, (int)x.z, (int)x.w, (int)y.x, (int)y.y, (int)y.z, (int)y.w}; }
__device__ __forceinline__ unsigned pk_fp8x4(float a, float b, float c, float d) { int r = __builtin_amdgcn_cvt_pk_fp8_f32(a, b, 0, false); r = __builtin_amdgcn_cvt_pk_fp8_f32(c, d, r, true); return (unsigned)r; }
__device__ __forceinline__ float bflo(unsigned w) { return __uint_as_float(w << 16); }
__device__ __forceinline__ float bfhi(unsigned w) { return __uint_as_float(w & 0xffff0000u); }
__device__ __forceinline__ float sigm(float x) { return __builtin_amdgcn_rcpf(1.0f + __expf(-x)); }

struct EpiStoreBf16 {
    static constexpr bool PERM = true, AFTER_DRAIN = false;
    bf16_t* O; int ldc; float scale = 1.0f;
    __device__ __forceinline__ void operator()(const f32x4 (&acc)[2][2][4][2], const Unit& u, int wr, int wc, int fr, int fq) const {
        const int row0 = u.pm * BM + wr * 64 + fr, col0 = u.po * BM + wc * 32 + 8 * fq;
#pragma unroll
        for (int ai = 0; ai < 2; ++ai)
#pragma unroll
            for (int m = 0; m < 4; ++m) { bf16_t* rowp = O + (size_t)(row0 + ai * HALF + m * 16) * ldc + col0;
#pragma unroll
                for (int bj = 0; bj < 2; ++bj) { const f32x4 v0 = acc[ai][bj][m][0] * scale, v1 = acc[ai][bj][m][1] * scale;
                    u32x4 w; w.x = cvt_pk_bf16(v0[0], v0[1]); w.y = cvt_pk_bf16(v0[2], v0[3]); w.z = cvt_pk_bf16(v1[0], v1[1]); w.w = cvt_pk_bf16(v1[2], v1[3]);
                    *(u32x4*)(rowp + bj * HALF) = w; } }
    }
};
struct EpiProj {
    static constexpr bool PERM = true, AFTER_DRAIN = false;
    bf16_t* base; int T_, SEQ_; float scale = 1.0f; float kvscale = 8.0f;
    __device__ __forceinline__ void seg(int col, int b, size_t& off, int& pitch, bool& f8) const {
        const size_t T = (size_t)T_; f8 = false;
        if (col < 1024) { off = (size_t)col * 2; pitch = 2048; }
        else if (col < 1536) { const int v = col >= 1280, cc = (col - (v ? 1280 : 1024)) >> 7, d = (col - (v ? 1280 : 1024)) & 127; off = T * (v ? 1280 : 1024) * 2 + (size_t)(b + cc) * SEQ_ * 128 + d; pitch = 128; f8 = true; }
        else if (col < 2048) { off = (T * 1536 + (col - 1536)) * 2; pitch = 1024; }
        else if (col < 2112) { off = (T * 2048 + (col - 2048)) * 2; pitch = 128; }
        else if (col < 2120) { off = (T * 2112 + (col - 2112)) * 2; pitch = 16; }
        else if (col < 5480) { off = (T * 2120 + (col - 2120)) * 2; pitch = 6720; }
        else if (col < 7528) { off = (T * 5480 + (col - 5480)) * 2; pitch = 4096; }
        else if (col < 9576) { off = (T * 7528 + (col - 7528)) * 2; pitch = 4096; }
        else { off = 0; pitch = 0; }
    }
    __device__ __forceinline__ void operator()(const f32x4 (&acc)[2][2][4][2], const Unit& u, int wr, int wc, int fr, int fq) const {
        const int row0 = u.pm * BM + wr * 64 + fr, col0 = u.po * BM + wc * 32 + 8 * fq, b = (u.pm * BM) / SEQ_;
        unsigned char* bb = (unsigned char*)base;
#pragma unroll
        for (int bj = 0; bj < 2; ++bj) { size_t off; int pitch; bool f8; seg(col0 + bj * HALF, b, off, pitch, f8);
            if (pitch) {
#pragma unroll
                for (int ai = 0; ai < 2; ++ai)
#pragma unroll
                    for (int m = 0; m < 4; ++m) { const f32x4 v0 = acc[ai][bj][m][0] * scale, v1 = acc[ai][bj][m][1] * scale; unsigned char* dst = bb + off + (size_t)(row0 + ai * HALF + m * 16) * pitch;
                        if (f8) { u32x2 w; w.x = pk_fp8x4(v0[0] * kvscale, v0[1] * kvscale, v0[2] * kvscale, v0[3] * kvscale); w.y = pk_fp8x4(v1[0] * kvscale, v1[1] * kvscale, v1[2] * kvscale, v1[3] * kvscale); *(u32x2*)dst = w; }
                        else { u32x4 w; w.x = cvt_pk_bf16(v0[0], v0[1]); w.y = cvt_pk_bf16(v0[2], v0[3]); w.z = cvt_pk_bf16(v1[0], v1[1]); w.w = cvt_pk_bf16(v1[2], v1[3]); *(u32x4*)dst = w; } } } }
    }
};
template <bool ADD> struct EpiGate {
    static constexpr bool PERM = true, AFTER_DRAIN = false;
    bf16_t* O; int ldc; const bf16_t* gate; int ldg;
    __device__ __forceinline__ void operator()(const f32x4 (&acc)[2][2][4][2], const Unit& u, int wr, int wc, int fr, int fq) const {
        const int row0 = u.pm * BM + wr * 64 + fr, col0 = u.po * BM + wc * 32 + 8 * fq;
#pragma unroll
        for (int ai = 0; ai < 2; ++ai) {
            u32x4 g[4][2], o[4][2];
#pragma unroll
            for (int m = 0; m < 4; ++m) { const size_t row = (size_t)(row0 + ai * HALF + m * 16);
#pragma unroll
                for (int bj = 0; bj < 2; ++bj) { g[m][bj] = *(const u32x4*)(gate + row * ldg + col0 + bj * HALF); if (ADD) o[m][bj] = *(const u32x4*)(O + row * ldc + col0 + bj * HALF); } }
            __builtin_amdgcn_sched_barrier(0);
#pragma unroll
            for (int m = 0; m < 4; ++m) { const size_t row = (size_t)(row0 + ai * HALF + m * 16); bf16_t* rowp = O + row * ldc + col0;
#pragma unroll
                for (int bj = 0; bj < 2; ++bj) { const f32x4 v0 = acc[ai][bj][m][0], v1 = acc[ai][bj][m][1];
                    const u32x4 gg = g[m][bj];
                    float r[8];
                    r[0] = sigm(bflo(gg.x)) * v0[0]; r[1] = sigm(bfhi(gg.x)) * v0[1]; r[2] = sigm(bflo(gg.y)) * v0[2]; r[3] = sigm(bfhi(gg.y)) * v0[3];
                    r[4] = sigm(bflo(gg.z)) * v1[0]; r[5] = sigm(bfhi(gg.z)) * v1[1]; r[6] = sigm(bflo(gg.w)) * v1[2]; r[7] = sigm(bfhi(gg.w)) * v1[3];
                    if (ADD) { const u32x4 oo = o[m][bj];
                        r[0] += bflo(oo.x); r[1] += bfhi(oo.x); r[2] += bflo(oo.y); r[3] += bfhi(oo.y); r[4] += bflo(oo.z); r[5] += bfhi(oo.z); r[6] += bflo(oo.w); r[7] += bfhi(oo.w); }
                    u32x4 w; w.x = cvt_pk_bf16(r[0], r[1]); w.y = cvt_pk_bf16(r[2], r[3]); w.z = cvt_pk_bf16(r[4], r[5]); w.w = cvt_pk_bf16(r[6], r[7]);
                    *(u32x4*)(rowp + bj * HALF) = w; } }
            __builtin_amdgcn_sched_barrier(0);
        }
    }
};
struct EpiResid {
    static constexpr bool PERM = false, AFTER_DRAIN = false;
    const float* in; float* out; int ldc; float scale = 1.0f;
    __device__ __forceinline__ void operator()(const f32x4 (&acc)[2][2][4][2], const Unit& u, int wr, int wc, int fr, int fq) const {
        const int row0 = u.pm * BM + wr * 64 + fr, col0 = u.po * BM + wc * 32 + 4 * fq;
#pragma unroll
        for (int ai = 0; ai < 2; ++ai) {
            f32x4 b[4][2][2];
#pragma unroll
            for (int m = 0; m < 4; ++m) { const size_t off = (size_t)(row0 + ai * HALF + m * 16) * ldc + col0;
#pragma unroll
                for (int bj = 0; bj < 2; ++bj)
#pragma unroll
                    for (int n = 0; n < 2; ++n) b[m][bj][n] = *(const f32x4*)(in + off + bj * HALF + n * 16); }
            __builtin_amdgcn_sched_barrier(0);
#pragma unroll
            for (int m = 0; m < 4; ++m) { const size_t off = (size_t)(row0 + ai * HALF + m * 16) * ldc + col0;
#pragma unroll
                for (int bj = 0; bj < 2; ++bj)
#pragma unroll
                    for (int n = 0; n < 2; ++n) *(f32x4*)(out + off + bj * HALF + n * 16) = b[m][bj][n] + acc[ai][bj][m][n] * scale; }
            __builtin_amdgcn_sched_barrier(0);
        }
    }
};
struct EpiSwiglu {
    static constexpr bool PERM = true, AFTER_DRAIN = false;
    bf16_t* U; int ldc;
    __device__ __forceinline__ void operator()(const f32x4 (&acc)[2][2][4][2], const Unit& u, int wr, int wc, int fr, int fq) const {
        const int row0 = u.pm * BM + wr * 64 + fr, col0 = u.po * HALF + wc * 32 + 8 * fq;
#pragma unroll
        for (int ai = 0; ai < 2; ++ai)
#pragma unroll
            for (int m = 0; m < 4; ++m) { bf16_t* rowp = U + (size_t)(row0 + ai * HALF + m * 16) * ldc + col0;
                float r[8];
#pragma unroll
                for (int n = 0; n < 2; ++n)
#pragma unroll
                    for (int j = 0; j < 4; ++j) { const float g = acc[ai][0][m][n][j], x = acc[ai][1][m][n][j]; r[4 * n + j] = g * sigm(g) * x; }
                u32x4 w; w.x = cvt_pk_bf16(r[0], r[1]); w.y = cvt_pk_bf16(r[2], r[3]); w.z = cvt_pk_bf16(r[4], r[5]); w.w = cvt_pk_bf16(r[6], r[7]);
                *(u32x4*)rowp = w; }
    }
};
struct EpiSwigluF8 {
    static constexpr bool PERM = true, AFTER_DRAIN = false;
    unsigned char* U; int ldc; float iscale, oscale;
    __device__ __forceinline__ void operator()(const f32x4 (&acc)[2][2][4][2], const Unit& u, int wr, int wc, int fr, int fq) const {
        const int row0 = u.pm * BM + wr * 64 + fr, col0 = u.po * HALF + wc * 32 + 8 * fq;
#pragma unroll
        for (int ai = 0; ai < 2; ++ai)
#pragma unroll
            for (int m = 0; m < 4; ++m) { unsigned char* rowp = U + (size_t)(row0 + ai * HALF + m * 16) * ldc + col0;
                float r[8];
#pragma unroll
                for (int n = 0; n < 2; ++n)
#pragma unroll
                    for (int j = 0; j < 4; ++j) { const float g = acc[ai][0][m][n][j] * iscale, x = acc[ai][1][m][n][j] * iscale; r[4 * n + j] = g * sigm(g) * x * oscale; }
                u32x2 w; w.x = pk_fp8x4(r[0], r[1], r[2], r[3]); w.y = pk_fp8x4(r[4], r[5], r[6], r[7]);
                *(u32x2*)rowp = w; }
    }
};
struct EpiPle {
    static constexpr bool PERM = false, AFTER_DRAIN = false;
    float* h; const bf16_t* pp; int ldc; float scale = 1.0f;
    __device__ __forceinline__ void operator()(const f32x4 (&acc)[2][2][4][2], const Unit& u, int wr, int wc, int fr, int fq) const {
        const int row0 = u.pm * BM + wr * 64 + fr, col0 = u.po * BM + wc * 32 + 4 * fq;
#pragma unroll
        for (int ai = 0; ai < 2; ++ai)
#pragma unroll
            for (int mh = 0; mh < 2; ++mh) {
                f32x4 b[2][2][2]; u32x2 p[2][2][2];
#pragma unroll
                for (int m = 0; m < 2; ++m) { const size_t off = (size_t)(row0 + ai * HALF + (2 * mh + m) * 16) * ldc + col0;
#pragma unroll
                    for (int bj = 0; bj < 2; ++bj)
#pragma unroll
                        for (int n = 0; n < 2; ++n) { const size_t o = off + bj * HALF + n * 16; b[m][bj][n] = *(const f32x4*)(h + o); p[m][bj][n] = *(const u32x2*)(pp + o); } }
                __builtin_amdgcn_sched_barrier(0);
#pragma unroll
                for (int m = 0; m < 2; ++m) { const size_t off = (size_t)(row0 + ai * HALF + (2 * mh + m) * 16) * ldc + col0;
#pragma unroll
                    for (int bj = 0; bj < 2; ++bj)
#pragma unroll
                        for (int n = 0; n < 2; ++n) { const size_t o = off + bj * HALF + n * 16; const f32x4 bb = b[m][bj][n]; const u32x2 pq = p[m][bj][n]; const f32x4 a = acc[ai][bj][2 * mh + m][n] * scale;
                            f32x4 r; r[0] = bb[0] + sigm(a[0]) * bflo(pq.x); r[1] = bb[1] + sigm(a[1]) * bfhi(pq.x); r[2] = bb[2] + sigm(a[2]) * bflo(pq.y); r[3] = bb[3] + sigm(a[3]) * bfhi(pq.y);
                            *(f32x4*)(h + o) = r; } }
                __builtin_amdgcn_sched_barrier(0);
            }
    }
};

template <class Epi, class Sched, bool ALIGN_EPI = false, bool SP2 = false, bool F8 = false>
__device__ __forceinline__ void gemm_phase(PG8_LAS unsigned char* lds, const Gemm g, const Sched& S, const Epi& E) {
    int tid_ = threadIdx.x; asm volatile("" : "+v"(tid_));
    const int tid = tid_, wid = __builtin_amdgcn_readfirstlane(tid >> 6), lane = tid & 63, wr = wid >> 2, wc = wid & 3, fr = lane & 15, fq = lane >> 4;
    const int K = g.K, nt = K / BK, lda = g.lda ? g.lda : K, ldb = g.ldb ? g.ldb : K;
    unsigned voffA[2], voffB[2];
#pragma unroll
    for (int i = 0; i < 2; ++i) { int R, C; stage_rc(tid * 16 + i * 8192, R, C); const int Rb = Epi::PERM ? ((R & ~31) + perm32(R & 31)) : R;
        voffA[i] = (unsigned)(R * lda + C) * 2u; voffB[i] = (unsigned)(Rb * ldb + C) * 2u; }
    const size_t kstep = (size_t)(BK * 2);
    const size_t hstepA = (size_t)HALF * lda * 2, hstepB = (size_t)HALF * ldb * 2;
    const size_t tstepA = 2 * hstepA, tstepB = 2 * hstepB;
    const unsigned ldsw = (unsigned)wid * 1024u;
    const int aoff = lds_byte(wr * 64 + fr, fq * 8), boff = lds_byte(wc * 32 + fr, fq * 8);
#define PG8_SA(b, h) (((b) * 2 + (h)) * HTB)
#define PG8_SB(b, h) ((4 + (b) * 2 + (h)) * HTB)
#define PG8_STAGE(bufoff, gbase, voff) do { _Pragma("unroll") for (int _i = 0; _i < 2; ++_i) \
        __builtin_amdgcn_global_load_lds((const unsigned*)((const char*)(gbase) + (voff)[_i]), (PG8_LAS unsigned*)(lds + (bufoff) + ldsw + _i * 8192), 16, 0, 0); } while (0)
#define PG8_LDA(dst, b, h) do { _Pragma("unroll") for (int m = 0; m < 4; ++m) { if constexpr (F8) { const u32x4 x_ = *(const PG8_LAS u32x4*)(lds + PG8_SA(b, h) + aoff + m * 2048), y_ = *(const PG8_LAS u32x4*)(lds + PG8_SA(b, h) + aoff + m * 2048 + 1024); \
        dst##8[m] = (i32x8){(int)x_.x, (int)x_.y, (int)x_.z, (int)x_.w, (int)y_.x, (int)y_.y, (int)y_.z, (int)y_.w}; } \
        else { _Pragma("unroll") for (int k = 0; k < 2; ++k) dst[m][k] = *(const PG8_LAS bf16x8*)(lds + PG8_SA(b, h) + aoff + m * 2048 + k * 1024); } } } while (0)
#define PG8_LDB(dst, b, h) do { _Pragma("unroll") for (int n = 0; n < 2; ++n) { if constexpr (F8) { const u32x4 x_ = *(const PG8_LAS u32x4*)(lds + PG8_SB(b, h) + boff + n * 2048), y_ = *(const PG8_LAS u32x4*)(lds + PG8_SB(b, h) + boff + n * 2048 + 1024); \
        dst##8[n] = (i32x8){(int)x_.x, (int)x_.y, (int)x_.z, (int)x_.w, (int)y_.x, (int)y_.y, (int)y_.z, (int)y_.w}; } \
        else { _Pragma("unroll") for (int k = 0; k < 2; ++k) dst[n][k] = *(const PG8_LAS bf16x8*)(lds + PG8_SB(b, h) + boff + n * 2048 + k * 1024); } } } while (0)
#define PG8_MMA(ai, bj, At, Bt) do { __builtin_amdgcn_s_setprio(1); _Pragma("unroll") for (int m = 0; m < 4; ++m) _Pragma("unroll") for (int n = 0; n < 2; ++n) { \
        if constexpr (F8) { asm volatile("v_mfma_scale_f32_16x16x128_f8f6f4 %0, %1, %2, %0, %3, %3 op_sel_hi:[0,0,0]" : "+v"(acc[ai][bj][m][n]) : "v"(Bt##8[n]), "v"(At##8[m]), "v"(f8sc)); } \
        else { _Pragma("unroll") for (int k = 0; k < 2; ++k) acc[ai][bj][m][n] = __builtin_amdgcn_mfma_f32_16x16x32_bf16(Bt[n][k], At[m][k], acc[ai][bj][m][n], 0, 0, 0); } } \
        __builtin_amdgcn_s_setprio(0); } while (0)
#define PG8_WAIT_V(n) asm volatile("s_waitcnt vmcnt(" #n ")" ::: "memory")
#define PG8_WAIT_L(n) asm volatile("s_waitcnt lgkmcnt(" #n ")" ::: "memory")
#define PG8_BAR __builtin_amdgcn_s_barrier()
#define PG8_SCHED __builtin_amdgcn_sched_barrier(0)
    Unit cur, nxt; int ui = 0;
    if (!S.next(0, cur)) return;
    f32x4 acc[2][2][4][2];
#pragma unroll
    for (int a = 0; a < 2; ++a)
#pragma unroll
        for (int b = 0; b < 2; ++b)
#pragma unroll
            for (int m = 0; m < 4; ++m)
#pragma unroll
                for (int n = 0; n < 2; ++n) acc[a][b][m][n] = (f32x4){0.f, 0.f, 0.f, 0.f};
    const int f8sc = 0x7f7f7f7f; (void)f8sc;
    bf16x8 At[4][2], B0[2][2], B1[2][2]; i32x8 At8[4], B08[2], B18[2]; (void)At; (void)B0; (void)B1; (void)At8; (void)B08; (void)B18;
    const char* cA = (const char*)g.A + (size_t)cur.pm * tstepA; const char* cB = (const char*)g.Bt + (size_t)cur.pn * tstepB;
    S.a_ready(cur);
    if constexpr (SP2) {
        PG8_STAGE(PG8_SB(0, 0), cB, voffB); PG8_STAGE(PG8_SB(0, 1), cB + hstepB, voffB); PG8_STAGE(PG8_SA(0, 0), cA, voffA); PG8_STAGE(PG8_SA(0, 1), cA + hstepA, voffA);
        if (wr == 1) PG8_BAR;
        PG8_WAIT_V(2); PG8_BAR;
        PG8_STAGE(PG8_SB(1, 0), cB + kstep, voffB); PG8_STAGE(PG8_SA(1, 0), cA + kstep, voffA); PG8_STAGE(PG8_SB(1, 1), cB + hstepB + kstep, voffB);
        PG8_WAIT_V(6); PG8_BAR;
    } else {
        PG8_STAGE(PG8_SB(0, 0), cB, voffB); PG8_STAGE(PG8_SA(0, 0), cA, voffA); PG8_STAGE(PG8_SB(0, 1), cB + hstepB, voffB); PG8_STAGE(PG8_SA(0, 1), cA + hstepA, voffA);
        if (wr == 1) PG8_BAR;
        PG8_WAIT_V(4); PG8_BAR;
        PG8_STAGE(PG8_SB(1, 0), cB + kstep, voffB); PG8_STAGE(PG8_SA(1, 0), cA + kstep, voffA); PG8_STAGE(PG8_SB(1, 1), cB + hstepB + kstep, voffB);
        PG8_WAIT_V(6); PG8_BAR;
    }
    for (;;) {
        const bool has_next = S.next(ui + 1, nxt);
        const char* nA = has_next ? (const char*)g.A + (size_t)nxt.pm * tstepA : cA; const char* nB = has_next ? (const char*)g.Bt + (size_t)nxt.pn * tstepB : cB;
        for (int t = 0; t < nt; t += 2) {
            const bool last = (t == nt - 2);
            const char* a1 = cA + (size_t)(t + 1) * kstep;
            const char* a2 = last ? nA : cA + (size_t)(t + 2) * kstep; const char* b2 = last ? nB : cB + (size_t)(t + 2) * kstep;
            const char* a3 = a2 + kstep; const char* b3 = b2 + kstep;
            if (last && has_next) S.a_ready(nxt);
            if constexpr (SP2) {
            PG8_LDB(B0, 0, 0); PG8_LDB(B1, 0, 1); PG8_SCHED; PG8_LDA(At, 0, 0); PG8_STAGE(PG8_SA(1, 1), a1 + hstepA, voffA);
            PG8_WAIT_V(8); PG8_WAIT_L(0); PG8_BAR; PG8_MMA(0, 0, At, B0); PG8_MMA(0, 1, At, B1); PG8_BAR; PG8_SCHED;
            PG8_LDA(At, 0, 1); PG8_STAGE(PG8_SB(0, 0), b2, voffB); PG8_STAGE(PG8_SB(0, 1), b2 + hstepB, voffB); PG8_STAGE(PG8_SA(0, 0), a2, voffA);
            PG8_WAIT_V(8); PG8_WAIT_L(0); PG8_BAR; PG8_MMA(1, 0, At, B0); PG8_MMA(1, 1, At, B1); PG8_BAR; PG8_SCHED;
            PG8_LDB(B0, 1, 0); PG8_LDB(B1, 1, 1); PG8_SCHED; PG8_LDA(At, 1, 0); PG8_STAGE(PG8_SA(0, 1), a2 + hstepA, voffA);
            PG8_WAIT_V(8); PG8_WAIT_L(0); PG8_BAR; PG8_MMA(0, 0, At, B0); PG8_MMA(0, 1, At, B1); PG8_BAR; PG8_SCHED;
            PG8_LDA(At, 1, 1); PG8_STAGE(PG8_SB(1, 0), b3, voffB); PG8_STAGE(PG8_SB(1, 1), b3 + hstepB, voffB); PG8_STAGE(PG8_SA(1, 0), a3, voffA);
            PG8_WAIT_V(8); PG8_WAIT_L(0); PG8_BAR; PG8_MMA(1, 0, At, B0); PG8_MMA(1, 1, At, B1); PG8_BAR; PG8_SCHED;
            } else {
            PG8_LDB(B0, 0, 0); PG8_SCHED; PG8_LDA(At, 0, 0); PG8_STAGE(PG8_SA(1, 1), a1 + hstepA, voffA);
            PG8_WAIT_L(8); PG8_BAR; PG8_WAIT_L(0); PG8_MMA(0, 0, At, B0); PG8_BAR; PG8_SCHED;
            PG8_LDB(B1, 0, 1); PG8_STAGE(PG8_SB(0, 0), b2, voffB);
            PG8_BAR; PG8_WAIT_L(0); PG8_MMA(0, 1, At, B1); PG8_BAR;
            PG8_LDA(At, 0, 1); PG8_STAGE(PG8_SA(0, 0), a2, voffA);
            PG8_BAR; PG8_WAIT_L(0); PG8_MMA(1, 0, At, B0); PG8_BAR; PG8_SCHED;
            PG8_STAGE(PG8_SB(0, 1), b2 + hstepB, voffB);
            PG8_WAIT_V(6); PG8_BAR; PG8_MMA(1, 1, At, B1); PG8_BAR;
            PG8_LDB(B0, 1, 0); PG8_SCHED; PG8_LDA(At, 1, 0); PG8_STAGE(PG8_SA(0, 1), a2 + hstepA, voffA);
            PG8_WAIT_L(8); PG8_BAR; PG8_WAIT_L(0); PG8_MMA(0, 0, At, B0); PG8_BAR; PG8_SCHED;
            PG8_LDB(B1, 1, 1); PG8_STAGE(PG8_SB(1, 0), b3, voffB);
            PG8_BAR; PG8_WAIT_L(0); PG8_MMA(0, 1, At, B1); PG8_BAR;
            PG8_LDA(At, 1, 1); PG8_STAGE(PG8_SA(1, 0), a3, voffA);
            PG8_BAR; PG8_WAIT_L(0); PG8_MMA(1, 0, At, B0); PG8_BAR; PG8_SCHED;
            PG8_STAGE(PG8_SB(1, 1), b3 + hstepB, voffB);
            PG8_WAIT_V(6); PG8_BAR; PG8_MMA(1, 1, At, B1); PG8_BAR;
            }
        }
        if constexpr (ALIGN_EPI) { if (wr == 0) PG8_BAR; }
        if constexpr (F8) asm volatile("s_nop 15\n\ts_nop 15" ::: "memory");
        E(acc, cur, wr, wc, fr, fq); S.done(cur);
        if (!has_next) break;
#pragma unroll
        for (int a = 0; a < 2; ++a)
#pragma unroll
            for (int b = 0; b < 2; ++b)
#pragma unroll
                for (int m = 0; m < 4; ++m)
#pragma unroll
                    for (int n = 0; n < 2; ++n) acc[a][b][m][n] = (f32x4){0.f, 0.f, 0.f, 0.f};
        cur = nxt; cA = nA; cB = nB; ++ui;
        if constexpr (ALIGN_EPI) { if (wr == 1) PG8_BAR; }
    }
    PG8_WAIT_V(0);
    if constexpr (!ALIGN_EPI) { if (wr == 0) PG8_BAR; }
    PG8_BAR;
#undef PG8_SA
#undef PG8_SB
#undef PG8_STAGE
#undef PG8_LDA
#undef PG8_LDB
#undef PG8_MMA
#undef PG8_WAIT_V
#undef PG8_WAIT_L
#undef PG8_BAR
#undef PG8_SCHED
}
}

constexpr int NB = 2, SEQ = 8192, T = NB * SEQ, D = 2048, DEPTH = 2;
constexpr int PW = 9728, IN_W = 9576;
constexpr int C_Q = 0, C_K = 1024, C_V = 1280, C_QI = 1536, C_KI = 2048, C_WI = 2112, C_SLAB = 2120, C_GA = 5480, C_GB = 7528;
constexpr size_t O_Q = 0, O_K = (size_t)T * 1024, O_V = O_K + (size_t)T * 256, O_QI = O_V + (size_t)T * 256, O_KI = O_QI + (size_t)T * 512, O_WI = O_KI + (size_t)T * 64, O_SL = O_WI + (size_t)T * 8,
                 O_GA = O_SL + (size_t)T * 3360, O_GB = O_GA + (size_t)T * 2048;
constexpr int S_R = 0, S_K = 1024, S_V = 2048, S_XW = 3072, SLAB_W = 3360;
constexpr int DFF = 5632, DFE = 7168, NE = 8;
constexpr int LRK = 384, LRN = 3072;
constexpr int MOE_ROWS = 34816;
constexpr int KPAD = 64;
constexpr int XGP = D + 2 * KPAD;
constexpr int NSEL = 256;
constexpr float MOE_AS = 8.0f, MOE_WS13 = 512.0f, MOE_WS2 = 1024.0f;
constexpr float PLE_AS = 8.0f, PLE_WS = 512.0f;
constexpr float RMS_EPS = 1e-6f, GN_EPS = 64e-5f;
constexpr int SREC = 896;

constexpr size_t MiB = 1u << 20;
constexpr size_t WS_CTL = 0, CTL_ZERO_BYTES = 65536;
constexpr size_t WS_ROUTE = 1 * MiB;
constexpr size_t WS_WIN = 4 * MiB, WS_UATT = 80 * MiB, WS_URW = 88 * MiB, WS_WOUT = 96 * MiB, WS_PLEG = 112 * MiB, WS_PLEP = 128 * MiB, WS_LRT = 130 * MiB;
constexpr size_t WS_F13 = 135 * MiB, WS_F2 = 179 * MiB, WS_M13 = 201 * MiB, WS_M2 = 649 * MiB, WS_PB = 873 * MiB, WS_XN = 889 * MiB, WS_ARENA = 953 * MiB;
constexpr size_t WS_PROJ = WS_ARENA, WS_SCANIN = WS_ARENA + 304 * MiB, WS_LR = WS_ARENA + 528 * MiB, WS_YS = WS_ARENA + 624 * MiB, WS_ATT = WS_ARENA + 688 * MiB, WS_IDX = WS_ARENA + 720 * MiB,
                 WS_CHK = WS_ARENA + 728 * MiB, WS_RW = WS_ARENA + 728 * MiB, WS_M1 = WS_ARENA + 760 * MiB;
constexpr size_t WS_UD = WS_ARENA, WS_XG = WS_ARENA, WS_UM = WS_ARENA + 136 * MiB, WS_YM = WS_ARENA + 612 * MiB, WS_PP = WS_ARENA, WS_LRA = WS_XN;
constexpr size_t WS_END = WS_ARENA + 920 * MiB;
constexpr size_t LRT_BYTES = (size_t)LRN * LRK * 2;
constexpr int CW_TMO = 0, CW_MOECNT = 64, CW_ATTQ = 8192, CW_BAR = 4096;
constexpr int RING_BYTES = 131072, MISC_OFF = RING_BYTES, BIAS_OFF = MISC_OFF + 256, JOB_OFF = MISC_OFF + 256, LDS_BYTES = 147456;

#define GAS __attribute__((address_space(1)))
#define LAS __attribute__((address_space(3)))
typedef unsigned short bf16;
typedef unsigned v4u __attribute__((ext_vector_type(4)));
typedef unsigned v2u __attribute__((ext_vector_type(2)));
typedef float f32x4 __attribute__((ext_vector_type(4)));
typedef float f32x16 __attribute__((ext_vector_type(16)));
typedef short bf16x8 __attribute__((ext_vector_type(8)));
#define LDS_WAIT() asm volatile("s_waitcnt lgkmcnt(0)" ::: "memory")
#define VM_WAIT() asm volatile("s_waitcnt vmcnt(0)" ::: "memory")
using pg8::cvt_pk_bf16; using pg8::bflo; using pg8::bfhi; using pg8::sigm;
__device__ __forceinline__ float bf2f(unsigned short b) { return __uint_as_float(((unsigned)b) << 16); }
__device__ __forceinline__ unsigned short f2bf(float f) { return (unsigned short)(cvt_pk_bf16(f, 0.f) & 0xffffu); }

#define XB_TMO      128
#define XB_XCNT(j)  (256  + 64 * (j))
#define XB_XSUB(j)  (1280 + 64 * (j))
#define XB_XGEN(j)  (2304 + 64 * (j))
#define XB_TOP      3328
#define XB_TOPGEN   3392
#define XCD_BAR_WORDS 3456
#define XB_SPIN_CAP (1u << 18)
__device__ __forceinline__ unsigned xb_ld(unsigned* p)              { return __hip_atomic_load(p, __ATOMIC_RELAXED, __HIP_MEMORY_SCOPE_AGENT); }
__device__ __forceinline__ unsigned xb_add(unsigned* p, unsigned v) { return __hip_atomic_fetch_add(p, v, __ATOMIC_RELAXED, __HIP_MEMORY_SCOPE_AGENT); }
__device__ __forceinline__ unsigned xb_xcc_id() { return (unsigned)__builtin_amdgcn_s_getreg((3 << 11) | 20) & 0xFu; }
#define XB_SPIN(cond, bar) do { unsigned _sp = 0; while (cond) { __builtin_amdgcn_s_sleep(1); \
    if ((++_sp & 255u) == 0u) { if (xb_ld(&(bar)[XB_TMO])) break; if (_sp > XB_SPIN_CAP) { atomicAdd(&(bar)[XB_TMO], 1u); break; } } } } while (0)
struct XcdBarrier { unsigned* bar; unsigned x; volatile LAS unsigned* st; };
__device__ __forceinline__ XcdBarrier xcd_barrier_post(unsigned* bar, volatile LAS unsigned* st) {
    XcdBarrier b; b.bar = bar; b.x = xb_xcc_id(); b.st = st;
    if (threadIdx.x == 0) (void)xb_add(&bar[XB_XCNT(b.x)], 1u);
    return b;
}
__device__ __forceinline__ void xcd_barrier_complete(unsigned* bar, unsigned x, unsigned& nloc, unsigned& nx) {
    const unsigned G = gridDim.x * gridDim.y * gridDim.z;
    unsigned sum, cnt, mine, sp = 0u;
    for (;;) {
        sum = 0u; cnt = 0u; mine = 0u;
#pragma unroll
        for (unsigned j = 0; j < 16; ++j) { const unsigned c = xb_ld(&bar[XB_XCNT(j)]); sum += c; cnt += (c > 0u) ? 1u : 0u; mine = (j == x) ? c : mine; }
        if (sum == G) break;
        __builtin_amdgcn_s_sleep(1);
        if ((++sp & 255u) == 0u) { if (xb_ld(&bar[XB_TMO])) break; if (sp > XB_SPIN_CAP) { atomicAdd(&bar[XB_TMO], 1u); break; } }
    }
    nloc = mine > 0u ? mine : 1u; nx = cnt > 0u ? cnt : 1u;
}
__device__ __forceinline__ void xcd_barrier(const XcdBarrier& b) {
    asm volatile("s_waitcnt vmcnt(0)" ::: "memory");
    __syncthreads();
    if (threadIdx.x == 0) {
        unsigned* bar = b.bar;
        __builtin_amdgcn_s_waitcnt(0);
        unsigned nloc = b.st[0], nx = b.st[1];
        if (nloc == 0u) { xcd_barrier_complete(bar, b.x, nloc, nx); b.st[0] = nloc; b.st[1] = nx; }
        const unsigned old = xb_add(&bar[XB_XSUB(b.x)], 1u);
        const unsigned gen = old / nloc;
        if (old + 1u == (gen + 1u) * nloc) {
            __builtin_amdgcn_fence(__ATOMIC_RELEASE, "agent");
            asm volatile("s_waitcnt vmcnt(0)" ::: "memory");
            const unsigned og = xb_add(&bar[XB_TOP], 1u);
            const unsigned tg = og / nx;
            if (og + 1u == (tg + 1u) * nx) xb_add(&bar[XB_TOPGEN], 1u);
            else XB_SPIN(xb_ld(&bar[XB_TOPGEN]) == tg, bar);
            __builtin_amdgcn_fence(__ATOMIC_ACQUIRE, "agent");
            xb_add(&bar[XB_XGEN(b.x)], 1u);
            asm volatile("s_waitcnt vmcnt(0)" ::: "memory");
        } else {
            XB_SPIN(xb_ld(&bar[XB_XGEN(b.x)]) == gen, bar);
            __builtin_amdgcn_fence(__ATOMIC_ACQUIRE, "agent");
            asm volatile("s_waitcnt vmcnt(0)" ::: "memory");
        }
    }
    __syncthreads();
}

__device__ __forceinline__ float wave_sum(float v) {
#pragma unroll
    for (int o = 1; o < 64; o <<= 1) v += __shfl_xor(v, o);
    return v;
}
__device__ __forceinline__ float wave_max(float v) {
#pragma unroll
    for (int o = 1; o < 64; o <<= 1) v = fmaxf(v, __shfl_xor(v, o));
    return v;
}
template <int CTRL> __device__ __forceinline__ float dpp_f(float x) { return __int_as_float(__builtin_amdgcn_update_dpp(0, __float_as_int(x), CTRL, 0xf, 0xf, true)); }
template <int CTRL> __device__ __forceinline__ unsigned dpp_u(unsigned x) { return (unsigned)__builtin_amdgcn_update_dpp(0, (int)x, CTRL, 0xf, 0xf, true); }
__device__ __forceinline__ float sum16(float x) { x += dpp_f<0xB1>(x); x += dpp_f<0x4E>(x); x += dpp_f<0x141>(x); x += dpp_f<0x140>(x); return x; }
__device__ __forceinline__ unsigned wave_sum_u(unsigned x) {
    x += dpp_u<0xB1>(x); x += dpp_u<0x4E>(x); x += dpp_u<0x141>(x); x += dpp_u<0x140>(x);
    return (unsigned)__builtin_amdgcn_readlane((int)x, 0) + (unsigned)__builtin_amdgcn_readlane((int)x, 16) + (unsigned)__builtin_amdgcn_readlane((int)x, 32) + (unsigned)__builtin_amdgcn_readlane((int)x, 48);
}

__device__ const unsigned char REL_BUCKET_TAB[113] = {0, 1, 2, 3, 4, 5, 6, 7, 8, 9, 10, 11, 12, 13, 14, 15, 16, 16, 16, 17, 17, 18, 18, 18, 19, 19, 19, 20, 20, 20, 20, 21, 21, 21, 21, 22, 22, 22, 22, 22, 23, 23, 23, 23, 23, 23,
    24, 24, 24, 24, 24, 24, 25, 25, 25, 25, 25, 25, 25, 26, 26, 26, 26, 26, 26, 26, 26, 27, 27, 27, 27, 27, 27, 27, 27, 27, 27, 28, 28, 28, 28, 28, 28, 28, 28, 28, 28, 29, 29, 29, 29, 29, 29, 29, 29, 29, 29, 29, 29,
    30, 30, 30, 30, 30, 30, 30, 30, 30, 30, 30, 30, 30, 30};

struct Args { const float* in[31]; float* out; unsigned char* ws; int ph_lo, ph_hi; };
enum { I_X = 0, I_P, I_WIN, I_UATT, I_URW, I_WOUT, I_RELB, I_MU, I_W0, I_WUP, I_A0, I_AUP, I_GUP, I_KK, I_KA, I_RK, I_GNW, I_GNB, I_NMIX, I_NFFN, I_NPLE, I_PLEP, I_PLEG, I_F1, I_F3, I_F2, I_ROUT, I_M1, I_M3, I_M2, I_FIN };

struct ConvJob { const float* src; bf16* dst; int K, N, mode, end; float f8scale; int pad; };
constexpr int NJOBS = 39;
__device__ __forceinline__ void tr_load(const float* W, int N, int item, int lane, f32x4 (&v)[8]) {
    const int nblk = (N + 31) >> 5, kb = item / nblk, nb = item - kb * nblk, k0 = 64 * kb, n0 = 32 * nb;
    const int rsub = lane >> 3, c4 = lane & 7, nr = n0 + 4 * c4;
    const GAS float* src = (const GAS float*)W + (size_t)(k0 + rsub) * N + (nr < N ? nr : 0);
#pragma unroll
    for (int i = 0; i < 8; ++i) v[i] = *(const GAS f32x4*)(src + (size_t)(8 * i) * N);
}
__device__ __forceinline__ void tr_store(int N, bf16* WT, int dpitch, int mode, LAS float* scr, int item, int lane, float f8scale, const f32x4 (&v)[8]) {
    const int nblk = (N + 31) >> 5, kb = item / nblk, nb = item - kb * nblk, k0 = 64 * kb, n0 = 32 * nb;
    const int rsub = lane >> 3, c4 = lane & 7, nr = n0 + 4 * c4;
    const bool inr = nr < N;
#pragma unroll
    for (int i = 0; i < 8; ++i) { LAS float* d = scr + (8 * i + rsub) * 33 + 4 * c4; d[0] = inr ? v[i][0] : 0.f; d[1] = inr ? v[i][1] : 0.f; d[2] = inr ? v[i][2] : 0.f; d[3] = inr ? v[i][3] : 0.f; }
    LDS_WAIT(); asm volatile("" ::: "memory");
    if (f8scale != 0.f) {
#pragma unroll
        for (int j = 0; j < 2; ++j) { const int ch = lane + 64 * j, nl = ch >> 2, c16 = ch & 3, n = n0 + nl; const LAS float* s = scr + (16 * c16) * 33 + nl;
            v4u o;
            o.x = pg8::pk_fp8x4(s[0 * 33] * f8scale, s[1 * 33] * f8scale, s[2 * 33] * f8scale, s[3 * 33] * f8scale); o.y = pg8::pk_fp8x4(s[4 * 33] * f8scale, s[5 * 33] * f8scale, s[6 * 33] * f8scale, s[7 * 33] * f8scale);
            o.z = pg8::pk_fp8x4(s[8 * 33] * f8scale, s[9 * 33] * f8scale, s[10 * 33] * f8scale, s[11 * 33] * f8scale); o.w = pg8::pk_fp8x4(s[12 * 33] * f8scale, s[13 * 33] * f8scale, s[14 * 33] * f8scale, s[15 * 33] * f8scale);
            if (n < N) { const int drow = mode == 0 ? n : ((n >> 7) * 256 + (n & 127) + (mode == 2 ? 128 : 0)); *(GAS v4u*)((GAS unsigned char*)WT + (size_t)drow * dpitch + k0 + 16 * c16) = o; } }
        LDS_WAIT(); asm volatile("" ::: "memory");
        return;
    }
    const int c = lane & 7;
#pragma unroll
    for (int j = 0; j < 4; ++j) { const int nl = (lane >> 3) + 8 * j, n = n0 + nl; const LAS float* s = scr + (8 * c) * 33 + nl;
        v4u o; o.x = cvt_pk_bf16(s[0 * 33], s[1 * 33]); o.y = cvt_pk_bf16(s[2 * 33], s[3 * 33]); o.z = cvt_pk_bf16(s[4 * 33], s[5 * 33]); o.w = cvt_pk_bf16(s[6 * 33], s[7 * 33]);
        if (n < N) { const int drow = mode == 0 ? n : ((n >> 7) * 256 + (n & 127) + (mode == 2 ? 128 : 0)); *(GAS v4u*)((GAS bf16*)WT + (size_t)drow * dpitch + k0 + 8 * c) = o; } }
    LDS_WAIT(); asm volatile("" ::: "memory");
}
__device__ __forceinline__ void p0_prologue(const Args& a, LAS unsigned char* lds, int tid, int lane, int wave, int G) {
    unsigned char* ws = a.ws;
    LAS ConvJob* jobs = (LAS ConvJob*)(lds + JOB_OFF);
    if (tid == 0) {
        int nj = 0, end = 0;
        { size_t zv = 0; asm volatile("" : "+v"(zv)); ws += zv; }
#define ADDJOB(src_, dst_, K_, N_, mode_) do { end += ((K_) / 64) * (((N_) + 31) / 32); jobs[nj].src = (src_); jobs[nj].dst = (dst_); jobs[nj].K = (K_); jobs[nj].N = (N_); jobs[nj].mode = (mode_); jobs[nj].end = end; jobs[nj].f8scale = 0.f; jobs[nj].pad = 0; ++nj; } while (0)
#define ADDJOB8(src_, dst_, K_, N_, mode_, sc_) do { ADDJOB(src_, dst_, K_, N_, mode_); jobs[nj - 1].f8scale = (sc_); } while (0)
        for (int e = 0; e < NE; ++e) {
            ADDJOB8(a.in[I_M1] + (size_t)e * D * DFE, (bf16*)(ws + WS_M13 + (size_t)e * 2 * DFE * XGP), D, DFE, 1, MOE_WS13); jobs[nj - 1].pad = 2 * KPAD;
            ADDJOB8(a.in[I_M3] + (size_t)e * D * DFE, (bf16*)(ws + WS_M13 + (size_t)e * 2 * DFE * XGP), D, DFE, 2, MOE_WS13); jobs[nj - 1].pad = 2 * KPAD;
            ADDJOB8(a.in[I_M2] + (size_t)e * DFE * D, (bf16*)(ws + WS_M2 + (size_t)e * D * DFE), DFE, D, 0, MOE_WS2);
        }
        ADDJOB(a.in[I_F1], (bf16*)(ws + WS_F13), D, DFF, 1);
        ADDJOB(a.in[I_F3], (bf16*)(ws + WS_F13), D, DFF, 2);
        ADDJOB(a.in[I_F2], (bf16*)(ws + WS_F2), DFF, D, 0);
        for (int l = 0; l < DEPTH; ++l) {
            ADDJOB(a.in[I_WIN] + (size_t)l * D * IN_W, (bf16*)(ws + WS_WIN) + (size_t)l * PW * D, D, IN_W, 0);
            ADDJOB(a.in[I_UATT] + (size_t)l * 1024 * D, (bf16*)(ws + WS_UATT) + (size_t)l * D * 1024, 1024, D, 0);
            ADDJOB(a.in[I_URW] + (size_t)l * 1024 * D, (bf16*)(ws + WS_URW) + (size_t)l * D * 1024, 1024, D, 0);
            ADDJOB(a.in[I_WOUT] + (size_t)l * D * D, (bf16*)(ws + WS_WOUT) + (size_t)l * D * D, D, D, 0);
            if (l == DEPTH - 1) ADDJOB8(a.in[I_PLEG] + (size_t)l * D * D, (bf16*)(ws + WS_PLEG) + (size_t)l * D * D, D, D, 0, PLE_WS);
            else ADDJOB(a.in[I_PLEG] + (size_t)l * D * D, (bf16*)(ws + WS_PLEG) + (size_t)l * D * D, D, D, 0);
            ADDJOB(a.in[I_PLEP] + (size_t)l * 256 * D, (bf16*)(ws + WS_PLEP) + (size_t)l * D * 256, 256, D, 0);
        }
#undef ADDJOB8
#undef ADDJOB
    }
    __syncthreads();
    LAS float* scr = (LAS float*)(lds + wave * 8704);
    const int gw = blockIdx.x * 8 + wave, NGW = G * 8;
    const int total = jobs[NJOBS - 1].end;
    {
        int j = 0, jbeg = 0, it = gw;
        f32x4 va[8], vb[8];
        if (it < total) { while (it >= jobs[j].end) { jbeg = jobs[j].end; ++j; } tr_load(jobs[j].src, jobs[j].N, it - jbeg, lane, va); }
#define TRHALF_(CUR, NXT) { \
            int jn = j, jbn = jbeg; const int itn = it + NGW; \
            asm volatile("" : "+v"(CUR[0]), "+v"(CUR[1]), "+v"(CUR[2]), "+v"(CUR[3]), "+v"(CUR[4]), "+v"(CUR[5]), "+v"(CUR[6]), "+v"(CUR[7]) :: "memory"); \
            if (itn < total) { while (itn >= jobs[jn].end) { jbn = jobs[jn].end; ++jn; } tr_load(jobs[jn].src, jobs[jn].N, itn - jbn, lane, NXT); } \
            __builtin_amdgcn_sched_barrier(0); \
            asm volatile("" : "+v"(CUR[0]), "+v"(CUR[1]), "+v"(CUR[2]), "+v"(CUR[3]), "+v"(CUR[4]), "+v"(CUR[5]), "+v"(CUR[6]), "+v"(CUR[7])); \
            tr_store(jobs[j].N, jobs[j].dst, jobs[j].K + jobs[j].pad, jobs[j].mode, scr, it - jbeg, lane, jobs[j].f8scale, CUR); \
            j = jn; jbeg = jbn; it = itn; }
        while (it < total) {
            TRHALF_(va, vb);
            if (it >= total) break;
            TRHALF_(vb, va);
        }
#undef TRHALF_
    }
    const int gt = blockIdx.x * 512 + tid, NGT = G * 512;
    for (int l = 0; l < DEPTH; ++l) {
        bf16* lrt = (bf16*)(ws + WS_LRT + (size_t)l * LRT_BYTES);
        const float* wup = a.in[I_WUP] + (size_t)l * 64 * 1024; const float* aup = a.in[I_AUP] + (size_t)l * 64 * 1024; const float* gup = a.in[I_GUP] + (size_t)l * 160 * 1024;
        for (int i0 = gt; i0 < LRN * LRK; i0 += 6 * NGT) {
            float v[6];
#pragma unroll
            for (int u = 0; u < 6; ++u) { const int i = i0 + u * NGT; const int n = i / LRK, k = i - n * LRK;
                const float* sp = wup; bool ok = false;
                if (i < LRN * LRK) {
                    if (n < 1024) { if (k < 64) { sp = wup + k * 1024 + n; ok = true; } }
                    else if (n < 2048) { if (k >= 64 && k < 128) { sp = aup + (k - 64) * 1024 + (n - 1024); ok = true; } }
                    else { if (k >= 128 && k < 288) { sp = gup + (k - 128) * 1024 + (n - 2048); ok = true; } } }
                const float x = *sp; v[u] = ok ? x : 0.f; }
            __builtin_amdgcn_sched_barrier(0);
#pragma unroll
            for (int u = 0; u < 6; ++u) { const int i = i0 + u * NGT; if (i < LRN * LRK) lrt[i] = f2bf(v[u]); }
        }
    }
    { const f32x4* p4 = (const f32x4*)a.in[I_P]; v2u* o = (v2u*)(ws + WS_PB); const int N4 = DEPTH * T * 256 / 4;
      for (int i0 = gt; i0 < N4; i0 += 8 * NGT) {
          f32x4 v[8];
#pragma unroll
          for (int u = 0; u < 8; ++u) { const int i = i0 + u * NGT; v[u] = p4[i < N4 ? i : gt]; }
          __builtin_amdgcn_sched_barrier(0);
#pragma unroll
          for (int u = 0; u < 8; ++u) { const int i = i0 + u * NGT; if (i < N4) { v2u w; w.x = cvt_pk_bf16(v[u][0], v[u][1]); w.y = cvt_pk_bf16(v[u][2], v[u][3]); o[i] = w; } } } }
}

template <int MODE, bool F8OUT = false>
__device__ __forceinline__ void norm_phase(const float* hin, float* hout, const float* gain, bf16* xn, const float* router, unsigned* ctl, int* route, const bf16* ym, const LAS int* tab, int lane, int wave, int G) {
    const int gw = blockIdx.x * 8 + wave, NGW = G * 8;
    f32x4 gv[8];
    { const f32x4* g4 = (const f32x4*)gain + lane;
#pragma unroll
      for (int j = 0; j < 8; ++j) gv[j] = g4[64 * j]; }
    f32x4 vn[8]; int rn[6] = {0, 0, 0, 0, 0, 0};
    if (gw < T) { const f32x4* xr = (const f32x4*)(hin + (size_t)gw * D) + lane;
#pragma unroll
        for (int j = 0; j < 8; ++j) vn[j] = xr[64 * j];
        if (MODE == 2) { const int* rt = route + (size_t)gw * 8; rn[0] = rt[0]; rn[1] = rt[1]; rn[2] = rt[2]; rn[3] = rt[3]; rn[4] = rt[4]; rn[5] = rt[5]; } }
    for (int m = gw; m < T; m += NGW) {
        f32x4 v[8];
#pragma unroll
        for (int j = 0; j < 8; ++j) v[j] = vn[j];
        v2u ya[8], yb[8]; float g1 = 0.f, g2 = 0.f;
        if (MODE == 2) {
            const int e1 = rn[0], p1 = rn[1], e2 = rn[3], p2 = rn[4]; g1 = __int_as_float(rn[2]); g2 = __int_as_float(rn[5]);
            const v2u* y1 = (const v2u*)(ym + (size_t)(tab[e1] * 256 + p1) * D) + lane; const v2u* y2 = (const v2u*)(ym + (size_t)(tab[e2] * 256 + p2) * D) + lane;
#pragma unroll
            for (int j = 0; j < 8; ++j) { ya[j] = y1[64 * j]; yb[j] = y2[64 * j]; }
        }
        { const int mn = m + NGW;
          if (mn < T) { const f32x4* xr = (const f32x4*)(hin + (size_t)mn * D) + lane;
#pragma unroll
              for (int j = 0; j < 8; ++j) vn[j] = xr[64 * j];
              if (MODE == 2) { const int* rt = route + (size_t)mn * 8; rn[0] = rt[0]; rn[1] = rt[1]; rn[2] = rt[2]; rn[3] = rt[3]; rn[4] = rt[4]; rn[5] = rt[5]; } } }
        __builtin_amdgcn_sched_barrier(0);
        if (MODE == 2) {
            f32x4* ho = (f32x4*)(hout + (size_t)m * D) + lane;
#pragma unroll
            for (int j = 0; j < 8; ++j) { const v2u a = ya[j], b = yb[j];
                v[j][0] += g1 * bflo(a.x) + g2 * bflo(b.x); v[j][1] += g1 * bfhi(a.x) + g2 * bfhi(b.x); v[j][2] += g1 * bflo(a.y) + g2 * bflo(b.y); v[j][3] += g1 * bfhi(a.y) + g2 * bfhi(b.y); }
#pragma unroll
            for (int j = 0; j < 8; ++j) ho[64 * j] = v[j];
        }
        float s = 0.f;
#pragma unroll
        for (int j = 0; j < 8; ++j) s += (v[j][0] * v[j][0] + v[j][1] * v[j][1]) + (v[j][2] * v[j][2] + v[j][3] * v[j][3]);
        const float rs = rsqrtf(wave_sum(s) * (1.0f / D) + RMS_EPS);
#pragma unroll
        for (int j = 0; j < 8; ++j) v[j] = (v[j] * rs) * gv[j];
        if (F8OUT) { unsigned* o = (unsigned*)((unsigned char*)xn + (size_t)m * D) + lane;
#pragma unroll
            for (int j = 0; j < 8; ++j) o[64 * j] = pg8::pk_fp8x4(v[j][0] * PLE_AS, v[j][1] * PLE_AS, v[j][2] * PLE_AS, v[j][3] * PLE_AS);
        } else
        if (MODE == 4) { unsigned* o = (unsigned*)((unsigned char*)xn + (size_t)m * D) + lane;
#pragma unroll
            for (int j = 0; j < 8; ++j) o[64 * j] = pg8::pk_fp8x4(v[j][0] * MOE_AS, v[j][1] * MOE_AS, v[j][2] * MOE_AS, v[j][3] * MOE_AS);
        } else
        if (MODE == 3) { f32x4* o = (f32x4*)(hout + (size_t)m * D) + lane;
#pragma unroll
            for (int j = 0; j < 8; ++j) o[64 * j] = v[j];
        } else { v2u* o = (v2u*)(xn + (size_t)m * D) + lane;
#pragma unroll
            for (int j = 0; j < 8; ++j) { v2u w; w.x = cvt_pk_bf16(v[j][0], v[j][1]); w.y = cvt_pk_bf16(v[j][2], v[j][3]); o[64 * j] = w; } }
        if (MODE == 1) {
            float lg[8];
#pragma unroll
            for (int e = 0; e < 8; ++e) lg[e] = 0.f;
#pragma unroll
            for (int jp = 0; jp < 4; ++jp) {
                f32x4 rr[2][4][2];
#pragma unroll
                for (int jj = 0; jj < 2; ++jj)
#pragma unroll
                    for (int q = 0; q < 4; ++q) { const f32x4* rp = (const f32x4*)(router + (size_t)(4 * lane + 256 * (2 * jp + jj) + q) * 8); rr[jj][q][0] = rp[0]; rr[jj][q][1] = rp[1]; }
                __builtin_amdgcn_sched_barrier(0);
#pragma unroll
                for (int jj = 0; jj < 2; ++jj)
#pragma unroll
                    for (int q = 0; q < 4; ++q) { const f32x4 r0 = rr[jj][q][0], r1 = rr[jj][q][1]; const float x = v[2 * jp + jj][q];
                        lg[0] += x * r0[0]; lg[1] += x * r0[1]; lg[2] += x * r0[2]; lg[3] += x * r0[3]; lg[4] += x * r1[0]; lg[5] += x * r1[1]; lg[6] += x * r1[2]; lg[7] += x * r1[3]; }
                __builtin_amdgcn_sched_barrier(0);
            }
#pragma unroll
            for (int e = 0; e < 8; ++e) lg[e] = wave_sum(lg[e]);
            int i1 = 0; float v1 = lg[0];
#pragma unroll
            for (int e = 1; e < 8; ++e) if (lg[e] > v1) { v1 = lg[e]; i1 = e; }
            int i2 = -1; float v2 = -INFINITY;
#pragma unroll
            for (int e = 0; e < 8; ++e) if (e != i1 && lg[e] > v2) { v2 = lg[e]; i2 = e; }
            if (lane == 0) {
                const float ex = __expf(v2 - v1), g1r = 1.0f / (1.0f + ex), g2r = ex * g1r;
                const int p1 = (int)atomicAdd(ctl + CW_MOECNT + i1, 1u), p2 = (int)atomicAdd(ctl + CW_MOECNT + i2, 1u);
                int* rt = route + (size_t)m * 8; rt[0] = i1; rt[1] = p1; rt[2] = __float_as_int(g1r); rt[3] = i2; rt[4] = p2; rt[5] = __float_as_int(g2r); rt[6] = 0; rt[7] = 0;
            }
        }
    }
}
__device__ __forceinline__ void moe_table(const unsigned* ctl, LAS int* tab, int NT, int tid) {
    __syncthreads();
    if (tid == 0) { int tb = 0, ub = 0;
        for (int e = 0; e < NE; ++e) { tab[e] = tb; tab[9 + e] = ub; const int tiles = ((int)ctl[CW_MOECNT + e] + 255) >> 8; tb += tiles; ub += tiles * NT; }
        tab[8] = tb; tab[17] = ub; }
    __syncthreads();
}
__device__ __forceinline__ void moe_gather(const bf16* xn, unsigned char* xg, const int* route, const LAS int* tab, int lane, int wave, int G) {
    const int gw = blockIdx.x * 8 + wave, NGW = G * 8;
    for (int m = gw; m < T; m += NGW) {
        const int* rt = route + (size_t)m * 8; const int r1 = tab[rt[0]] * 256 + rt[1], r2 = tab[rt[3]] * 256 + rt[4];
        const v4u* s = (const v4u*)(xn + (size_t)m * D) + 4 * lane;
        float x[32];
#pragma unroll
        for (int j = 0; j < 4; ++j) { const v4u v = s[j]; x[8 * j] = bflo(v.x); x[8 * j + 1] = bfhi(v.x); x[8 * j + 2] = bflo(v.y); x[8 * j + 3] = bfhi(v.y); x[8 * j + 4] = bflo(v.z); x[8 * j + 5] = bfhi(v.z); x[8 * j + 6] = bflo(v.w); x[8 * j + 7] = bfhi(v.w); }
        v4u o0, o1;
        o0.x = pg8::pk_fp8x4(x[0] * MOE_AS, x[1] * MOE_AS, x[2] * MOE_AS, x[3] * MOE_AS); o0.y = pg8::pk_fp8x4(x[4] * MOE_AS, x[5] * MOE_AS, x[6] * MOE_AS, x[7] * MOE_AS);
        o0.z = pg8::pk_fp8x4(x[8] * MOE_AS, x[9] * MOE_AS, x[10] * MOE_AS, x[11] * MOE_AS); o0.w = pg8::pk_fp8x4(x[12] * MOE_AS, x[13] * MOE_AS, x[14] * MOE_AS, x[15] * MOE_AS);
        o1.x = pg8::pk_fp8x4(x[16] * MOE_AS, x[17] * MOE_AS, x[18] * MOE_AS, x[19] * MOE_AS); o1.y = pg8::pk_fp8x4(x[20] * MOE_AS, x[21] * MOE_AS, x[22] * MOE_AS, x[23] * MOE_AS);
        o1.z = pg8::pk_fp8x4(x[24] * MOE_AS, x[25] * MOE_AS, x[26] * MOE_AS, x[27] * MOE_AS); o1.w = pg8::pk_fp8x4(x[28] * MOE_AS, x[29] * MOE_AS, x[30] * MOE_AS, x[31] * MOE_AS);
        v4u* d1 = (v4u*)(xg + (size_t)r1 * XGP) + 2 * lane; v4u* d2 = (v4u*)(xg + (size_t)r2 * XGP) + 2 * lane;
        d1[0] = o0; d1[1] = o1; d2[0] = o0; d2[1] = o1;
    }
}

__device__ __forceinline__ void rwkv_prep_a(const bf16* proj, const float* mu, bf16* lra, int tid, int G) {
    const int gt = blockIdx.x * 512 + tid, NGT = G * 512;
    for (int i = gt; i < T * 48; i += NGT) {
        const int m = i / 48, j8 = i - m * 48, t = m & (SEQ - 1);
        v4u o = {0u, 0u, 0u, 0u};
        if (j8 < 36) {
            const int sc = S_XW + 8 * j8;
            const v4u cu = *(const v4u*)(proj + O_SL + (size_t)m * SLAB_W + sc);
            v4u pv = {0u, 0u, 0u, 0u}; if (t > 0) pv = *(const v4u*)(proj + O_SL + (size_t)(m - 1) * SLAB_W + sc);
            const f32x4 m0 = *(const f32x4*)(mu + sc), m1 = *(const f32x4*)(mu + sc + 4);
            float x[8];
            x[0] = bflo(cu.x) + (bflo(pv.x) - bflo(cu.x)) * m0[0]; x[1] = bfhi(cu.x) + (bfhi(pv.x) - bfhi(cu.x)) * m0[1];
            x[2] = bflo(cu.y) + (bflo(pv.y) - bflo(cu.y)) * m0[2]; x[3] = bfhi(cu.y) + (bfhi(pv.y) - bfhi(cu.y)) * m0[3];
            x[4] = bflo(cu.z) + (bflo(pv.z) - bflo(cu.z)) * m1[0]; x[5] = bfhi(cu.z) + (bfhi(pv.z) - bfhi(cu.z)) * m1[1];
            x[6] = bflo(cu.w) + (bflo(pv.w) - bflo(cu.w)) * m1[2]; x[7] = bfhi(cu.w) + (bfhi(pv.w) - bfhi(cu.w)) * m1[3];
            if (j8 < 8) {
#pragma unroll
                for (int q = 0; q < 8; ++q) x[q] = 1.0f - 2.0f * __builtin_amdgcn_rcpf(1.0f + __expf(2.0f * x[q]));
            } else if (j8 >= 16) {
#pragma unroll
                for (int q = 0; q < 8; ++q) x[q] = sigm(x[q]);
            }
            o.x = cvt_pk_bf16(x[0], x[1]); o.y = cvt_pk_bf16(x[2], x[3]); o.z = cvt_pk_bf16(x[4], x[5]); o.w = cvt_pk_bf16(x[6], x[7]);
        }
        *(v4u*)(lra + (size_t)m * LRK + 8 * j8) = o;
    }
}
__device__ __forceinline__ float sum8(float x) { x += dpp_f<0xB1>(x); x += dpp_f<0x4E>(x); x += dpp_f<0x141>(x); return x; }
__device__ __forceinline__ void unpack8(const v4u v, float (&o)[8]) { o[0] = bflo(v.x); o[1] = bfhi(v.x); o[2] = bflo(v.y); o[3] = bfhi(v.y); o[4] = bflo(v.z); o[5] = bfhi(v.z); o[6] = bflo(v.w); o[7] = bfhi(v.w); }
__device__ __forceinline__ v4u pack8(const float (&x)[8]) { v4u o; o.x = cvt_pk_bf16(x[0], x[1]); o.y = cvt_pk_bf16(x[2], x[3]); o.z = cvt_pk_bf16(x[4], x[5]); o.w = cvt_pk_bf16(x[6], x[7]); return o; }
__device__ __forceinline__ void load8f(const float* p, float (&o)[8]) { const f32x4 a = *(const f32x4*)p, b = *(const f32x4*)(p + 4); o[0] = a[0]; o[1] = a[1]; o[2] = a[2]; o[3] = a[3]; o[4] = b[0]; o[5] = b[1]; o[6] = b[2]; o[7] = b[3]; }
__device__ __forceinline__ void rwkv_prep_b(const bf16* proj_, const bf16* lr_, const float* mu, const float* w0, const float* a0, const float* k_k, const float* k_a, unsigned char* scanin, int tid, int G, int ntok) {
    const GAS bf16* proj = (const GAS bf16*)proj_; const GAS bf16* lr = (const GAS bf16*)lr_;
    const int gt = blockIdx.x * 512 + tid, NGT = G * 512;
    const int c8 = gt & 127, c = 8 * c8, h = c8 >> 3, sub = c8 & 7;
    float mur[8], muk[8], muv[8], w0v[8], a0v[8], kkv[8], kav[8];
    load8f(mu + S_R + c, mur); load8f(mu + S_K + c, muk); load8f(mu + S_V + c, muv); load8f(w0 + c, w0v); load8f(a0 + c, a0v); load8f(k_k + c, kkv); load8f(k_a + c, kav);
    for (int it = gt; it < ntok * 128; it += NGT) {
        const int m = it >> 7, b = m >> 13, t = m & (SEQ - 1);
        const GAS bf16* pc = proj + O_SL + (size_t)m * SLAB_W + c;
        float rc[8], kc[8], vc[8], rp[8], kp[8], vp[8], dp[8], ap[8];
        unpack8(*(const GAS v4u*)(pc + S_R), rc); unpack8(*(const GAS v4u*)(pc + S_K), kc); unpack8(*(const GAS v4u*)(pc + S_V), vc);
        if (t > 0) { unpack8(*(const GAS v4u*)(pc - SLAB_W + S_R), rp); unpack8(*(const GAS v4u*)(pc - SLAB_W + S_K), kp); unpack8(*(const GAS v4u*)(pc - SLAB_W + S_V), vp); }
        else {
#pragma unroll
            for (int j = 0; j < 8; ++j) { rp[j] = 0.f; kp[j] = 0.f; vp[j] = 0.f; } }
        unpack8(*(const GAS v4u*)(lr + (size_t)m * LRN + c), dp); unpack8(*(const GAS v4u*)(lr + (size_t)m * LRN + 1024 + c), ap);
        float r[8], kt[8], v[8], kk[8], bb[8], w[8], k[8], av[8]; float ss = 0.f;
#pragma unroll
        for (int j = 0; j < 8; ++j) { r[j] = rc[j] + (rp[j] - rc[j]) * mur[j]; k[j] = kc[j] + (kp[j] - kc[j]) * muk[j]; v[j] = vc[j] + (vp[j] - vc[j]) * muv[j];
            w[j] = __expf(-0.6065306597126334f * sigm(w0v[j] + dp[j])); av[j] = sigm(a0v[j] + ap[j]); kk[j] = k[j] * kkv[j]; ss += kk[j] * kk[j]; kt[j] = k[j] * (1.0f + (av[j] - 1.0f) * kav[j]); }
        const float rn = rsqrtf(fmaxf(sum8(ss), 1e-24f));
#pragma unroll
        for (int j = 0; j < 8; ++j) { kk[j] *= rn; bb[j] = kk[j] * av[j]; }
        unsigned char* rec = scanin + ((size_t)(b * 16 + h) * SEQ + t) * SREC;
        *(f32x4*)(rec + sub * 32) = (f32x4){w[0], w[1], w[2], w[3]}; *(f32x4*)(rec + sub * 32 + 16) = (f32x4){w[4], w[5], w[6], w[7]};
        *(v4u*)(rec + 256 + sub * 16) = pack8(r); *(v4u*)(rec + 384 + sub * 16) = pack8(kt); *(v4u*)(rec + 512 + sub * 16) = pack8(v); *(v4u*)(rec + 640 + sub * 16) = pack8(kk); *(v4u*)(rec + 768 + sub * 16) = pack8(bb);
    }
}
template <int RKV_REC> __device__ __forceinline__ void rwkv_post(const float* ys, const unsigned char* scanin, const bf16* lr_, const float* r_k, const float* gn_w, const float* gn_b, bf16* rw, int tid, int G) {
    const GAS bf16* lr = (const GAS bf16*)lr_;
    const int gt = blockIdx.x * 512 + tid, NGT = G * 512;
    const int c8 = gt & 127, c = 8 * c8, h = c8 >> 3, sub = c8 & 7;
    float rkv[8], gw[8], gb[8];
    load8f(r_k + c, rkv); load8f(gn_w + c, gw); load8f(gn_b + c, gb);
    for (int it = gt; it < T * 128; it += NGT) {
        const int m = it >> 7, b = m >> 13, t = m & (SEQ - 1);
        float y[8]; load8f(ys + (size_t)m * 1024 + c, y);
        float s = 0.f;
#pragma unroll
        for (int j = 0; j < 8; ++j) s += y[j];
        const float mean = sum8(s) * (1.0f / 64.0f); float q = 0.f;
#pragma unroll
        for (int j = 0; j < 8; ++j) { y[j] -= mean; q += y[j] * y[j]; }
        const float rstd = rsqrtf(sum8(q) * (1.0f / 64.0f) + GN_EPS);
        const unsigned char* rec = scanin + ((size_t)(b * 16 + h) * SEQ + t) * RKV_REC;
        float r[8], kt[8], v[8], g[8];
        unpack8(*(const v4u*)(rec + sub * 16), r); unpack8(*(const v4u*)(rec + 128 + sub * 16), kt); unpack8(*(const v4u*)(rec + 256 + sub * 16), v);
        unpack8(*(const GAS v4u*)(lr + (size_t)m * LRN + 2048 + c), g);
        float bs = 0.f;
#pragma unroll
        for (int j = 0; j < 8; ++j) bs += r[j] * kt[j] * rkv[j];
        bs = sum8(bs);
        float o[8];
#pragma unroll
        for (int j = 0; j < 8; ++j) o[j] = (y[j] * rstd * gw[j] + gb[j] + bs * v[j]) * g[j];
        *(v4u*)(rw + (size_t)m * 1024 + c) = pack8(o);
    }
}

#ifndef SEL_CHECK
#define SEL_CHECK 0
#endif
#ifndef PROBE_REPEAT
#define PROBE_REPEAT 0u
#endif
#define SUBREP(k) for (int rep_ = 0; rep_ < 1 + (int)(((PROBE_REPEAT) >> (k)) & 1u); ++rep_)
typedef float f32x2 __attribute__((ext_vector_type(2)));
__device__ __forceinline__ int f2ikey(float f) { const int u = __float_as_int(f); return u ^ ((u >> 31) & 0x7fffffff); }
__device__ __forceinline__ unsigned pk_ge_flags(unsigned xm1x2, unsigned d) {
    unsigned t; asm volatile("v_pk_sub_i16 %0, %1, %2 clamp\n\tv_pk_lshrrev_b16 %0, %3, %0" : "=&v"(t) : "v"(xm1x2), "v"(d), "v"(0x000f000fu)); return t; }
__device__ __forceinline__ unsigned pk_add16(unsigned a, unsigned b) { unsigned r; asm volatile("v_pk_add_u16 %0, %1, %2" : "=v"(r) : "v"(a), "v"(b)); return r; }
__device__ __forceinline__ unsigned wave_sum_pk(unsigned acc) {
    unsigned x = (acc & 0xffffu) + (acc >> 16);
    x += dpp_u<0xB1>(x); x += dpp_u<0x4E>(x); x += dpp_u<0x141>(x); x += dpp_u<0x140>(x);
    return (unsigned)__builtin_amdgcn_readlane((int)x, 0) + (unsigned)__builtin_amdgcn_readlane((int)x, 16) + (unsigned)__builtin_amdgcn_readlane((int)x, 32) + (unsigned)__builtin_amdgcn_readlane((int)x, 48);
}
__device__ __forceinline__ unsigned count_ge16(const LAS unsigned short* hrow, int ng, int x, int lane) {
    const unsigned xm = (unsigned)((x - 1) & 0xffff), xm1x2 = xm | (xm << 16);
    unsigned acc = 0u;
    v4u a = *(const LAS v4u*)(hrow + 8 * lane);
    for (int g = 1; g < ng; ++g) {
        const v4u b = *(const LAS v4u*)(hrow + 512 * g + 8 * lane);
        acc = pk_add16(acc, pk_ge_flags(xm1x2, a.x)); acc = pk_add16(acc, pk_ge_flags(xm1x2, a.y)); acc = pk_add16(acc, pk_ge_flags(xm1x2, a.z)); acc = pk_add16(acc, pk_ge_flags(xm1x2, a.w));
        a = b;
    }
    acc = pk_add16(acc, pk_ge_flags(xm1x2, a.x)); acc = pk_add16(acc, pk_ge_flags(xm1x2, a.y)); acc = pk_add16(acc, pk_ge_flags(xm1x2, a.z)); acc = pk_add16(acc, pk_ge_flags(xm1x2, a.w));
    return wave_sum_pk(acc);
}
__device__ __forceinline__ unsigned wave_scan_u(unsigned x) {
    x += (unsigned)__builtin_amdgcn_update_dpp(0, (int)x, 0x111, 0xf, 0xf, false); x += (unsigned)__builtin_amdgcn_update_dpp(0, (int)x, 0x112, 0xf, 0xf, false);
    x += (unsigned)__builtin_amdgcn_update_dpp(0, (int)x, 0x114, 0xf, 0xf, false); x += (unsigned)__builtin_amdgcn_update_dpp(0, (int)x, 0x118, 0xf, 0xf, false);
    x += (unsigned)__builtin_amdgcn_update_dpp(0, (int)x, 0x142, 0xa, 0xf, false); x += (unsigned)__builtin_amdgcn_update_dpp(0, (int)x, 0x143, 0xc, 0xf, false);
    return x;
}
__device__ __forceinline__ void select_phase(const bf16* proj_, unsigned short* idx, unsigned short* loscr, LAS unsigned char* lds, int tid, int lane, int wave, int G, unsigned* chk) {
    LAS unsigned short* hk = (LAS unsigned short*)lds;
    LAS unsigned short* olist = (LAS unsigned short*)(lds + MISC_OFF + 2048);
    LAS unsigned short* cand = (LAS unsigned short*)(lds + MISC_OFF + 8192);
    const GAS bf16* proj = (const GAS bf16*)proj_;
    GAS unsigned short* lo = (GAS unsigned short*)loscr + (size_t)blockIdx.x * 8 * SEQ;
#define LOIDX_(row, key) ((size_t)(key) * 8 + ((row) & 3) * 2 + ((row) >> 2))
    const int kq = lane >> 4, l15 = lane & 15;
    const bool mirror = ((T / 8) % G == 0);
    for (int u_ = blockIdx.x, rnd = 0; u_ < T / 8; u_ += G, ++rnd) {
        const int u = (mirror && (rnd & 1)) ? (u_ - (int)blockIdx.x) + (G - 1 - (int)blockIdx.x) : u_;
        const int m0 = 8 * u, b = m0 >> 13, t0 = m0 & (SEQ - 1);
        if (t0 < NSEL) {
            for (int r = 0; r < 8; ++r) for (int j = tid; j <= t0 + r; j += 512) idx[(size_t)(m0 + r) * NSEL + j] = (unsigned short)j;
            continue;
        }
        const int tmax = t0 + 7, ntiles = (tmax >> 4) + 1, n16 = ntiles * 16, ng = (n16 + 511) >> 9, npad = ng * 512 - n16;
        for (int i = tid; i < 8 * npad; i += 512) { const int r = i / npad, k = n16 + (i - r * npad); hk[r * SEQ + k] = (unsigned short)0x807f; }
        SUBREP(13) {
        bf16x8 af[2][2][2]; f32x2 w2[2][4];
#pragma unroll
        for (int rs = 0; rs < 2; ++rs) {
#pragma unroll
            for (int ps = 0; ps < 2; ++ps) { const GAS bf16* qrow = proj + O_QI + (size_t)(m0 + 4 * rs + (l15 >> 2)) * 512 + ((l15 & 3) + 4 * ps) * 64 + 16 * kq;
                af[rs][ps][0] = *(const GAS bf16x8*)qrow; af[rs][ps][1] = *(const GAS bf16x8*)(qrow + 8); }
            const v4u w = *(const GAS v4u*)(proj + O_WI + (size_t)(m0 + 4 * rs + kq) * 8);
            w2[rs][0] = (f32x2){bflo(w.x), bfhi(w.x)}; w2[rs][1] = (f32x2){bflo(w.y), bfhi(w.y)}; w2[rs][2] = (f32x2){bflo(w.z), bfhi(w.z)}; w2[rs][3] = (f32x2){bflo(w.w), bfhi(w.w)}; }
        const GAS bf16* kcol = proj + O_KI + (size_t)b * SEQ * 64 + (size_t)l15 * 64 + 16 * kq;
        const int kst2 = 8;
        const int rot = 0;
#define ROT_(x) ({ int r_ = min((x), ntiles - 1) + rot; r_ >= ntiles ? r_ - ntiles : r_; })
        bf16x8 frA[4][2], frB[4][2];
#pragma unroll
        for (int p = 0; p < 4; ++p) { const GAS bf16* kp = kcol + (size_t)(ROT_(wave + 8 * p) * 16) * 64; frA[p][0] = *(const GAS bf16x8*)kp; frA[p][1] = *(const GAS bf16x8*)(kp + kst2); }
        const unsigned lanoff = (unsigned)(kq * SEQ + l15) * 2u;
        const unsigned lanoff32 = (unsigned)(l15 * 16 + kq * 4);
        GAS unsigned char* const lodump = (GAS unsigned char*)loscr + (size_t)(64u << 20);
        unsigned pend[4] = {0u, 0u, 0u, 0u}; int ktp = -1;
#define RELU2_(x, y) (f32x2){__int_as_float(max(__float_as_int(x), 0)), __int_as_float(max(__float_as_int(y), 0))}
#define PENDST_() do { GAS unsigned char* pb_ = ktp < 0 ? lodump : (GAS unsigned char*)lo; const int kb_ = ktp < 0 ? 0 : ktp; \
        _Pragma("unroll") for (int p = 0; p < 4; ++p) { const int ktq = ROT_(kb_ + 8 * p); __builtin_nontemporal_store(pend[p], (GAS unsigned*)(pb_ + ktq * 256 + lanoff32)); } } while (0)
#define TILE4_(CUR, NXT, KT0, FK) do { \
        asm volatile("" : "+v"(CUR[0][0]), "+v"(CUR[0][1]), "+v"(CUR[1][0]), "+v"(CUR[1][1]), "+v"(CUR[2][0]), "+v"(CUR[2][1]), "+v"(CUR[3][0]), "+v"(CUR[3][1]) :: "memory"); \
        _Pragma("unroll") for (int p = 0; p < 4; ++p) { const GAS bf16* kp = kcol + (size_t)((((FK) & 2) ? 0 : ROT_((KT0) + 8 * p + 32)) * 16) * 64; NXT[p][0] = *(const GAS bf16x8*)kp; NXT[p][1] = *(const GAS bf16x8*)(kp + kst2); } \
        if (!((FK) & 8)) PENDST_(); \
        __builtin_amdgcn_sched_barrier(0); \
        asm volatile("" : "+v"(CUR[0][0]), "+v"(CUR[0][1]), "+v"(CUR[1][0]), "+v"(CUR[1][1]), "+v"(CUR[2][0]), "+v"(CUR[2][1]), "+v"(CUR[3][0]), "+v"(CUR[3][1])); \
        _Pragma("unroll") for (int p = 0; p < 4; ++p) { \
            const int kt = ROT_((KT0) + 8 * p); \
            const bf16x8 c0 = CUR[p][0], c1 = CUR[p][1]; \
            const bool lastt = (kt == ntiles - 1); \
            f32x4 a0[2], a1[2]; \
            _Pragma("unroll") for (int rs = 0; rs < 2; ++rs) { \
                a0[rs] = (f32x4){0.f, 0.f, 0.f, 0.f}; a1[rs] = (f32x4){0.f, 0.f, 0.f, 0.f}; \
                if ((FK) & 1) { a0[rs] = __builtin_bit_cast(f32x4, c0); a1[rs] = __builtin_bit_cast(f32x4, c1); } else { \
                a0[rs] = __builtin_amdgcn_mfma_f32_16x16x32_bf16(af[rs][0][0], c0, a0[rs], 0, 0, 0); a1[rs] = __builtin_amdgcn_mfma_f32_16x16x32_bf16(af[rs][1][0], c0, a1[rs], 0, 0, 0); \
                a0[rs] = __builtin_amdgcn_mfma_f32_16x16x32_bf16(af[rs][0][1], c1, a0[rs], 0, 0, 0); a1[rs] = __builtin_amdgcn_mfma_f32_16x16x32_bf16(af[rs][1][1], c1, a1[rs], 0, 0, 0); } } \
            LAS unsigned char* hkt = (LAS unsigned char*)hk + kt * 32 + lanoff; \
            int ikk[2]; \
            _Pragma("unroll") for (int rs = 0; rs < 2; ++rs) { \
                f32x2 acc = {0.f, 0.f}; \
                acc += RELU2_(a0[rs][0], a0[rs][1]) * w2[rs][0]; acc += RELU2_(a0[rs][2], a0[rs][3]) * w2[rs][1]; acc += RELU2_(a1[rs][0], a1[rs][1]) * w2[rs][2]; acc += RELU2_(a1[rs][2], a1[rs][3]) * w2[rs][3]; \
                float sc = acc[0] + acc[1]; \
                if (lastt) { if (kt * 16 + l15 > t0 + 4 * rs + kq) sc = -INFINITY; } \
                const int ik = f2ikey(sc); \
                if (!((FK) & 4)) *(LAS unsigned short*)(hkt + rs * 8 * SEQ) = (unsigned short)((unsigned)ik >> 16); ikk[rs] = ik; } \
            pend[p] = ((unsigned)ikk[0] & 0xffffu) | ((unsigned)ikk[1] << 16); } \
        ktp = (KT0); } while (0)
#ifdef SWEEP_FAKE
        if (rep_ == 0) {
        const int ntf_ = (SWEEP_FAKE & 16) ? (ntiles >> 1) : ntiles;
        for (int kt0 = wave; kt0 < ntf_; kt0 += 64) {
            TILE4_(frA, frB, kt0, SWEEP_FAKE);
            if (kt0 + 32 >= ntf_) break;
            TILE4_(frB, frA, kt0 + 32, SWEEP_FAKE);
        }
        } else
#endif
        for (int kt0 = wave; kt0 < ntiles; kt0 += 64) {
            TILE4_(frA, frB, kt0, 0);
            if (kt0 + 32 >= ntiles) break;
            TILE4_(frB, frA, kt0 + 32, 0);
        }
        if (ktp >= 0) PENDST_();
#undef TILE4_
#undef ROT_
#undef PENDST_
#undef RELU2_
        }
        asm volatile("s_waitcnt vmcnt(0)" ::: "memory");
        __syncthreads();
        {
            const int row = wave, m = m0 + row;
            const LAS unsigned short* hrow = hk + row * SEQ;
            LAS unsigned short* hroww = hk + row * SEQ;
            int thr16 = 0;
            unsigned lifted_idx = 0xffffffffu; int bucket = 0; bool skipchk = false; (void)lifted_idx; (void)bucket; (void)skipchk;
            SUBREP(14) {
            int klo = -32640, khi = 32641; unsigned cnt_hi = 0u, cnt_lo = 0u; bool exact = false;
            while (khi - klo > 1) {
                const int mid = (klo + khi) >> 1;
                const unsigned c = count_ge16(hrow, ng, mid, lane);
                if (c == (unsigned)NSEL) { klo = mid; exact = true; break; }
                if (c > (unsigned)NSEL) { klo = mid; cnt_lo = c; } else { khi = mid; cnt_hi = c; }
            }
            thr16 = klo;
            if (!exact) {
                if (cnt_lo == 0u) cnt_lo = count_ge16(hrow, ng, klo, lane);
                const unsigned need = (unsigned)NSEL - cnt_hi, cb = cnt_lo - cnt_hi;
                const bool small = cb <= 64u;
                bucket = klo; skipchk = !small;
                const unsigned bx = (unsigned)(klo & 0xffff), bxx = bx | (bx << 16);
                const unsigned dumpaddr = (unsigned)(size_t)(cand + row * 72 + 64);
                unsigned base = 0u; asm volatile("" : "+v"(base));
                for (int g = 0; g < ng; ++g) {
                    const v4u kv = *(const LAS v4u*)(hrow + 512 * g + 8 * lane);
                    const unsigned d[4] = {kv.x ^ bxx, kv.y ^ bxx, kv.z ^ bxx, kv.w ^ bxx};
                    unsigned eq[8], ce = 0u;
#pragma unroll
                    for (int q = 0; q < 4; ++q) { const unsigned l0 = d[q] & 0xffffu, h0 = d[q] >> 16; eq[2 * q] = 1u - ((l0 | (0u - l0)) >> 31); eq[2 * q + 1] = 1u - ((h0 | (0u - h0)) >> 31); ce += eq[2 * q] + eq[2 * q + 1]; }
                    const unsigned isc = wave_scan_u(ce);
                    unsigned pos = base + isc - ce;
#pragma unroll
                    for (int e = 0; e < 8; ++e) { const unsigned kidx = (unsigned)(512 * g + 8 * lane + e);
                        if (small) { const unsigned inb = ((unsigned)((int)pos - 64)) >> 31; const unsigned f = eq[e] & inb; const unsigned slot = 64u + f * (pos - 64u); cand[row * 72 + slot] = (unsigned short)kidx; }
                        else { const unsigned inb = ((unsigned)((int)pos - (int)need)) >> 31; const unsigned f = eq[e] & inb; const unsigned tgt = (unsigned)(size_t)(hroww + kidx);
                               *(LAS unsigned short*)(size_t)(dumpaddr + f * (tgt - dumpaddr)) = (unsigned short)(klo + 1); }
                        pos += eq[e]; }
                    base += (unsigned)__builtin_amdgcn_readlane((int)isc, 63);
                }
                LDS_WAIT(); asm volatile("" ::: "memory");
                if (small) {
                    const bool mine = (unsigned)lane < cb;
                    const unsigned myidx = mine ? (unsigned)cand[row * 72 + lane] : 0u;
                    const unsigned mylo = mine ? (unsigned)__hip_atomic_load(lo + LOIDX_(row, myidx), __ATOMIC_RELAXED, __HIP_MEMORY_SCOPE_AGENT) : 0u;
                    unsigned rank = 0u;
                    for (unsigned j = 0; j < cb; ++j) { const unsigned oj = (unsigned)__shfl((int)mylo, (int)j), ij = (unsigned)__shfl((int)myidx, (int)j);
                        rank += (oj > mylo || (oj == mylo && ij < myidx)) ? 1u : 0u; }
                    if (mine && rank < need) { hroww[myidx] = (unsigned short)(klo + 1); lifted_idx = myidx; }
                    LDS_WAIT(); asm volatile("" ::: "memory");
                }
                thr16 = klo + 1;
            }
            }
            SUBREP(15) {
            const unsigned xm = (unsigned)((thr16 - 1) & 0xffff), xm1x2 = xm | (xm << 16);
            unsigned sel_base = 0u; asm volatile("" : "+v"(sel_base));
            LAS unsigned short* ol = olist + row * 264;
            for (int g = 0; g < ng; ++g) {
                const v4u kv = *(const LAS v4u*)(hrow + 512 * g + 8 * lane);
                const unsigned f4[4] = {pk_ge_flags(xm1x2, kv.x), pk_ge_flags(xm1x2, kv.y), pk_ge_flags(xm1x2, kv.z), pk_ge_flags(xm1x2, kv.w)};
                unsigned cs = 0u;
#pragma unroll
                for (int q = 0; q < 4; ++q) cs += (f4[q] & 1u) + (f4[q] >> 16);
                const unsigned iss = wave_scan_u(cs);
                unsigned pos = sel_base + iss - cs;
#pragma unroll
                for (int e = 0; e < 8; ++e) { const unsigned fl = (e & 1) ? (f4[e >> 1] >> 16) : (f4[e >> 1] & 1u); const unsigned inb = ((unsigned)((int)pos - NSEL)) >> 31; const unsigned f = fl & inb;
                    const unsigned slot = 256u + f * (pos - 256u); ol[slot] = (unsigned short)(512 * g + 8 * lane + e); pos += fl; }
                sel_base += (unsigned)__builtin_amdgcn_readlane((int)iss, 63);
            }
            LDS_WAIT(); asm volatile("" ::: "memory");
            if (lane < 32) *(GAS v4u*)((GAS unsigned short*)idx + (size_t)m * NSEL + 8 * lane) = *(const LAS v4u*)(ol + 8 * lane);
#if SEL_CHECK
            {
                if (lifted_idx != 0xffffffffu) hroww[lifted_idx] = (unsigned short)bucket;
                LDS_WAIT(); asm volatile("" ::: "memory");
                unsigned bad = (sel_base != (unsigned)NSEL) ? 1u : 0u; int mn = 0x7fffffff;
                for (int e = 0; e < 4; ++e) { const int j = 4 * lane + e; const int id = (int)ol[j]; const int full = (int)(((unsigned)hrow[id] << 16) | (unsigned)__hip_atomic_load(lo + LOIDX_(row, id), __ATOMIC_RELAXED, __HIP_MEMORY_SCOPE_AGENT));
                    mn = full < mn ? full : mn; if (id > t0 + row) bad = 1u; if (j < 255 && (int)ol[j + 1] <= id) bad = 1u; }
                for (int o = 1; o < 64; o <<= 1) { const int v = __shfl_xor(mn, o); mn = v < mn ? v : mn; }
                unsigned cgt = 0u, cge = 0u;
                for (int j = lane; j < n16; j += 64) { const int full = (int)(((unsigned)hrow[j] << 16) | (unsigned)__hip_atomic_load(lo + LOIDX_(row, j), __ATOMIC_RELAXED, __HIP_MEMORY_SCOPE_AGENT)); cgt += (full > mn) ? 1u : 0u; cge += (full >= mn) ? 1u : 0u; }
                for (int o = 1; o < 64; o <<= 1) { cgt += __shfl_xor(cgt, o); cge += __shfl_xor(cge, o); }
                if (!skipchk && (cgt > 255u || cge < 256u)) bad = 1u;
                if (__ballot(bad != 0u) != 0ull && lane == 0) atomicAdd(chk + 34, 1u);
                if (lane == 0) { atomicAdd(chk + 35, 1u); if (skipchk) atomicAdd(chk + 36, 1u); }
            }
#endif
            }
        }
        __syncthreads();
    }
}

__device__ __forceinline__ void attn_phase_ref(const bf16* proj, const unsigned short* idx, const float* rel_bias, bf16* att, LAS unsigned char* lds, int tid, int lane, int wave, int G) {
    LAS float* btab = (LAS float*)(lds + BIAS_OFF);
    for (int i = tid; i < 129 * 8; i += 512) { const int d = i >> 3, hh = i & 7; const int bk = d < 113 ? (int)REL_BUCKET_TAB[d] : 31; btab[i] = rel_bias[bk * 8 + hh]; }
    __syncthreads();
    LAS unsigned char* base = lds + wave * 8192;
    LAS float* qf = (LAS float*)base;
    LAS f32x4* pl = (LAS f32x4*)(base + 2048);
    LAS unsigned short* il = (LAS unsigned short*)(base + 6144);
    const int gw = blockIdx.x * 8 + wave, NGW = G * 8;
    const float scale = 0.08838834764831845f;
    for (int item = gw; item < 2 * T; item += NGW) {
        const int m = item >> 1, c = item & 1, b = m >> 13, t = m & (SEQ - 1), nsel = (t + 1 < NSEL) ? t + 1 : NSEL;
        { const v4u qv = *(const v4u*)(proj + O_Q + (size_t)m * 1024 + c * 512 + 8 * lane);
          f32x4 q0 = {bflo(qv.x), bfhi(qv.x), bflo(qv.y), bfhi(qv.y)}, q1 = {bflo(qv.z), bfhi(qv.z), bflo(qv.w), bfhi(qv.w)};
          *(LAS f32x4*)(qf + 8 * lane) = q0; *(LAS f32x4*)(qf + 8 * lane + 4) = q1; }
        int id[4];
#pragma unroll
        for (int i2 = 0; i2 < 4; ++i2) { const int j = lane + 64 * i2; id[i2] = (j < nsel) ? (int)idx[(size_t)m * NSEL + j] : 0; il[j] = (unsigned short)id[i2]; }
        LDS_WAIT(); asm volatile("" ::: "memory");
        float lg[4][4];
#pragma unroll
        for (int i2 = 0; i2 < 4; ++i2)
#pragma unroll
            for (int g = 0; g < 4; ++g) lg[i2][g] = 0.f;
        const bf16* kbase = proj + O_K + (size_t)(b * 2 + c) * SEQ * 128;
#pragma unroll 2
        for (int dc = 0; dc < 16; ++dc) {
            v4u kv[4];
#pragma unroll
            for (int i2 = 0; i2 < 4; ++i2) kv[i2] = *(const v4u*)(kbase + (size_t)id[i2] * 128 + 8 * dc);
            f32x4 qa[4][2];
#pragma unroll
            for (int g = 0; g < 4; ++g) { qa[g][0] = *(const LAS f32x4*)(qf + g * 128 + 8 * dc); qa[g][1] = *(const LAS f32x4*)(qf + g * 128 + 8 * dc + 4); }
#pragma unroll
            for (int i2 = 0; i2 < 4; ++i2) { const float k0 = bflo(kv[i2].x), k1 = bfhi(kv[i2].x), k2 = bflo(kv[i2].y), k3 = bfhi(kv[i2].y), k4 = bflo(kv[i2].z), k5 = bfhi(kv[i2].z), k6 = bflo(kv[i2].w), k7 = bfhi(kv[i2].w);
#pragma unroll
                for (int g = 0; g < 4; ++g) lg[i2][g] += (qa[g][0][0] * k0 + qa[g][0][1] * k1) + (qa[g][0][2] * k2 + qa[g][0][3] * k3) + (qa[g][1][0] * k4 + qa[g][1][1] * k5) + (qa[g][1][2] * k6 + qa[g][1][3] * k7); }
        }
#pragma unroll
        for (int i2 = 0; i2 < 4; ++i2) { const int j = lane + 64 * i2; int dist = t - id[i2]; dist = dist > 128 ? 128 : dist;
#pragma unroll
            for (int g = 0; g < 4; ++g) { const float l = lg[i2][g] * scale + btab[dist * 8 + 4 * c + g]; lg[i2][g] = (j < nsel) ? l : -INFINITY; } }
#pragma unroll
        for (int g = 0; g < 4; ++g) {
            const float mx = wave_max(fmaxf(fmaxf(lg[0][g], lg[1][g]), fmaxf(lg[2][g], lg[3][g])));
            float e0 = __expf(lg[0][g] - mx), e1 = __expf(lg[1][g] - mx), e2 = __expf(lg[2][g] - mx), e3 = __expf(lg[3][g] - mx);
            const float inv = 1.0f / wave_sum((e0 + e1) + (e2 + e3));
            lg[0][g] = e0 * inv; lg[1][g] = e1 * inv; lg[2][g] = e2 * inv; lg[3][g] = e3 * inv;
        }
#pragma unroll
        for (int i2 = 0; i2 < 4; ++i2) { const f32x4 pv = {lg[i2][0], lg[i2][1], lg[i2][2], lg[i2][3]}; pl[lane + 64 * i2] = pv; }
        LDS_WAIT(); asm volatile("" ::: "memory");
        float o[4][2];
#pragma unroll
        for (int g = 0; g < 4; ++g) { o[g][0] = 0.f; o[g][1] = 0.f; }
        const bf16* vbase = proj + O_V + (size_t)(b * 2 + c) * SEQ * 128 + 2 * lane;
        for (int j0 = 0; j0 < NSEL; j0 += 8) {
            const v4u iv = *(const LAS v4u*)(il + j0);
            const int ids[8] = {(int)(iv.x & 0xffffu), (int)(iv.x >> 16), (int)(iv.y & 0xffffu), (int)(iv.y >> 16), (int)(iv.z & 0xffffu), (int)(iv.z >> 16), (int)(iv.w & 0xffffu), (int)(iv.w >> 16)};
            unsigned vv[8];
#pragma unroll
            for (int q = 0; q < 8; ++q) vv[q] = *(const unsigned*)(vbase + (size_t)ids[q] * 128);
#pragma unroll
            for (int q = 0; q < 8; ++q) { const f32x4 pj = pl[j0 + q]; const float v0 = bflo(vv[q]), v1 = bfhi(vv[q]);
#pragma unroll
                for (int g = 0; g < 4; ++g) { o[g][0] += pj[g] * v0; o[g][1] += pj[g] * v1; } }
        }
#pragma unroll
        for (int g = 0; g < 4; ++g) *(unsigned*)(att + (size_t)m * 1024 + (4 * c + g) * 128 + 2 * lane) = cvt_pk_bf16(o[g][0], o[g][1]);
        LDS_WAIT(); asm volatile("" ::: "memory");
    }
}

template <int CTRL> __device__ __forceinline__ float dpp_max(float x) { return fmaxf(x, dpp_f<CTRL>(x)); }
__device__ __forceinline__ float max16(float x) { x = dpp_max<0xB1>(x); x = dpp_max<0x4E>(x); x = dpp_max<0x141>(x); x = dpp_max<0x140>(x); return x; }
__device__ __forceinline__ void attn_phase(const bf16* proj, const unsigned short* idx, const float* rel_bias, bf16* att, LAS unsigned char* lds, int tid, int lane, int wave, int G, unsigned* queue) {
    LAS float* btab = (LAS float*)(lds + BIAS_OFF);
    for (int i = tid; i < 129 * 8; i += 512) { const int d = i >> 3, hh = i & 7; const int bk = d < 113 ? (int)REL_BUCKET_TAB[d] : 31; btab[i] = rel_bias[bk * 8 + hh]; }
    __syncthreads();
    LAS unsigned char* base = lds + wave * 8192;
    LAS unsigned char* p8 = base;
    LAS unsigned short* il = (LAS unsigned short*)(base + 4352);
    const int gq = lane >> 4, dl = lane & 15;
    const float scale = 0.08838834764831845f * (1.0f / 64.0f);
    const bool xmode = (G % 64 == 0);
    const int xcd = blockIdx.x & 7;
    const int gw = blockIdx.x * 8 + wave, NGW = G * 8;
    unsigned zoff = 0u; asm volatile("" : "+v"(zoff));
    constexpr int QG = 4;
    const int qsub = (xcd & 1) * QG + ((blockIdx.x >> 3) & (QG - 1));
    unsigned* qw = queue + (xcd * QG + ((blockIdx.x >> 3) & (QG - 1))) * 32 + zoff;
    unsigned ticket = 0u;
    int it = 0, m = -1, c = 0;
    if (xmode) { if (lane == 0) ticket = __hip_atomic_fetch_add(qw, 1u, __ATOMIC_RELAXED, __HIP_MEMORY_SCOPE_AGENT);
        const int t_ = __builtin_amdgcn_readfirstlane((int)ticket); if (t_ < SEQ / (2 * QG)) { m = (xcd >> 2) * SEQ + 2 * QG * t_ + qsub; c = (xcd >> 1) & 1; }
        if (lane == 0) ticket = __hip_atomic_fetch_add(qw, 1u, __ATOMIC_RELAXED, __HIP_MEMORY_SCOPE_AGENT); }
    else { if (gw < 2 * T) { m = gw >> 1; c = gw & 1; } }
    v4u ix0 = {0u, 0u, 0u, 0u}, ix1 = ix0;
    if (m >= 0) { const GAS v4u* ip = (const GAS v4u*)((const GAS unsigned short*)idx + (size_t)m * NSEL + 16 * dl); ix0 = __builtin_nontemporal_load(ip); ix1 = __builtin_nontemporal_load(ip + 1); }
    while (m >= 0) {
        const int b = m >> 13, t = m & (SEQ - 1), nsel = (t + 1 < NSEL) ? t + 1 : NSEL;
        v4u qv[4];
        { const GAS bf16* qp = (const GAS bf16*)proj + O_Q + (size_t)m * 1024 + (4 * c + (dl & 3)) * 128 + 32 * gq;
#pragma unroll
          for (int ks = 0; ks < 4; ++ks) qv[ks] = __builtin_nontemporal_load((const GAS v4u*)(qp + 8 * ks)); }
        int ids[16];
        { const unsigned wv_[8] = {ix0.x, ix0.y, ix0.z, ix0.w, ix1.x, ix1.y, ix1.z, ix1.w};
#pragma unroll
          for (int q = 0; q < 8; ++q) { ids[2 * q] = (16 * dl + 2 * q < nsel) ? (int)(wv_[q] & 0xffffu) : 0; ids[2 * q + 1] = (16 * dl + 2 * q + 1 < nsel) ? (int)(wv_[q] >> 16) : 0; } }
        const GAS unsigned char* kbase = (const GAS unsigned char*)proj + O_K * 2 + (size_t)(b * 2 + c) * SEQ * 128 + 32 * gq;
        v4u kb[16][2];
#pragma unroll
        for (int q = 0; q < 16; ++q) { const GAS v4u* kp = (const GAS v4u*)(kbase + (size_t)ids[q] * 128); kb[q][0] = kp[0]; kb[q][1] = kp[1]; }
        if (gq == 0) { v4u o0, o1;
            o0.x = (unsigned)ids[0] | ((unsigned)ids[1] << 16); o0.y = (unsigned)ids[2] | ((unsigned)ids[3] << 16); o0.z = (unsigned)ids[4] | ((unsigned)ids[5] << 16); o0.w = (unsigned)ids[6] | ((unsigned)ids[7] << 16);
            o1.x = (unsigned)ids[8] | ((unsigned)ids[9] << 16); o1.y = (unsigned)ids[10] | ((unsigned)ids[11] << 16); o1.z = (unsigned)ids[12] | ((unsigned)ids[13] << 16); o1.w = (unsigned)ids[14] | ((unsigned)ids[15] << 16);
            *(LAS v4u*)(il + 16 * dl) = o0; *(LAS v4u*)(il + 16 * dl + 8) = o1; }
        __builtin_amdgcn_sched_barrier(0);
        long qa[4];
#pragma unroll
        for (int ks = 0; ks < 4; ++ks) { const v4u v = qv[ks];
            const unsigned lo8 = pg8::pk_fp8x4(bflo(v.x) * 8.0f, bfhi(v.x) * 8.0f, bflo(v.y) * 8.0f, bfhi(v.y) * 8.0f), hi8 = pg8::pk_fp8x4(bflo(v.z) * 8.0f, bfhi(v.z) * 8.0f, bflo(v.w) * 8.0f, bfhi(v.w) * 8.0f);
            qa[ks] = (dl < 4) ? (long)(((unsigned long long)hi8 << 32) | lo8) : 0l; }
        f32x4 lg[16];
#pragma unroll
        for (int q = 0; q < 8; ++q) { f32x4 acc = {0.f, 0.f, 0.f, 0.f};
            const long k0 = (long)(((unsigned long long)kb[q][0].y << 32) | kb[q][0].x), k1 = (long)(((unsigned long long)kb[q][0].w << 32) | kb[q][0].z), k2 = (long)(((unsigned long long)kb[q][1].y << 32) | kb[q][1].x), k3 = (long)(((unsigned long long)kb[q][1].w << 32) | kb[q][1].z);
            acc = __builtin_amdgcn_mfma_f32_16x16x32_fp8_fp8(qa[0], k0, acc, 0, 0, 0); acc = __builtin_amdgcn_mfma_f32_16x16x32_fp8_fp8(qa[1], k1, acc, 0, 0, 0);
            acc = __builtin_amdgcn_mfma_f32_16x16x32_fp8_fp8(qa[2], k2, acc, 0, 0, 0); acc = __builtin_amdgcn_mfma_f32_16x16x32_fp8_fp8(qa[3], k3, acc, 0, 0, 0);
            lg[q] = acc; }
        __builtin_amdgcn_sched_barrier(0);
#pragma unroll
        for (int q = 8; q < 16; ++q) { f32x4 acc = {0.f, 0.f, 0.f, 0.f};
            const long k0 = (long)(((unsigned long long)kb[q][0].y << 32) | kb[q][0].x), k1 = (long)(((unsigned long long)kb[q][0].w << 32) | kb[q][0].z), k2 = (long)(((unsigned long long)kb[q][1].y << 32) | kb[q][1].x), k3 = (long)(((unsigned long long)kb[q][1].w << 32) | kb[q][1].z);
            acc = __builtin_amdgcn_mfma_f32_16x16x32_fp8_fp8(qa[0], k0, acc, 0, 0, 0); acc = __builtin_amdgcn_mfma_f32_16x16x32_fp8_fp8(qa[1], k1, acc, 0, 0, 0);
            acc = __builtin_amdgcn_mfma_f32_16x16x32_fp8_fp8(qa[2], k2, acc, 0, 0, 0); acc = __builtin_amdgcn_mfma_f32_16x16x32_fp8_fp8(qa[3], k3, acc, 0, 0, 0);
            lg[q] = acc; }
        __builtin_amdgcn_sched_barrier(0);
        LDS_WAIT(); asm volatile("" ::: "memory");
        const GAS unsigned char* vbase = (const GAS unsigned char*)proj + O_V * 2 + (size_t)(b * 2 + c) * SEQ * 128 + 8 * dl;
        v2u va[32], vb[32];
        { v4u iq[4];
#pragma unroll
          for (int k = 0; k < 4; ++k) iq[k] = *(const LAS v4u*)(il + 32 * k + 8 * gq);
#pragma unroll
          for (int q = 0; q < 32; ++q) { const unsigned wd = ((q >> 1) & 3) == 0 ? iq[q >> 3].x : ((q >> 1) & 3) == 1 ? iq[q >> 3].y : ((q >> 1) & 3) == 2 ? iq[q >> 3].z : iq[q >> 3].w;
              const unsigned w = (q & 1) ? (wd >> 16) : (wd & 0xffffu);
              va[q] = *(const GAS v2u*)(vbase + (size_t)w * 128); } }
        __builtin_amdgcn_sched_barrier(0);
        float mx[4] = {-INFINITY, -INFINITY, -INFINITY, -INFINITY};
#pragma unroll
        for (int tau = 0; tau < 16; ++tau) { int dist = t - ids[tau]; dist = dist > 128 ? 128 : dist; const bool ok = (16 * dl + tau) < nsel;
            const f32x4 bv = *(const LAS f32x4*)(btab + dist * 8 + 4 * c);
#pragma unroll
            for (int g = 0; g < 4; ++g) { const float l = ok ? (lg[tau][g] * scale + bv[g]) : -INFINITY; lg[tau][g] = l; mx[g] = fmaxf(mx[g], l); } }
        float sm[4];
#pragma unroll
        for (int g = 0; g < 4; ++g) { mx[g] = max16(mx[g]); sm[g] = 0.f; }
#pragma unroll
        for (int tau = 0; tau < 16; ++tau)
#pragma unroll
            for (int g = 0; g < 4; ++g) { const float e = __expf(lg[tau][g] - mx[g] + 5.545177444f); lg[tau][g] = e; sm[g] += e; }
#pragma unroll
        for (int g = 0; g < 4; ++g) sm[g] = 0.125f / sum16(sm[g]);
        if (gq == 0) {
#pragma unroll
            for (int g = 0; g < 4; ++g) { v4u hi4, lo4;
#pragma unroll
                for (int w = 0; w < 4; ++w) { const float e0 = lg[4 * w][g], e1 = lg[4 * w + 1][g], e2 = lg[4 * w + 2][g], e3 = lg[4 * w + 3][g];
                    const unsigned h = pg8::pk_fp8x4(e0, e1, e2, e3);
                    const f32x2 b01 = __builtin_amdgcn_cvt_pk_f32_fp8((int)h, false), b23 = __builtin_amdgcn_cvt_pk_f32_fp8((int)h, true);
                    const unsigned lw = pg8::pk_fp8x4(e0 - b01[0], e1 - b01[1], e2 - b23[0], e3 - b23[1]);
                    if (w == 0) { hi4.x = h; lo4.x = lw; } else if (w == 1) { hi4.y = h; lo4.y = lw; } else if (w == 2) { hi4.z = h; lo4.z = lw; } else { hi4.w = h; lo4.w = lw; } }
                *(LAS v4u*)(p8 + g * 272 + 16 * dl) = hi4; *(LAS v4u*)(p8 + 1088 + g * 272 + 16 * dl) = lo4; }
        }
        __builtin_amdgcn_sched_barrier(0);
        const int m_cur = m, c_cur = c;
        { int mn = -1, cn = 0; ++it;
          if (xmode) { const int t_ = __builtin_amdgcn_readfirstlane((int)ticket); if (t_ < SEQ / (2 * QG)) { mn = (xcd >> 2) * SEQ + 2 * QG * t_ + qsub; cn = (xcd >> 1) & 1; } }
          else { const int item = gw + it * NGW; if (item < 2 * T) { mn = item >> 1; cn = item & 1; } }
          m = mn; c = cn;
          if (m >= 0) { const GAS v4u* ip = (const GAS v4u*)((const GAS unsigned short*)idx + (size_t)m * NSEL + 16 * dl); ix0 = __builtin_nontemporal_load(ip); ix1 = __builtin_nontemporal_load(ip + 1); } }
        { v4u iq[4];
#pragma unroll
          for (int k = 0; k < 4; ++k) iq[k] = *(const LAS v4u*)(il + 128 + 32 * k + 8 * gq);
#pragma unroll
          for (int q = 0; q < 32; ++q) { const unsigned wd = ((q >> 1) & 3) == 0 ? iq[q >> 3].x : ((q >> 1) & 3) == 1 ? iq[q >> 3].y : ((q >> 1) & 3) == 2 ? iq[q >> 3].z : iq[q >> 3].w;
              const unsigned w = (q & 1) ? (wd >> 16) : (wd & 0xffffu);
              vb[q] = *(const GAS v2u*)(vbase + (size_t)w * 128); } }
        if (xmode && m >= 0 && lane == 0) ticket = __hip_atomic_fetch_add(qw, 1u, __ATOMIC_RELAXED, __HIP_MEMORY_SCOPE_AGENT);
        LDS_WAIT(); asm volatile("" ::: "memory");
        __builtin_amdgcn_sched_barrier(0);
        f32x4 acc[8];
#pragma unroll
        for (int ch = 0; ch < 8; ++ch) acc[ch] = (f32x4){0.f, 0.f, 0.f, 0.f};
        const LAS unsigned char* pa = p8 + (dl & 3) * 272 + 8 * gq;
#define PERM_(hi_, lo_, sel_) __builtin_amdgcn_perm((hi_), (lo_), (sel_))
#define PVBLK_(R, blk) do { \
            const long ahi = *(const LAS long*)(pa + 32 * (blk)), alo = *(const LAS long*)(pa + 1088 + 32 * (blk)); \
            _Pragma("unroll") for (int hf = 0; hf < 2; ++hf) { \
                const unsigned r0 = hf ? R[0].y : R[0].x, r1 = hf ? R[1].y : R[1].x, r2 = hf ? R[2].y : R[2].x, r3 = hf ? R[3].y : R[3].x, r4 = hf ? R[4].y : R[4].x, r5 = hf ? R[5].y : R[5].x, r6 = hf ? R[6].y : R[6].x, r7 = hf ? R[7].y : R[7].x; \
                const unsigned a0 = PERM_(r1, r0, 0x05010400u), a1 = PERM_(r1, r0, 0x07030602u), b0 = PERM_(r3, r2, 0x05010400u), b1 = PERM_(r3, r2, 0x07030602u); \
                const unsigned c0 = PERM_(r5, r4, 0x05010400u), c1 = PERM_(r5, r4, 0x07030602u), d0 = PERM_(r7, r6, 0x05010400u), d1 = PERM_(r7, r6, 0x07030602u); \
                const unsigned t0 = PERM_(b0, a0, 0x05040100u), t1 = PERM_(b0, a0, 0x07060302u), t2 = PERM_(b1, a1, 0x05040100u), t3 = PERM_(b1, a1, 0x07060302u); \
                const unsigned u0 = PERM_(d0, c0, 0x05040100u), u1 = PERM_(d0, c0, 0x07060302u), u2 = PERM_(d1, c1, 0x05040100u), u3 = PERM_(d1, c1, 0x07060302u); \
                const long bq0 = (long)(((unsigned long long)u0 << 32) | t0), bq1 = (long)(((unsigned long long)u1 << 32) | t1), bq2 = (long)(((unsigned long long)u2 << 32) | t2), bq3 = (long)(((unsigned long long)u3 << 32) | t3); \
                acc[4 * hf + 0] = __builtin_amdgcn_mfma_f32_16x16x32_fp8_fp8(ahi, bq0, acc[4 * hf + 0], 0, 0, 0); acc[4 * hf + 1] = __builtin_amdgcn_mfma_f32_16x16x32_fp8_fp8(ahi, bq1, acc[4 * hf + 1], 0, 0, 0); \
                acc[4 * hf + 2] = __builtin_amdgcn_mfma_f32_16x16x32_fp8_fp8(ahi, bq2, acc[4 * hf + 2], 0, 0, 0); acc[4 * hf + 3] = __builtin_amdgcn_mfma_f32_16x16x32_fp8_fp8(ahi, bq3, acc[4 * hf + 3], 0, 0, 0); \
                acc[4 * hf + 0] = __builtin_amdgcn_mfma_f32_16x16x32_fp8_fp8(alo, bq0, acc[4 * hf + 0], 0, 0, 0); acc[4 * hf + 1] = __builtin_amdgcn_mfma_f32_16x16x32_fp8_fp8(alo, bq1, acc[4 * hf + 1], 0, 0, 0); \
                acc[4 * hf + 2] = __builtin_amdgcn_mfma_f32_16x16x32_fp8_fp8(alo, bq2, acc[4 * hf + 2], 0, 0, 0); acc[4 * hf + 3] = __builtin_amdgcn_mfma_f32_16x16x32_fp8_fp8(alo, bq3, acc[4 * hf + 3], 0, 0, 0); } } while (0)
#pragma unroll
        for (int k = 0; k < 4; ++k) { const v2u* R = va + 8 * k; PVBLK_(R, k); }
        __builtin_amdgcn_sched_barrier(0);
#pragma unroll
        for (int k = 0; k < 4; ++k) { const v2u* R = vb + 8 * k; PVBLK_(R, 4 + k); }
#undef PVBLK_
#undef PERM_
        if (gq == 0) {
#pragma unroll
            for (int g = 0; g < 4; ++g) { const float sg = sm[g]; v4u w;
                w.x = cvt_pk_bf16(acc[0][g] * sg, acc[1][g] * sg); w.y = cvt_pk_bf16(acc[2][g] * sg, acc[3][g] * sg); w.z = cvt_pk_bf16(acc[4][g] * sg, acc[5][g] * sg); w.w = cvt_pk_bf16(acc[6][g] * sg, acc[7][g] * sg);
                __builtin_nontemporal_store(w, (GAS v4u*)((GAS bf16*)att + (size_t)m_cur * 1024 + (4 * c_cur + g) * 128 + 8 * dl)); }
        }
        LDS_WAIT(); asm volatile("" ::: "memory");
        __builtin_amdgcn_sched_barrier(0);
    }
}

constexpr int SCH = 64, SCH_BYTES = SCH * SREC;
__device__ __forceinline__ void scan_phase(const unsigned char* scanin, float* ys, LAS unsigned char* lds, int tid, int lane, int wave, int G, int nunits) {
    for (int u = blockIdx.x; u < nunits; u += G) {
        const int bh = u >> 2, qtr = u & 3, b = bh >> 4, h = bh & 15;
        const unsigned char* src = scanin + (size_t)bh * SEQ * SREC;
        const int row = qtr * 16 + wave * 4 + (lane >> 4), k4 = (lane & 15) * 4;
        float S0 = 0.f, S1 = 0.f, S2 = 0.f, S3 = 0.f;
        v4u pre[7];
#pragma unroll
        for (int i = 0; i < 7; ++i) pre[i] = *(const v4u*)(src + (size_t)(i * 512 + tid) * 16);
#pragma unroll
        for (int i = 0; i < 7; ++i) *(LAS v4u*)(lds + (size_t)(i * 512 + tid) * 16) = pre[i];
        __syncthreads();
        for (int ck = 0; ck < SEQ / SCH; ++ck) {
            const LAS unsigned char* buf = lds + (ck & 1) * SCH_BYTES;
            if (ck + 1 < SEQ / SCH) {
#pragma unroll
                for (int i = 0; i < 7; ++i) pre[i] = *(const v4u*)(src + (size_t)(ck + 1) * SCH_BYTES + (size_t)(i * 512 + tid) * 16);
            }
            if (wave < 4) {
                float* yo = ys + ((size_t)(b * SEQ + ck * SCH)) * 1024 + h * 64 + row;
                for (int t = 0; t < SCH; ++t) {
                    const LAS unsigned char* sb = buf + t * SREC;
                    const f32x4 w = *(const LAS f32x4*)(sb + k4 * 4);
                    const v2u r2 = *(const LAS v2u*)(sb + 256 + k4 * 2), kt2 = *(const LAS v2u*)(sb + 384 + k4 * 2), kk2 = *(const LAS v2u*)(sb + 640 + k4 * 2), bb2 = *(const LAS v2u*)(sb + 768 + k4 * 2);
                    const float v = bf2f(*(const LAS unsigned short*)(sb + 512 + row * 2));
                    const float p = (S0 * bflo(kk2.x) + S1 * bfhi(kk2.x)) + (S2 * bflo(kk2.y) + S3 * bfhi(kk2.y));
                    const float sk = sum16(p);
                    S0 = S0 * w[0] + (v * bflo(kt2.x) - sk * bflo(bb2.x));
                    S1 = S1 * w[1] + (v * bfhi(kt2.x) - sk * bfhi(bb2.x));
                    S2 = S2 * w[2] + (v * bflo(kt2.y) - sk * bflo(bb2.y));
                    S3 = S3 * w[3] + (v * bfhi(kt2.y) - sk * bfhi(bb2.y));
                    const float yq = (S0 * bflo(r2.x) + S1 * bfhi(r2.x)) + (S2 * bflo(r2.y) + S3 * bfhi(r2.y));
                    const float y = sum16(yq);
                    if ((lane & 15) == 0) yo[(size_t)t * 1024] = y;
                }
            }
            if (ck + 1 < SEQ / SCH) {
                LAS unsigned char* nb = lds + ((ck + 1) & 1) * SCH_BYTES;
#pragma unroll
                for (int i = 0; i < 7; ++i) *(LAS v4u*)(nb + (size_t)(i * 512 + tid) * 16) = pre[i];
            }
            __syncthreads();
        }
    }
}

#ifndef PROBE_REPEAT
#define PROBE_REPEAT 0u
#endif
#define SREP(k) for (int rep_ = 0; rep_ < 1 + (int)(((PROBE_REPEAT) >> (k)) & 1u); ++rep_)
constexpr int CB_BYTES = 49152;
constexpr int MP = 144;
__device__ __forceinline__ int kperm(int k) { return (k & ~15) + 8 * ((k >> 2) & 1) + 4 * ((k >> 3) & 1) + (k & 3); }
__device__ __forceinline__ f32x16 mfma4(const LAS unsigned char* A, const LAS unsigned char* B, int lane, f32x16 acc) {
    const int off = (lane & 31) * MP + (lane >> 5) * 16;
#pragma unroll
    for (int ks = 0; ks < 4; ++ks) acc = __builtin_amdgcn_mfma_f32_32x32x16_bf16(*(const LAS bf16x8*)(A + off + ks * 32), *(const LAS bf16x8*)(B + off + ks * 32), acc, 0, 0, 0);
    return acc;
}
__device__ __forceinline__ void nfma(float& s, float a, float b) { asm volatile("v_fma_f32 %0, -%1, %2, %0" : "+v"(s) : "v"(a), "v"(b)); }
struct RwkvPar { const float* mu; const float* w0; const float* a0; const float* k_k; const float* k_a; };
__device__ __forceinline__ void scan_a_phase(const bf16* proj_, const bf16* lr_, const RwkvPar par, unsigned char* rkv, unsigned char* chk, LAS unsigned char* lds_in, int tid, int lane, int wave, int G) {
    const GAS bf16* proj = (const GAS bf16*)proj_; const GAS bf16* lr = (const GAS bf16*)lr_;
    const int hi = lane >> 5, r32 = lane & 31;
    for (int u = blockIdx.x; u < 32 * 128; u += G) {
        LAS unsigned char* lds_u = lds_in; asm volatile("" : "+s"(lds_u));
        LAS unsigned char* const lds = lds_u;
        LAS unsigned char* GB = lds;
        LAS unsigned char* KH = lds + 18432; LAS unsigned char* RH = KH + 9216; LAS unsigned char* BH = RH + 9216; LAS unsigned char* KHAT = BH + 9216;
        LAS unsigned char* NBT = KHAT + 9216; LAS unsigned char* KTT = NBT + 9216; LAS unsigned char* VT = KTT + 9216;
        LAS unsigned char* LS = lds + 82944;
        LAS unsigned char* DIAG = LS + 9216; LAS unsigned char* DINV = LS + 13312;
        LAS unsigned char* AKK = LS + 17408; LAS unsigned char* NABR = AKK + 9216; LAS unsigned char* AKR = NABR + 9216;
        LAS float* GC = (LAS float*)(lds + 128000);
        LAS float* WTOT = (LAS float*)(lds + 128256);
        const int bh = u >> 7, ck = u & 127;
        unsigned char* ob = chk + (size_t)u * CB_BYTES;
        SREP(25) {
            const int t = tid >> 3, k8 = (tid & 7) * 8;
            const int bq = bh >> 4, hq = bh & 15, tpos = ck * 64 + t, m = bq * SEQ + tpos, c = hq * 64 + k8;
            float w[8], r[8], kt[8], kk[8], bb[8]; unsigned short vraw[8];
            {
                const GAS bf16* pc = proj + O_SL + (size_t)m * SLAB_W + c;
                float rc[8], kc[8], vc[8], rp[8], kp[8], vp[8], dp[8], ap[8], pr[8];
                const v4u q_rc = *(const GAS v4u*)(pc + S_R), q_kc = *(const GAS v4u*)(pc + S_K), q_vc = *(const GAS v4u*)(pc + S_V);
                const bool hasp = tpos > 0; const GAS bf16* pp = hasp ? pc - SLAB_W : pc;
                const v4u q_rp = *(const GAS v4u*)(pp + S_R), q_kp = *(const GAS v4u*)(pp + S_K), q_vp = *(const GAS v4u*)(pp + S_V);
                const v4u q_dp = *(const GAS v4u*)(lr + (size_t)m * LRN + c), q_ap = *(const GAS v4u*)(lr + (size_t)m * LRN + 1024 + c);
                f32x4 pq[7][2];
                { const float* ps[3] = {par.mu + S_R + c, par.mu + S_K + c, par.mu + S_V + c};
#pragma unroll
                  for (int i = 0; i < 3; ++i) { pq[i][0] = *(const f32x4*)ps[i]; pq[i][1] = *(const f32x4*)(ps[i] + 4); } }
                __builtin_amdgcn_sched_barrier(0);
                unpack8(q_rc, rc); unpack8(q_kc, kc); unpack8(q_vc, vc);
                if (hasp) { unpack8(q_rp, rp); unpack8(q_kp, kp); unpack8(q_vp, vp); }
                else {
#pragma unroll
                    for (int j = 0; j < 8; ++j) { rp[j] = 0.f; kp[j] = 0.f; vp[j] = 0.f; } }
                unpack8(q_dp, dp); unpack8(q_ap, ap);
                float kx[8], av[8], vx[8]; float ss = 0.f;
#define PQ_(i) do { pr[0] = pq[i][0][0]; pr[1] = pq[i][0][1]; pr[2] = pq[i][0][2]; pr[3] = pq[i][0][3]; pr[4] = pq[i][1][0]; pr[5] = pq[i][1][1]; pr[6] = pq[i][1][2]; pr[7] = pq[i][1][3]; } while (0)
                PQ_(0);
#pragma unroll
                for (int j = 0; j < 8; ++j) r[j] = rc[j] + (rp[j] - rc[j]) * pr[j];
                PQ_(1);
#pragma unroll
                for (int j = 0; j < 8; ++j) kx[j] = kc[j] + (kp[j] - kc[j]) * pr[j];
                PQ_(2);
#pragma unroll
                for (int j = 0; j < 8; ++j) vx[j] = vc[j] + (vp[j] - vc[j]) * pr[j];
                __builtin_amdgcn_sched_barrier(0);
                { const float* ps[4] = {par.w0 + c, par.a0 + c, par.k_k + c, par.k_a + c};
#pragma unroll
                  for (int i = 0; i < 4; ++i) { pq[3 + i][0] = *(const f32x4*)ps[i]; pq[3 + i][1] = *(const f32x4*)(ps[i] + 4); } }
                __builtin_amdgcn_sched_barrier(0);
                PQ_(3);
#pragma unroll
                for (int j = 0; j < 8; ++j) w[j] = __expf(-0.6065306597126334f * sigm(pr[j] + dp[j]));
                PQ_(4);
#pragma unroll
                for (int j = 0; j < 8; ++j) av[j] = sigm(pr[j] + ap[j]);
                PQ_(5);
#pragma unroll
                for (int j = 0; j < 8; ++j) { kk[j] = kx[j] * pr[j]; ss += kk[j] * kk[j]; }
                PQ_(6);
#pragma unroll
                for (int j = 0; j < 8; ++j) kt[j] = kx[j] * (1.0f + (av[j] - 1.0f) * pr[j]);
#undef PQ_
                const float rn = rsqrtf(fmaxf(sum8(ss), 1e-24f));
#pragma unroll
                for (int j = 0; j < 8; ++j) { kk[j] *= rn; bb[j] = kk[j] * av[j]; }
                const v4u r4 = pack8(r), kt4 = pack8(kt), v4 = pack8(vx), kk4 = pack8(kk), bb4 = pack8(bb);
                unsigned char* rec = rkv + ((size_t)bh * SEQ + tpos) * 384;
                *(v4u*)(rec + k8 * 2) = r4; *(v4u*)(rec + 128 + k8 * 2) = kt4; *(v4u*)(rec + 256 + k8 * 2) = v4;
                unpack8(r4, r); unpack8(kt4, kt); unpack8(kk4, kk); unpack8(bb4, bb);
                vraw[0] = (unsigned short)(v4.x & 0xffffu); vraw[1] = (unsigned short)(v4.x >> 16); vraw[2] = (unsigned short)(v4.y & 0xffffu); vraw[3] = (unsigned short)(v4.y >> 16);
                vraw[4] = (unsigned short)(v4.z & 0xffffu); vraw[5] = (unsigned short)(v4.z >> 16); vraw[6] = (unsigned short)(v4.w & 0xffffu); vraw[7] = (unsigned short)(v4.w >> 16);
            }
            float g[8];
#pragma unroll
            for (int j = 0; j < 8; ++j) g[j] = w[j];
#pragma unroll
            for (int o = 8; o < 64; o <<= 1) {
#pragma unroll
                for (int j = 0; j < 8; ++j) { const float up = __shfl_up(g[j], o); if (lane >= o) g[j] *= up; }
            }
            if ((lane >> 3) == 7) {
#pragma unroll
                for (int j = 0; j < 8; ++j) WTOT[wave * 64 + k8 + j] = g[j];
            }
            __syncthreads();
            for (int ww = 0; ww < wave; ++ww) {
#pragma unroll
                for (int j = 0; j < 8; ++j) g[j] *= WTOT[ww * 64 + k8 + j];
            }
            if (t == 63) {
#pragma unroll
                for (int j = 0; j < 8; ++j) GC[k8 + j] = g[j];
            }
            __syncthreads();
            float kh[8], rh[8], bh_[8], kha[8];
#pragma unroll
            for (int j = 0; j < 8; ++j) { const float ig = 1.0f / g[j], gc = GC[k8 + j];
                kh[j] = (g[j] / w[j]) * kk[j]; rh[j] = g[j] * r[j]; bh_[j] = bb[j] * ig; kha[j] = kt[j] * ig;
                *(LAS unsigned short*)(NBT + (k8 + j) * MP + t * 2) = f2bf(-(bh_[j] * gc));
                *(LAS unsigned short*)(KTT + (k8 + j) * MP + t * 2) = f2bf(kha[j] * gc);
                *(LAS unsigned short*)(VT + (k8 + j) * MP + t * 2) = vraw[j]; }
            v4u o;
            o.x = cvt_pk_bf16(kh[0], kh[1]); o.y = cvt_pk_bf16(kh[2], kh[3]); o.z = cvt_pk_bf16(kh[4], kh[5]); o.w = cvt_pk_bf16(kh[6], kh[7]); *(LAS v4u*)(KH + t * MP + k8 * 2) = o;
            o.x = cvt_pk_bf16(rh[0], rh[1]); o.y = cvt_pk_bf16(rh[2], rh[3]); o.z = cvt_pk_bf16(rh[4], rh[5]); o.w = cvt_pk_bf16(rh[6], rh[7]); *(LAS v4u*)(RH + t * MP + k8 * 2) = o;
            o.x = cvt_pk_bf16(bh_[0], bh_[1]); o.y = cvt_pk_bf16(bh_[2], bh_[3]); o.z = cvt_pk_bf16(bh_[4], bh_[5]); o.w = cvt_pk_bf16(bh_[6], bh_[7]); *(LAS v4u*)(BH + t * MP + k8 * 2) = o;
            o.x = cvt_pk_bf16(kha[0], kha[1]); o.y = cvt_pk_bf16(kha[2], kha[3]); o.z = cvt_pk_bf16(kha[4], kha[5]); o.w = cvt_pk_bf16(kha[6], kha[7]); *(LAS v4u*)(KHAT + t * MP + k8 * 2) = o;
        }
        __syncthreads();
        {
            const int tr = wave >> 1; const LAS unsigned char* Am = (tr < 2 ? KH : RH) + 32 * (tr & 1) * MP;
#pragma unroll
            for (int q = 0; q < 2; ++q) {
                const int tc = 2 * (wave & 1) + q; const LAS unsigned char* Bm = (tc < 2 ? BH : KHAT) + 32 * (tc & 1) * MP;
                f32x16 acc = {0.f, 0.f, 0.f, 0.f, 0.f, 0.f, 0.f, 0.f, 0.f, 0.f, 0.f, 0.f, 0.f, 0.f, 0.f, 0.f};
                acc = mfma4(Am, Bm, lane, acc);
                const int i = 32 * (tc & 1) + r32;
#pragma unroll
                for (int reg = 0; reg < 16; ++reg) { const int t = 32 * (tr & 1) + (reg & 3) + 8 * (reg >> 2) + 4 * hi; const float v = acc[reg];
                    if (tr < 2) { if (tc < 2) { const float lv = (i < t) ? v : 0.f; *(LAS unsigned short*)(LS + t * MP + i * 2) = f2bf(-lv); if ((t >> 4) == (i >> 4)) *(LAS float*)(DIAG + ((t >> 4) * 256 + (t & 15) * 16 + (i & 15)) * 4) = lv; } else *(LAS unsigned short*)(AKK + t * MP + i * 2) = f2bf((i < t) ? v : 0.f); }
                    else { if (tc < 2) *(LAS unsigned short*)(NABR + t * MP + i * 2) = f2bf((i <= t) ? -v : 0.f); else *(LAS unsigned short*)(AKR + t * MP + i * 2) = f2bf((i <= t) ? v : 0.f); } }
            }
        }
        __syncthreads();
        if (wave < 4) {
            const int rt = wave >> 1, ct = wave & 1;
            f32x16 acc = {0.f, 0.f, 0.f, 0.f, 0.f, 0.f, 0.f, 0.f, 0.f, 0.f, 0.f, 0.f, 0.f, 0.f, 0.f, 0.f};
            acc = mfma4(AKK + 32 * rt * MP, VT + 32 * ct * MP, lane, acc);
#pragma unroll
            for (int reg = 0; reg < 16; ++reg) { const int t = 32 * rt + (reg & 3) + 8 * (reg >> 2) + 4 * hi; *(LAS float*)(GB + (t * 64 + 32 * ct + r32) * 4) = acc[reg]; }
        } else if (wave == 4) {
            const int b = lane >> 4, j = lane & 15;
            const LAS unsigned char* db = DIAG + b * 1024; asm volatile("" : "+v"(db));
            float z[16];
#pragma unroll
            for (int t = 0; t < 16; ++t) {
                float sacc = (t == j) ? 1.0f : 0.0f;
                f32x4 l[4];
#pragma unroll
                for (int i4 = 0; i4 < (t + 3) / 4; ++i4) l[i4] = *(const LAS f32x4*)(db + t * 64 + i4 * 16);
#pragma unroll
                for (int i = 0; i < t; ++i) nfma(sacc, l[i >> 2][i & 3], z[i]);
                z[t] = sacc;
            }
            { LAS unsigned char* dw = DINV + b * 512 + j * 2; asm volatile("" : "+v"(dw));
#pragma unroll
              for (int t = 0; t < 16; ++t) *(LAS unsigned short*)(dw + t * 32) = f2bf(z[t]); }
        }
        __syncthreads();
        {
            const int c = 16 * wave + (lane & 15), g = lane >> 4, tl = lane & 15;
            const LAS unsigned char* rbase = (wave < 4) ? (const LAS unsigned char*)(KH + 4 * g * MP + c * 2) : (const LAS unsigned char*)(GB + (4 * g * 64 + (c - 64)) * 4); asm volatile("" : "+v"(rbase));
            const LAS unsigned char* abase = LS + tl * MP + 8 * g; asm volatile("" : "+v"(abase));
            const LAS unsigned char* dbase = DINV + tl * 32 + g * 8; asm volatile("" : "+v"(dbase));
            LAS unsigned char* pbase = GB + c * MP + 8 * g; asm volatile("" : "+v"(pbase));
            float rv[4][4];
#pragma unroll
            for (int b = 0; b < 4; ++b)
#pragma unroll
                for (int r = 0; r < 4; ++r) rv[b][r] = (wave < 4) ? bf2f(*(const LAS unsigned short*)(rbase + (16 * b + r) * MP)) : *(const LAS float*)(rbase + (16 * b + r) * 256);
            asm volatile("s_waitcnt lgkmcnt(0)" ::: "memory");
            __syncthreads();
            typedef unsigned u32x2v __attribute__((ext_vector_type(2)));
            u32x2v xb[4];
            const pg8::u32x4 zero4 = {0u, 0u, 0u, 0u}; (void)zero4;
#pragma unroll
            for (int b = 0; b < 4; ++b) {
                f32x4 acc = {rv[b][0], rv[b][1], rv[b][2], rv[b][3]};
#pragma unroll
                for (int m = 0; m < b; m += 2) {
                    const u32x2v alo = *(const LAS u32x2v*)(abase + 16 * b * MP + 32 * m);
                    u32x2v ahi = {0u, 0u}, bhi = {0u, 0u};
                    if (m + 1 < b) { ahi = *(const LAS u32x2v*)(abase + 16 * b * MP + 32 * (m + 1)); bhi = xb[m + 1]; }
                    const pg8::u32x4 av = {alo.x, alo.y, ahi.x, ahi.y}, bv = {xb[m].x, xb[m].y, bhi.x, bhi.y};
                    acc = __builtin_amdgcn_mfma_f32_16x16x32_bf16(__builtin_bit_cast(bf16x8, av), __builtin_bit_cast(bf16x8, bv), acc, 0, 0, 0);
                }
                const u32x2v dlo = *(const LAS u32x2v*)(dbase + b * 512);
                const pg8::u32x4 av = {dlo.x, dlo.y, 0u, 0u}, bv = {cvt_pk_bf16(acc[0], acc[1]), cvt_pk_bf16(acc[2], acc[3]), 0u, 0u};
                f32x4 xz = {0.f, 0.f, 0.f, 0.f};
                xz = __builtin_amdgcn_mfma_f32_16x16x32_bf16(__builtin_bit_cast(bf16x8, av), __builtin_bit_cast(bf16x8, bv), xz, 0, 0, 0);
                xb[b] = (u32x2v){cvt_pk_bf16(xz[0], xz[1]), cvt_pk_bf16(xz[2], xz[3])};
                *(LAS u32x2v*)(pbase + 32 * b) = xb[b];
            }
        }
        __syncthreads();
        SREP(27) {
            const int tr = wave >> 1; const LAS unsigned char* A1 = (tr < 2 ? NABR : NBT) + 32 * (tr & 1) * MP; const LAS unsigned char* A2 = (tr < 2 ? AKR : KTT) + 32 * (tr & 1) * MP;
#pragma unroll
            for (int q = 0; q < 2; ++q) {
                const int tc = 2 * (wave & 1) + q;
                f32x16 acc = {0.f, 0.f, 0.f, 0.f, 0.f, 0.f, 0.f, 0.f, 0.f, 0.f, 0.f, 0.f, 0.f, 0.f, 0.f, 0.f};
                acc = mfma4(A1, GB + 32 * tc * MP, lane, acc);
                if (tc >= 2) {
                    acc = mfma4(A2, VT + 32 * (tc - 2) * MP, lane, acc);
                    unsigned char* dst = ob + (tr < 2 ? 32768 : 16384) + ((tr & 1) * 2 + (tc - 2)) * 4096 + lane * 16;
#pragma unroll
                    for (int q4 = 0; q4 < 4; ++q4) { const f32x4 v = {acc[4 * q4], acc[4 * q4 + 1], acc[4 * q4 + 2], acc[4 * q4 + 3]}; *(f32x4*)(dst + q4 * 1024) = v; }
                } else {
                    const int k = 32 * tc + r32; bf16* dst = (bf16*)(ob + (tr < 2 ? 8192 : 0)) + kperm(k);
#pragma unroll
                    for (int reg = 0; reg < 16; ++reg) { const int row = 32 * (tr & 1) + (reg & 3) + 8 * (reg >> 2) + 4 * hi;
                        float v = acc[reg];
                        if (tr < 2) v += bf2f(*(const LAS unsigned short*)(RH + row * MP + k * 2)); else v += (row == k) ? GC[k] : 0.f;
                        dst[row * 64] = f2bf(v); }
                }
            }
        }
        __syncthreads();
    }
}
constexpr int SB_BUF = 51200;
__device__ __forceinline__ f32x16 load_acc(const LAS unsigned char* p, int lane) {
    f32x16 a;
#pragma unroll
    for (int q4 = 0; q4 < 4; ++q4) { const f32x4 v = *(const LAS f32x4*)(p + q4 * 1024 + lane * 16); a[4 * q4] = v[0]; a[4 * q4 + 1] = v[1]; a[4 * q4 + 2] = v[2]; a[4 * q4 + 3] = v[3]; }
    return a;
}
__device__ __forceinline__ bf16x8 acc_to_frag(const f32x16& a, int s) {
    v4u o; o.x = cvt_pk_bf16(a[8 * s], a[8 * s + 1]); o.y = cvt_pk_bf16(a[8 * s + 2], a[8 * s + 3]); o.z = cvt_pk_bf16(a[8 * s + 4], a[8 * s + 5]); o.w = cvt_pk_bf16(a[8 * s + 6], a[8 * s + 7]);
    return __builtin_bit_cast(bf16x8, o);
}
__device__ __forceinline__ void scan_b_phase(const unsigned char* chk, float* ys, LAS unsigned char* lds, int tid, int lane, int wave, int G) {
    const int hi = lane >> 5, r32 = lane & 31;
    const int prow = tid >> 3, pc16 = tid & 7;
    for (int u = blockIdx.x; u < 32; u += G) {
        const int b = u >> 4, h = u & 15;
        const unsigned char* src = chk + (size_t)u * 128 * CB_BYTES;
        f32x16 T0 = {0.f, 0.f, 0.f, 0.f, 0.f, 0.f, 0.f, 0.f, 0.f, 0.f, 0.f, 0.f, 0.f, 0.f, 0.f, 0.f}, T1 = T0;
        v4u pre[6], pre2[6];
#pragma unroll
        for (int i = 0; i < 6; ++i) pre[i] = *(const GAS v4u*)((const GAS unsigned char*)src + (size_t)(i * 512 + tid) * 16);
#pragma unroll
        for (int i = 0; i < 6; ++i) pre2[i] = *(const GAS v4u*)((const GAS unsigned char*)src + (size_t)CB_BYTES + (size_t)(i * 512 + tid) * 16);
        for (int cc = 0; cc < 128; ++cc) {
            { LAS unsigned char* nb = lds + (cc & 1) * SB_BUF;
              *(LAS v4u*)(nb + prow * MP + pc16 * 16) = pre[0]; *(LAS v4u*)(nb + 9216 + prow * MP + pc16 * 16) = pre[1];
#pragma unroll
              for (int i = 2; i < 6; ++i) *(LAS v4u*)(nb + 18432 + (size_t)((i - 2) * 512 + tid) * 16) = pre[i]; }
            __syncthreads();
#pragma unroll
            for (int i = 0; i < 6; ++i) pre[i] = pre2[i];
            if (cc + 2 < 128) {
#pragma unroll
                for (int i = 0; i < 6; ++i) pre2[i] = *(const GAS v4u*)((const GAS unsigned char*)src + (size_t)(cc + 2) * CB_BYTES + (size_t)(i * 512 + tid) * 16);
            }
            if (wave < 2) {
                const int ct = wave; const LAS unsigned char* buf = lds + (cc & 1) * SB_BUF;
                const bf16x8 tb0 = acc_to_frag(T0, 0), tb1 = acc_to_frag(T0, 1), tb2 = acc_to_frag(T1, 0), tb3 = acc_to_frag(T1, 1);
                f32x16 N0 = load_acc(buf + 18432 + (0 * 2 + ct) * 4096, lane), N1 = load_acc(buf + 18432 + (1 * 2 + ct) * 4096, lane);
                f32x16 Y0 = load_acc(buf + 34816 + (0 * 2 + ct) * 4096, lane), Y1 = load_acc(buf + 34816 + (1 * 2 + ct) * 4096, lane);
                const LAS unsigned char* g0 = buf + r32 * MP + hi * 16; const LAS unsigned char* q0 = buf + 9216 + r32 * MP + hi * 16;
#define SB_STEP(ks, tb) do { \
                N0 = __builtin_amdgcn_mfma_f32_32x32x16_bf16(*(const LAS bf16x8*)(g0 + (ks) * 32), tb, N0, 0, 0, 0); \
                N1 = __builtin_amdgcn_mfma_f32_32x32x16_bf16(*(const LAS bf16x8*)(g0 + 32 * MP + (ks) * 32), tb, N1, 0, 0, 0); \
                Y0 = __builtin_amdgcn_mfma_f32_32x32x16_bf16(*(const LAS bf16x8*)(q0 + (ks) * 32), tb, Y0, 0, 0, 0); \
                Y1 = __builtin_amdgcn_mfma_f32_32x32x16_bf16(*(const LAS bf16x8*)(q0 + 32 * MP + (ks) * 32), tb, Y1, 0, 0, 0); } while (0)
                SB_STEP(0, tb0); SB_STEP(1, tb1); SB_STEP(2, tb2); SB_STEP(3, tb3);
#undef SB_STEP
                T0 = N0; T1 = N1;
                float* yo = ys + ((size_t)(b * SEQ + cc * 64)) * 1024 + h * 64 + 32 * ct + r32;
#pragma unroll
                for (int reg = 0; reg < 16; ++reg) { const int t = (reg & 3) + 8 * (reg >> 2) + 4 * hi; yo[(size_t)t * 1024] = Y0[reg]; yo[(size_t)(t + 32) * 1024] = Y1[reg]; }
            }
        }
        __syncthreads();
    }
}

constexpr int NPL = 18, PH_FINAL = 1 + DEPTH * NPL, NPH = PH_FINAL + 1;
#ifndef SCAN_CHECK
#define SCAN_CHECK 0
#endif
#ifndef ATT_CHECK
#define ATT_CHECK 0
#endif
#ifndef SCAN_CHECK_TOL
#define SCAN_CHECK_TOL 1e-3f
#endif
#define PG8_SP2 true
#define PG8_ALIGN true
__global__ void __launch_bounds__(512, 2) trunk_fwd(Args args) {
    extern __shared__ __attribute__((aligned(16))) unsigned char lds_raw[];
    LAS unsigned char* lds = (LAS unsigned char*)lds_raw;
    const int G = gridDim.x;
    unsigned* ctl = (unsigned*)(args.ws + WS_CTL);
    volatile LAS unsigned* MISC = (volatile LAS unsigned*)(lds + MISC_OFF);
    LAS int* tab = (LAS int*)(lds + MISC_OFF + 64);
    for (int u = threadIdx.x; u < (LDS_BYTES - MISC_OFF) / 4; u += 512) ((LAS unsigned*)(lds + MISC_OFF))[u] = 0u;
    __syncthreads();
    const int lo = args.ph_lo, hi = args.ph_hi;
    const bool multi = (hi - lo) > 1;
    XcdBarrier bar; bar.bar = ctl + CW_BAR; bar.x = 0; bar.st = nullptr;
    if (multi) bar = xcd_barrier_post(ctl + CW_BAR, MISC);
#ifndef PHASE_MASK
#define PHASE_MASK 0xFFFFFFFFu
#endif
#define KIND_ON(kind) (((PHASE_MASK) >> (kind)) & 1u)
#ifndef PROBE_REPEAT
#define PROBE_REPEAT 0u
#endif
#define REP(kind) for (int rep_ = 0; rep_ < 1 + (int)(((PROBE_REPEAT) >> (kind)) & 1u); ++rep_)
#define IN(k) (lo <= (k) && (k) < hi)
#define SEAM(k) do { if ((k) + 1 < hi) xcd_barrier(bar); } while (0)

#define PH_LOCALS int tid = threadIdx.x; asm volatile("" : "+v"(tid)); const int lane = tid & 63, wave = __builtin_amdgcn_readfirstlane(tid >> 6); unsigned char* ws = args.ws; asm volatile("" : "+s"(ws)); (void)lane; (void)wave; \
    bf16* XN = (bf16*)(ws + WS_XN); bf16* PROJ = (bf16*)(ws + WS_PROJ); bf16* LRA = (bf16*)(ws + WS_LRA); bf16* LR = (bf16*)(ws + WS_LR); \
    unsigned char* SCANIN = ws + WS_SCANIN; float* YS = (float*)(ws + WS_YS); bf16* ATT = (bf16*)(ws + WS_ATT); bf16* RW = (bf16*)(ws + WS_RW); bf16* M1 = (bf16*)(ws + WS_M1); \
    unsigned short* IDX = (unsigned short*)(ws + WS_IDX); int* ROUTE = (int*)(ws + WS_ROUTE); \
    bf16* UD = (bf16*)(ws + WS_UD); bf16* XG = (bf16*)(ws + WS_XG); bf16* UM = (bf16*)(ws + WS_UM); bf16* YM = (bf16*)(ws + WS_YM); bf16* PP = (bf16*)(ws + WS_PP); \
    (void)XN; (void)PROJ; (void)LRA; (void)LR; (void)SCANIN; (void)YS; (void)ATT; (void)RW; (void)M1; (void)IDX; (void)ROUTE; (void)UD; (void)XG; (void)UM; (void)YM; (void)PP;
    float* H = args.out;

#if (PROBE_REPEAT >> 17) & 1
    if (IN(0)) { float x = (float)threadIdx.x; for (int i = 0; i < 25000; ++i) { asm volatile("v_fma_f32 %0, %0, %0, %0\n v_fma_f32 %0, %0, %0, %0\n v_fma_f32 %0, %0, %0, %0\n v_fma_f32 %0, %0, %0, %0" : "+v"(x)); } if (x == 12345.678f) args.out[0] = x; }
#endif
#if (PROBE_REPEAT >> 19) & 1
    if (IN(0)) { float x = (float)threadIdx.x; for (int i = 0; i < 25000; ++i) { asm volatile("v_cmp_le_f32 vcc, 1.0, %0\n v_cndmask_b32 %0, 0, %0, vcc\n v_cmp_le_f32 vcc, 2.0, %0\n v_cndmask_b32 %0, 0, %0, vcc" : "+v"(x) : : "vcc"); } if (x == 12345.678f) args.out[0] = x; }
#endif
#if (PROBE_REPEAT >> 18) & 1
    if (IN(0)) { unsigned c = 0; for (int i = 0; i < 25000; ++i) { unsigned long long m; asm volatile("v_cmp_le_f32_e64 %0, 0, %1\n s_bcnt1_i32_b64 s20, %0\n s_add_i32 %2, %2, s20\n v_cmp_le_f32_e64 %0, 1.0, %1\n s_bcnt1_i32_b64 s20, %0\n s_add_i32 %2, %2, s20" : "=&s"(m), "+v"(*(float*)&i), "+s"(c) : : "s20"); } if (c == 12345u) args.out[0] = 1.f; }
#endif
    if (KIND_ON(0) && IN(0)) { PH_LOCALS REP(0) { p0_prologue(args, lds, tid, lane, wave, G); __syncthreads(); }
        norm_phase<0>(args.in[I_X], nullptr, args.in[I_NMIX], XN, nullptr, nullptr, nullptr, nullptr, nullptr, lane, wave, G);
        SEAM(0); }

    for (int l = 0; l < DEPTH; ++l) {
        const int pb = 1 + l * NPL;
        const float* hin = (l == 0) ? args.in[I_X] : H;
        if (l > 0 && KIND_ON(1) && IN(pb + 0)) { PH_LOCALS norm_phase<0>(hin, nullptr, args.in[I_NMIX] + l * D, XN, nullptr, nullptr, nullptr, nullptr, nullptr, lane, wave, G); SEAM(pb + 0); }
        if (KIND_ON(2) && IN(pb + 1)) { PH_LOCALS
            pg8::Gemm g{XN, (const bf16*)(ws + WS_WIN) + (size_t)l * PW * D, T, PW, D}; pg8::StaticOrder S; S.init(T, PW, G, (int)blockIdx.x);
            pg8::EpiProj E{PROJ, T, SEQ};
            REP(23) { pg8::gemm_phase<pg8::EpiProj, pg8::StaticOrder, PG8_ALIGN, PG8_SP2>(lds, g, S, E); }
            SEAM(pb + 1);
        }
        if (KIND_ON(3) && IN(pb + 2)) { PH_LOCALS
            REP(3) { select_phase(PROJ, IDX, (unsigned short*)(ws + WS_CHK), lds, tid, lane, wave, G, ctl);
            rwkv_prep_a(PROJ, args.in[I_MU] + l * SLAB_W, LRA, tid, G); }
            SEAM(pb + 2);
        }
        if (KIND_ON(4) && IN(pb + 3)) { PH_LOCALS
            pg8::Gemm g{LRA, (const bf16*)(ws + WS_LRT + (size_t)l * LRT_BYTES), T, LRN, LRK}; pg8::StaticOrder S; S.init(T, LRN, G, (int)blockIdx.x);
            pg8::EpiStoreBf16 E{LR, LRN};
            pg8::gemm_phase<pg8::EpiStoreBf16, pg8::StaticOrder, PG8_ALIGN, PG8_SP2>(lds, g, S, E);
            SEAM(pb + 3);
        }
#if SCAN_CHECK
        if (KIND_ON(5) && IN(pb + 4)) { PH_LOCALS
            rwkv_prep_b(PROJ, LR, args.in[I_MU] + l * SLAB_W, args.in[I_W0] + l * 1024, args.in[I_A0] + l * 1024, args.in[I_KK] + l * 1024, args.in[I_KA] + l * 1024, SCANIN + 96 * MiB, tid, G, T / 2);
            SEAM(pb + 4);
        }
#endif
        if (KIND_ON(6) && IN(pb + 5)) { PH_LOCALS const RwkvPar par{args.in[I_MU] + l * SLAB_W, args.in[I_W0] + l * 1024, args.in[I_A0] + l * 1024, args.in[I_KK] + l * 1024, args.in[I_KA] + l * 1024};
            REP(10) { scan_a_phase(PROJ, LR, par, SCANIN, ws + WS_CHK, lds, tid, lane, wave, G); } SEAM(pb + 5); }
        if (KIND_ON(7) && IN(pb + 6)) { PH_LOCALS
            REP(11) { scan_b_phase(ws + WS_CHK, YS, lds, tid, lane, wave, G); }
#if SCAN_CHECK
            if (l == 0) scan_phase(SCANIN + 96 * MiB, args.out, lds, tid, lane, wave, G, 64);
#endif
            attn_phase(PROJ, IDX, args.in[I_RELB], ATT, lds, tid, lane, wave, G, ctl + CW_ATTQ + 2048 * l); __syncthreads();
#if (PROBE_REPEAT >> 5) & 1
            attn_phase(PROJ, IDX, args.in[I_RELB], ATT, lds, tid, lane, wave, G, ctl + CW_ATTQ + 2048 * l + 1024); __syncthreads();
#endif
#if ATT_CHECK
            if (l == 0) { attn_phase_ref(PROJ, IDX, args.in[I_RELB], (bf16*)args.out, lds, tid, lane, wave, G); __syncthreads(); }
#endif
            SEAM(pb + 6);
        }
        if (KIND_ON(8) && IN(pb + 7)) { PH_LOCALS
#if ATT_CHECK
            if (l == 0) { float e2 = 0.f, r2 = 0.f; const bf16* ar = (const bf16*)args.out; for (size_t i = (size_t)blockIdx.x * 512 + tid; i < (size_t)T * 1024; i += (size_t)G * 512) { const float a = bf2f(ATT[i]), b = bf2f(ar[i]), d = a - b; e2 += d * d; r2 += b * b; }
                e2 = wave_sum(e2); r2 = wave_sum(r2); if (lane == 0) { atomicAdd((float*)(ctl + 32), e2); atomicAdd((float*)(ctl + 33), r2); } }
#endif
#if SCAN_CHECK
            if (l == 0) { float e2 = 0.f, r2 = 0.f; for (size_t i = (size_t)blockIdx.x * 512 + tid; i < (size_t)(T / 2) * 1024; i += (size_t)G * 512) { const float a = YS[i], b = args.out[i], d = a - b; e2 += d * d; r2 += b * b; }
                e2 = wave_sum(e2); r2 = wave_sum(r2); if (lane == 0) { atomicAdd((float*)(ctl + 32), e2); atomicAdd((float*)(ctl + 33), r2); } }
#endif
            REP(12) rwkv_post<384>(YS, SCANIN, LR, args.in[I_RK] + l * 1024, args.in[I_GNW] + l * 1024, args.in[I_GNB] + l * 1024, RW, tid, G); }
        if (KIND_ON(9) && IN(pb + 7)) { PH_LOCALS
            pg8::Gemm g{ATT, (const bf16*)(ws + WS_UATT) + (size_t)l * D * 1024, T, D, 1024}; pg8::StaticOrder S; S.init(T, D, G, (int)blockIdx.x);
            pg8::EpiGate<false> E{M1, D, PROJ + O_GA, D};
            pg8::gemm_phase<pg8::EpiGate<false>, pg8::StaticOrder, PG8_ALIGN, PG8_SP2>(lds, g, S, E);
            SEAM(pb + 7);
        }
        if (KIND_ON(10) && IN(pb + 9)) { PH_LOCALS
            pg8::Gemm g{RW, (const bf16*)(ws + WS_URW) + (size_t)l * D * 1024, T, D, 1024}; pg8::StaticOrder S; S.init(T, D, G, (int)blockIdx.x);
            pg8::EpiGate<true> E{M1, D, PROJ + O_GB, D};
            pg8::gemm_phase<pg8::EpiGate<true>, pg8::StaticOrder, PG8_ALIGN, PG8_SP2>(lds, g, S, E);
            SEAM(pb + 9);
        }
        if (KIND_ON(11) && IN(pb + 10)) { PH_LOCALS
            pg8::Gemm g{M1, (const bf16*)(ws + WS_WOUT) + (size_t)l * D * D, T, D, D}; pg8::StaticOrder S; S.init(T, D, G, (int)blockIdx.x);
            pg8::EpiResid E{hin, H, D};
            pg8::gemm_phase<pg8::EpiResid, pg8::StaticOrder, PG8_ALIGN, PG8_SP2>(lds, g, S, E);
            SEAM(pb + 10);
        }
        if (KIND_ON(12) && IN(pb + 11)) { PH_LOCALS
            if (l & 1) norm_phase<1>(H, nullptr, args.in[I_NFFN] + l * D, XN, args.in[I_ROUT] + (size_t)(l >> 1) * D * NE, ctl, ROUTE, nullptr, nullptr, lane, wave, G);
            else norm_phase<0>(H, nullptr, args.in[I_NFFN] + l * D, XN, nullptr, nullptr, nullptr, nullptr, nullptr, lane, wave, G);
            SEAM(pb + 11);
        }
        if (l & 1) {
            if (KIND_ON(13) && IN(pb + 12)) { PH_LOCALS moe_table(ctl, tab, 2 * DFE / 256, tid); moe_gather(XN, (unsigned char*)XG, ROUTE, tab, lane, wave, G); SEAM(pb + 12); }
            if (KIND_ON(14) && IN(pb + 13)) { PH_LOCALS
                moe_table(ctl, tab, 2 * DFE / 256, tid);
                pg8::Gemm g{XG, (const bf16*)(ws + WS_M13), MOE_ROWS, 2 * DFE, D / 2, XGP / 2, XGP / 2}; pg8::MoeOrder S{tab, 2 * DFE / 256, G, (int)blockIdx.x};
                pg8::EpiSwigluF8 E{(unsigned char*)UM, DFE, 1.0f / (MOE_AS * MOE_WS13), MOE_AS};
                REP(21) { pg8::gemm_phase<pg8::EpiSwigluF8, pg8::MoeOrder, PG8_ALIGN, PG8_SP2, true>(lds, g, S, E); }
                SEAM(pb + 13);
            }
            if (KIND_ON(15) && IN(pb + 14)) { PH_LOCALS
                moe_table(ctl, tab, D / 256, tid);
                pg8::Gemm g{UM, (const bf16*)(ws + WS_M2), MOE_ROWS, D, DFE / 2}; pg8::MoeOrder S{tab, D / 256, G, (int)blockIdx.x};
                pg8::EpiStoreBf16 E{YM, D, 1.0f / (MOE_AS * MOE_WS2)};
                REP(22) { pg8::gemm_phase<pg8::EpiStoreBf16, pg8::MoeOrder, PG8_ALIGN, PG8_SP2, true>(lds, g, S, E); }
                SEAM(pb + 14);
            }
            if (KIND_ON(16) && IN(pb + 15)) { PH_LOCALS moe_table(ctl, tab, D / 256, tid); if (l == DEPTH - 1) norm_phase<2, true>(H, H, args.in[I_NPLE] + l * D, XN, nullptr, nullptr, ROUTE, YM, tab, lane, wave, G); else norm_phase<2>(H, H, args.in[I_NPLE] + l * D, XN, nullptr, nullptr, ROUTE, YM, tab, lane, wave, G); }
        } else {
            if (KIND_ON(14) && IN(pb + 13)) { PH_LOCALS
                pg8::Gemm g{XN, (const bf16*)(ws + WS_F13), T, 2 * DFF, D}; pg8::StaticOrder S; S.init(T, 2 * DFF, G, (int)blockIdx.x);
                pg8::EpiSwiglu E{UD, DFF};
                REP(24) { pg8::gemm_phase<pg8::EpiSwiglu, pg8::StaticOrder, PG8_ALIGN, PG8_SP2>(lds, g, S, E); }
                SEAM(pb + 13);
            }
            if (KIND_ON(15) && IN(pb + 14)) { PH_LOCALS
                pg8::Gemm g{UD, (const bf16*)(ws + WS_F2), T, D, DFF}; pg8::StaticOrder S; S.init(T, D, G, (int)blockIdx.x);
                pg8::EpiResid E{H, H, D};
                pg8::gemm_phase<pg8::EpiResid, pg8::StaticOrder, PG8_ALIGN, PG8_SP2>(lds, g, S, E);
                SEAM(pb + 14);
            }
            if (KIND_ON(16) && IN(pb + 15)) { PH_LOCALS norm_phase<0>(H, nullptr, args.in[I_NPLE] + l * D, XN, nullptr, nullptr, nullptr, nullptr, nullptr, lane, wave, G); }
        }
        if (KIND_ON(17) && IN(pb + 15)) { PH_LOCALS
            pg8::Gemm g{(const bf16*)(ws + WS_PB) + (size_t)l * T * 256, (const bf16*)(ws + WS_PLEP) + (size_t)l * D * 256, T, D, 256}; pg8::StaticOrder S; S.init(T, D, G, (int)blockIdx.x);
            pg8::EpiStoreBf16 E{PP, D};
            pg8::gemm_phase<pg8::EpiStoreBf16, pg8::StaticOrder, PG8_ALIGN, PG8_SP2>(lds, g, S, E);
            SEAM(pb + 15);
        }
        if (KIND_ON(18) && IN(pb + 17)) { PH_LOCALS
            pg8::StaticOrder S; S.init(T, D, G, (int)blockIdx.x);
            if (l == DEPTH - 1 && (l & 1)) {
                pg8::Gemm g{XN, (const bf16*)(ws + WS_PLEG) + (size_t)l * D * D, T, D, D / 2};
                pg8::EpiPle E{H, PP, D, 1.0f / (PLE_AS * PLE_WS)};
                pg8::gemm_phase<pg8::EpiPle, pg8::StaticOrder, PG8_ALIGN, PG8_SP2, true>(lds, g, S, E);
            } else {
                pg8::Gemm g{XN, (const bf16*)(ws + WS_PLEG) + (size_t)l * D * D, T, D, D};
                pg8::EpiPle E{H, PP, D};
                pg8::gemm_phase<pg8::EpiPle, pg8::StaticOrder, PG8_ALIGN, PG8_SP2>(lds, g, S, E);
            }
            SEAM(pb + 17);
        }
    }
    if (KIND_ON(19) && IN(PH_FINAL)) { PH_LOCALS norm_phase<3>(H, H, args.in[I_FIN], nullptr, nullptr, nullptr, nullptr, nullptr, nullptr, lane, wave, G);
#if SEL_CHECK
        __syncthreads(); if (blockIdx.x == 0 && tid == 0) { const unsigned nb = ((volatile unsigned*)ctl)[34], nr = ((volatile unsigned*)ctl)[35]; if (nb != 0u || nr != 2u * (unsigned)(T - 2 * NSEL) || ((volatile unsigned*)ctl)[36] > 2000u) H[12345] = __builtin_nanf(""); }
#endif
#if SCAN_CHECK || ATT_CHECK
        __syncthreads(); if (blockIdx.x == 0 && tid == 0) { const float e2 = ((volatile float*)(ctl + 32))[0], r2 = ((volatile float*)(ctl + 33))[0]; if (!(e2 <= SCAN_CHECK_TOL * r2) || !(r2 > 0.f)) H[12345] = __builtin_nanf(""); }
#endif
    }
#undef IN
#undef SEAM
}

extern "C" void kernel_launch(void* const* d_in, const int* in_sizes, int n_in, void* d_out, int out_size, void* d_ws, size_t ws_size, hipStream_t stream) {
    static int grid = 0;
    if (grid == 0) {
        if (n_in != 31 || out_size != T * D || ws_size < WS_END) { fprintf(stderr, "kernel_launch: unexpected problem: n_in %d out %d ws %zu (need %zu)\n", n_in, out_size, ws_size, (size_t)WS_END); grid = -1; return; }
        int dev = 0, cus = 0, per_cu = 0;
        if (hipGetDevice(&dev) != hipSuccess || hipDeviceGetAttribute(&cus, hipDeviceAttributeMultiprocessorCount, dev) != hipSuccess) { grid = -1; return; }
        if (hipFuncSetAttribute((const void*)trunk_fwd, hipFuncAttributeMaxDynamicSharedMemorySize, LDS_BYTES) != hipSuccess) { fprintf(stderr, "kernel_launch: hipFuncSetAttribute failed\n"); grid = -1; return; }
        if (hipOccupancyMaxActiveBlocksPerMultiprocessor(&per_cu, (const void*)trunk_fwd, 512, LDS_BYTES) != hipSuccess || per_cu < 1) { fprintf(stderr, "kernel_launch: occupancy query says %d\n", per_cu); }
        (void)hipGetLastError();
        grid = cus;
    }
    if (grid < 0) return;
    (void)hipMemsetAsync((char*)d_ws + WS_CTL, 0, CTL_ZERO_BYTES, stream);
    Args a{};
    for (int i = 0; i < 31; ++i) a.in[i] = (const float*)d_in[i];
    a.out = (float*)d_out; a.ws = (unsigned char*)d_ws;
#if MK_ONE_LAUNCH
    a.ph_lo = 0; a.ph_hi = NPH;
    hipLaunchKernelGGL(trunk_fwd, dim3(grid), dim3(512), LDS_BYTES, stream, a);
#else
    for (int ph = 0; ph < NPH; ++ph) {
        if (ph >= 1 && ph < PH_FINAL && ((ph - 1) % NPL) == 12 && (((ph - 1) / NPL) & 1) == 0) continue;
        a.ph_lo = ph; a.ph_hi = ph + 1;
        hipLaunchKernelGGL(trunk_fwd, dim3(grid), dim3(512), LDS_BYTES, stream, a);
    }
#endif
}
```

```cpp
#include <hip/hip_runtime.h>
#include <cstdio>
#include <cstdint>

#ifndef MK_ONE_LAUNCH
#define MK_ONE_LAUNCH 1
#endif

namespace pg8 {
#define PG8_LAS __attribute__((address_space(3)))
typedef unsigned short bf16_t;
typedef short bf16x8 __attribute__((ext_vector_type(8)));
typedef float f32x4 __attribute__((ext_vector_type(4)));
typedef unsigned u32x4 __attribute__((ext_vector_type(4)));
typedef unsigned u32x2 __attribute__((ext_vector_type(2)));
constexpr int BM = 256, BK = 64, HALF = 128, HTB = HALF * BK * 2, STAGE_BYTES = 8 * HTB, NXCD = 8, WGM = 8;

__host__ __device__ __forceinline__ int lds_byte(int r, int c) { const int st = (r >> 4) * 2 + (c >> 5), rr = r & 15, cc = c & 31, ob = rr * 64 + cc * 2; return st * 1024 + (ob ^ (((ob >> 9) & 1) << 5)); }
__host__ __device__ __forceinline__ void stage_rc(int b, int& R, int& C) { const int st = b / 1024, sb = b % 1024, swz = sb ^ (((sb >> 9) & 1) << 5); R = (st >> 1) * 16 + swz / 64; C = (st & 1) * 32 + (swz % 64) / 2; }
__host__ __device__ __forceinline__ int perm32(int rho) { const int n = rho >> 4, i = rho & 15; return 8 * (i >> 2) + 4 * n + (i & 3); }

struct Unit { int pm, pn, po; };
struct Gemm { const bf16_t* A; const bf16_t* Bt; int M, N, K; int lda = 0, ldb = 0; };

struct StaticOrder {
    int nM, nN, nwg, G, c;
    __device__ void init(int M, int N, int G_, int c_) { nM = M / BM; nN = N / BM; nwg = nM * nN; G = G_; c = c_; }
    __device__ bool next(int i, Unit& u) const {
        const long L = (long)i * G + c; if (L >= nwg) return false;
        int wgid = (int)L; { const int q = nwg / NXCD, r = nwg % NXCD, xcd = wgid % NXCD, off = wgid / NXCD; wgid = (xcd < r ? xcd * (q + 1) : r * (q + 1) + (xcd - r) * q) + off; }
        const int nig = WGM * nN, gid = wgid / nig, fm = gid * WGM, gsz = (nM - fm) < WGM ? (nM - fm) : WGM;
        u.pm = fm + ((wgid % nig) % gsz); u.pn = (wgid % nig) / gsz; u.po = u.pn; return true;
    }
    __device__ __forceinline__ void a_ready(const Unit&) const {}
    __device__ __forceinline__ void done(const Unit&) const {}
};
struct MoeOrder {
    const PG8_LAS int* tab; int NT, G, c;
    __device__ bool next(int i, Unit& u) const {
        const int L = i * G + c; if (L >= tab[17]) return false;
        int e = 0;
#pragma unroll
        for (int j = 1; j < 8; ++j) e += (L >= tab[9 + j]) ? 1 : 0;
        const int l = L - tab[9 + e], tiles = tab[e + 1] - tab[e];
        const int mt = l % tiles, pl = l / tiles;
        u.pm = tab[e] + mt; u.pn = e * NT + pl; u.po = pl; return true;
    }
    __device__ __forceinline__ void a_ready(const Unit&) const {}
    __device__ __forceinline__ void done(const Unit&) const {}
};

typedef float f32x2cv __attribute__((ext_vector_type(2))); typedef __bf16 bf16x2cv __attribute__((ext_vector_type(2)));
__device__ __forceinline__ unsigned cvt_pk_bf16(float lo, float hi) { const f32x2cv v = {lo, hi}; const bf16x2cv b = __builtin_convertvector(v, bf16x2cv); return __builtin_bit_cast(unsigned, b); }
typedef int i32x8 __attribute__((ext_vector_type(8)));
__device__ __forceinline__ i32x8 cat8(bf16x8 a, bf16x8 b) { const u32x4 x = __builtin_bit_cast(u32x4, a), y = __builtin_bit_cast(u32x4, b); return (i32x8){(int)x.x, (int)x.y, (int)x.z, (int)x.w, (int)y.x, (int)y.y, (int)y.z, (int)y.w}; }
__device__ __forceinline__ unsigned pk_fp8x4(float a, float b, float c, float d) { int r = __builtin_amdgcn_cvt_pk_fp8_f32(a, b, 0, false); r = __builtin_amdgcn_cvt_pk_fp8_f32(c, d, r, true); return (unsigned)r; }
__device__ __forceinline__ float bflo(unsigned w) { return __uint_as_float(w << 16); }
__device__ __forceinline__ float bfhi(unsigned w) { return __uint_as_float(w & 0xffff0000u); }
__device__ __forceinline__ float sigm(float x) { return __builtin_amdgcn_rcpf(1.0f + __expf(-x)); }

struct EpiStoreBf16 {
    static constexpr bool PERM = true, AFTER_DRAIN = false;
    bf16_t* O; int ldc; float scale = 1.0f;
    __device__ __forceinline__ void operator()(const f32x4 (&acc)[2][2][4][2], const Unit& u, int wr, int wc, int fr, int fq) const {
        const int row0 = u.pm * BM + wr * 64 + fr, col0 = u.po * BM + wc * 32 + 8 * fq;
#pragma unroll
        for (int ai = 0; ai < 2; ++ai)
#pragma unroll
            for (int m = 0; m < 4; ++m) { bf16_t* rowp = O + (size_t)(row0 + ai * HALF + m * 16) * ldc + col0;
#pragma unroll
                for (int bj = 0; bj < 2; ++bj) { const f32x4 v0 = acc[ai][bj][m][0] * scale, v1 = acc[ai][bj][m][1] * scale;
                    u32x4 w; w.x = cvt_pk_bf16(v0[0], v0[1]); w.y = cvt_pk_bf16(v0[2], v0[3]); w.z = cvt_pk_bf16(v1[0], v1[1]); w.w = cvt_pk_bf16(v1[2], v1[3]);
                    *(u32x4*)(rowp + bj * HALF) = w; } }
    }
};
struct EpiProj {
    static constexpr bool PERM = true, AFTER_DRAIN = false;
    bf16_t* base; int T_, SEQ_; float scale = 1.0f; float kvscale = 8.0f;
    __device__ __forceinline__ void seg(int col, int b, size_t& off, int& pitch, bool& f8) const {
        const size_t T = (size_t)T_; f8 = false;
        if (col < 1024) { off = (size_t)col * 2; pitch = 2048; }
        else if (col < 1536) { const int v = col >= 1280, cc = (col - (v ? 1280 : 1024)) >> 7, d = (col - (v ? 1280 : 1024)) & 127; off = T * (v ? 1280 : 1024) * 2 + (size_t)(b + cc) * SEQ_ * 128 + d; pitch = 128; f8 = true; }
        else if (col < 2048) { off = (T * 1536 + (col - 1536)) * 2; pitch = 1024; }
        else if (col < 2112) { off = (T * 2048 + (col - 2048)) * 2; pitch = 128; }
        else if (col < 2120) { off = (T * 2112 + (col - 2112)) * 2; pitch = 16; }
        else if (col < 5480) { off = (T * 2120 + (col - 2120)) * 2; pitch = 6720; }
        else if (col < 7528) { off = (T * 5480 + (col - 5480)) * 2; pitch = 4096; }
        else if (col < 9576) { off = (T * 7528 + (col - 7528)) * 2; pitch = 4096; }
        else { off = 0; pitch = 0; }
    }
    __device__ __forceinline__ void operator()(const f32x4 (&acc)[2][2][4][2], const Unit& u, int wr, int wc, int fr, int fq) const {
        const int row0 = u.pm * BM + wr * 64 + fr, col0 = u.po * BM + wc * 32 + 8 * fq, b = (u.pm * BM) / SEQ_;
        unsigned char* bb = (unsigned char*)base;
#pragma unroll
        for (int bj = 0; bj < 2; ++bj) { size_t off; int pitch; bool f8; seg(col0 + bj * HALF, b, off, pitch, f8);
            if (pitch) {
#pragma unroll
                for (int ai = 0; ai < 2; ++ai)
#pragma unroll
                    for (int m = 0; m < 4; ++m) { const f32x4 v0 = acc[ai][bj][m][0] * scale, v1 = acc[ai][bj][m][1] * scale; unsigned char* dst = bb + off + (size_t)(row0 + ai * HALF + m * 16) * pitch;
                        if (f8) { u32x2 w; w.x = pk_fp8x4(v0[0] * kvscale, v0[1] * kvscale, v0[2] * kvscale, v0[3] * kvscale); w.y = pk_fp8x4(v1[0] * kvscale, v1[1] * kvscale, v1[2] * kvscale, v1[3] * kvscale); *(u32x2*)dst = w; }
                        else { u32x4 w; w.x = cvt_pk_bf16(v0[0], v0[1]); w.y = cvt_pk_bf16(v0[2], v0[3]); w.z = cvt_pk_bf16(v1[0], v1[1]); w.w = cvt_pk_bf16(v1[2], v1[3]); *(u32x4*)dst = w; } } } }
    }
};
template <bool ADD> struct EpiGate {
    static constexpr bool PERM = true, AFTER_DRAIN = false;
    bf16_t* O; int ldc; const bf16_t* gate; int ldg;
    __device__ __forceinline__ void operator()(const f32x4 (&acc)[2][2][4][2], const Unit& u, int wr, int wc, int fr, int fq) const {
        const int row0 = u.pm * BM + wr * 64 + fr, col0 = u.po * BM + wc * 32 + 8 * fq;
#pragma unroll
        for (int ai = 0; ai < 2; ++ai) {
            u32x4 g[4][2], o[4][2];
#pragma unroll
            for (int m = 0; m < 4; ++m) { const size_t row = (size_t)(row0 + ai * HALF + m * 16);
#pragma unroll
                for (int bj = 0; bj < 2; ++bj) { g[m][bj] = *(const u32x4*)(gate + row * ldg + col0 + bj * HALF); if (ADD) o[m][bj] = *(const u32x4*)(O + row * ldc + col0 + bj * HALF); } }
            __builtin_amdgcn_sched_barrier(0);
#pragma unroll
            for (int m = 0; m < 4; ++m) { const size_t row = (size_t)(row0 + ai * HALF + m * 16); bf16_t* rowp = O + row * ldc + col0;
#pragma unroll
                for (int bj = 0; bj < 2; ++bj) { const f32x4 v0 = acc[ai][bj][m][0], v1 = acc[ai][bj][m][1];
                    const u32x4 gg = g[m][bj];
                    float r[8];
                    r[0] = sigm(bflo(gg.x)) * v0[0]; r[1] = sigm(bfhi(gg.x)) * v0[1]; r[2] = sigm(bflo(gg.y)) * v0[2]; r[3] = sigm(bfhi(gg.y)) * v0[3];
                    r[4] = sigm(bflo(gg.z)) * v1[0]; r[5] = sigm(bfhi(gg.z)) * v1[1]; r[6] = sigm(bflo(gg.w)) * v1[2]; r[7] = sigm(bfhi(gg.w)) * v1[3];
                    if (ADD) { const u32x4 oo = o[m][bj];
                        r[0] += bflo(oo.x); r[1] += bfhi(oo.x); r[2] += bflo(oo.y); r[3] += bfhi(oo.y); r[4] += bflo(oo.z); r[5] += bfhi(oo.z); r[6] += bflo(oo.w); r[7] += bfhi(oo.w); }
                    u32x4 w; w.x = cvt_pk_bf16(r[0], r[1]); w.y = cvt_pk_bf16(r[2], r[3]); w.z = cvt_pk_bf16(r[4], r[5]); w.w = cvt_pk_bf16(r[6], r[7]);
                    *(u32x4*)(rowp + bj * HALF) = w; } }
            __builtin_amdgcn_sched_barrier(0);
        }
    }
};
struct EpiResid {
    static constexpr bool PERM = false, AFTER_DRAIN = false;
    const float* in; float* out; int ldc; float scale = 1.0f;
    __device__ __forceinline__ void operator()(const f32x4 (&acc)[2][2][4][2], const Unit& u, int wr, int wc, int fr, int fq) const {
        const int row0 = u.pm * BM + wr * 64 + fr, col0 = u.po * BM + wc * 32 + 4 * fq;
#pragma unroll
        for (int ai = 0; ai < 2; ++ai) {
            f32x4 b[4][2][2];
#pragma unroll
            for (int m = 0; m < 4; ++m) { const size_t off = (size_t)(row0 + ai * HALF + m * 16) * ldc + col0;
#pragma unroll
                for (int bj = 0; bj < 2; ++bj)
#pragma unroll
                    for (int n = 0; n < 2; ++n) b[m][bj][n] = *(const f32x4*)(in + off + bj * HALF + n * 16); }
            __builtin_amdgcn_sched_barrier(0);
#pragma unroll
            for (int m = 0; m < 4; ++m) { const size_t off = (size_t)(row0 + ai * HALF + m * 16) * ldc + col0;
#pragma unroll
                for (int bj = 0; bj < 2; ++bj)
#pragma unroll
                    for (int n = 0; n < 2; ++n) *(f32x4*)(out + off + bj * HALF + n * 16) = b[m][bj][n] + acc[ai][bj][m][n] * scale; }
            __builtin_amdgcn_sched_barrier(0);
        }
    }
};
struct EpiSwiglu {
    static constexpr bool PERM = true, AFTER_DRAIN = false;
    bf16_t* U; int ldc;
    __device__ __forceinline__ void operator()(const f32x4 (&acc)[2][2][4][2], const Unit& u, int wr, int wc, int fr, int fq) const {
        const int row0 = u.pm * BM + wr * 64 + fr, col0 = u.po * HALF + wc * 32 + 8 * fq;
#pragma unroll
        for (int ai = 0; ai < 2; ++ai)
#pragma unroll
            for (int m = 0; m < 4; ++m) { bf16_t* rowp = U + (size_t)(row0 + ai * HALF + m * 16) * ldc + col0;
                float r[8];
#pragma unroll
                for (int n = 0; n < 2; ++n)
#pragma unroll
                    for (int j = 0; j < 4; ++j) { const float g = acc[ai][0][m][n][j], x = acc[ai][1][m][n][j]; r[4 * n + j] = g * sigm(g) * x; }
                u32x4 w; w.x = cvt_pk_bf16(r[0], r[1]); w.y = cvt_pk_bf16(r[2], r[3]); w.z = cvt_pk_bf16(r[4], r[5]); w.w = cvt_pk_bf16(r[6], r[7]);
                *(u32x4*)rowp = w; }
    }
};
struct EpiSwigluF8 {
    static constexpr bool PERM = true, AFTER_DRAIN = false;
    unsigned char* U; int ldc; float iscale, oscale;
    __device__ __forceinline__ void operator()(const f32x4 (&acc)[2][2][4][2], const Unit& u, int wr, int wc, int fr, int fq) const {
        const int row0 = u.pm * BM + wr * 64 + fr, col0 = u.po * HALF + wc * 32 + 8 * fq;
#pragma unroll
        for (int ai = 0; ai < 2; ++ai)
#pragma unroll
            for (int m = 0; m < 4; ++m) { unsigned char* rowp = U + (size_t)(row0 + ai * HALF + m * 16) * ldc + col0;
                float r[8];
#pragma unroll
                for (int n = 0; n < 2; ++n)
#pragma unroll
                    for (int j = 0; j < 4; ++j) { const float g = acc[ai][0][m][n][j] * iscale, x = acc[ai][1][m][n][j] * iscale; r[4 * n + j] = g * sigm(g) * x * oscale; }
                u32x2 w; w.x = pk_fp8x4(r[0], r[1], r[2], r[3]); w.y = pk_fp8x4(r[4], r[5], r[6], r[7]);
                *(u32x2*)rowp = w; }
    }
};
struct EpiPle {
    static constexpr bool PERM = false, AFTER_DRAIN = false;
    float* h; const bf16_t* pp; int ldc; float scale = 1.0f;
    __device__ __forceinline__ void operator()(const f32x4 (&acc)[2][2][4][2], const Unit& u, int wr, int wc, int fr, int fq) const {
        const int row0 = u.pm * BM + wr * 64 + fr, col0 = u.po * BM + wc * 32 + 4 * fq;
#pragma unroll
        for (int ai = 0; ai < 2; ++ai)
#pragma unroll
            for (int mh = 0; mh < 2; ++mh) {
                f32x4 b[2][2][2]; u32x2 p[2][2][2];
#pragma unroll
                for (int m = 0; m < 2; ++m) { const size_t off = (size_t)(row0 + ai * HALF + (2 * mh + m) * 16) * ldc + col0;
#pragma unroll
                    for (int bj = 0; bj < 2; ++bj)
#pragma unroll
                        for (int n = 0; n < 2; ++n) { const size_t o = off + bj * HALF + n * 16; b[m][bj][n] = *(const f32x4*)(h + o); p[m][bj][n] = *(const u32x2*)(pp + o); } }
                __builtin_amdgcn_sched_barrier(0);
#pragma unroll
                for (int m = 0; m < 2; ++m) { const size_t off = (size_t)(row0 + ai * HALF + (2 * mh + m) * 16) * ldc + col0;
#pragma unroll
                    for (int bj = 0; bj < 2; ++bj)
#pragma unroll
                        for (int n = 0; n < 2; ++n) { const size_t o = off + bj * HALF + n * 16; const f32x4 bb = b[m][bj][n]; const u32x2 pq = p[m][bj][n]; const f32x4 a = acc[ai][bj][2 * mh + m][n] * scale;
                            f32x4 r; r[0] = bb[0] + sigm(a[0]) * bflo(pq.x); r[1] = bb[1] + sigm(a[1]) * bfhi(pq.x); r[2] = bb[2] + sigm(a[2]) * bflo(pq.y); r[3] = bb[3] + sigm(a[3]) * bfhi(pq.y);
                            *(f32x4*)(h + o) = r; } }
                __builtin_amdgcn_sched_barrier(0);
            }
    }
};

template <class Epi, class Sched, bool ALIGN_EPI = false, bool SP2 = false, bool F8 = false>
__device__ __forceinline__ void gemm_phase(PG8_LAS unsigned char* lds, const Gemm g, const Sched& S, const Epi& E) {
    int tid_ = threadIdx.x; asm volatile("" : "+v"(tid_));
    const int tid = tid_, wid = __builtin_amdgcn_readfirstlane(tid >> 6), lane = tid & 63, wr = wid >> 2, wc = wid & 3, fr = lane & 15, fq = lane >> 4;
    const int K = g.K, nt = K / BK, lda = g.lda ? g.lda : K, ldb = g.ldb ? g.ldb : K;
    unsigned voffA[2], voffB[2];
#pragma unroll
    for (int i = 0; i < 2; ++i) { int R, C; stage_rc(tid * 16 + i * 8192, R, C); const int Rb = Epi::PERM ? ((R & ~31) + perm32(R & 31)) : R;
        voffA[i] = (unsigned)(R * lda + C) * 2u; voffB[i] = (unsigned)(Rb * ldb + C) * 2u; }
    const size_t kstep = (size_t)(BK * 2);
    const size_t hstepA = (size_t)HALF * lda * 2, hstepB = (size_t)HALF * ldb * 2;
    const size_t tstepA = 2 * hstepA, tstepB = 2 * hstepB;
    const unsigned ldsw = (unsigned)wid * 1024u;
    const int aoff = lds_byte(wr * 64 + fr, fq * 8), boff = lds_byte(wc * 32 + fr, fq * 8);
#define PG8_SA(b, h) (((b) * 2 + (h)) * HTB)
#define PG8_SB(b, h) ((4 + (b) * 2 + (h)) * HTB)
#define PG8_STAGE(bufoff, gbase, voff) do { _Pragma("unroll") for (int _i = 0; _i < 2; ++_i) \
        __builtin_amdgcn_global_load_lds((const unsigned*)((const char*)(gbase) + (voff)[_i]), (PG8_LAS unsigned*)(lds + (bufoff) + ldsw + _i * 8192), 16, 0, 0); } while (0)
#define PG8_LDA(dst, b, h) do { _Pragma("unroll") for (int m = 0; m < 4; ++m) { if constexpr (F8) { const u32x4 x_ = *(const PG8_LAS u32x4*)(lds + PG8_SA(b, h) + aoff + m * 2048), y_ = *(const PG8_LAS u32x4*)(lds + PG8_SA(b, h) + aoff + m * 2048 + 1024); \
        dst##8[m] = (i32x8){(int)x_.x, (int)x_.y, (int)x_.z, (int)x_.w, (int)y_.x, (int)y_.y, (int)y_.z, (int)y_.w}; } \
        else { _Pragma("unroll") for (int k = 0; k < 2; ++k) dst[m][k] = *(const PG8_LAS bf16x8*)(lds + PG8_SA(b, h) + aoff + m * 2048 + k * 1024); } } } while (0)
#define PG8_LDB(dst, b, h) do { _Pragma("unroll") for (int n = 0; n < 2; ++n) { if constexpr (F8) { const u32x4 x_ = *(const PG8_LAS u32x4*)(lds + PG8_SB(b, h) + boff + n * 2048), y_ = *(const PG8_LAS u32x4*)(lds + PG8_SB(b, h) + boff + n * 2048 + 1024); \
        dst##8[n] = (i32x8){(int)x_.x, (int)x_.y, (int)x_.z, (int)x_.w, (int)y_.x, (int)y_.y, (int)y_.z, (int)y_.w}; } \
        else { _Pragma("unroll") for (int k = 0; k < 2; ++k) dst[n][k] = *(const PG8_LAS bf16x8*)(lds + PG8_SB(b, h) + boff + n * 2048 + k * 1024); } } } while (0)
#define PG8_MMA(ai, bj, At, Bt) do { __builtin_amdgcn_s_setprio(1); _Pragma("unroll") for (int m = 0; m < 4; ++m) _Pragma("unroll") for (int n = 0; n < 2; ++n) { \
        if constexpr (F8) { asm volatile("v_mfma_scale_f32_16x16x128_f8f6f4 %0, %1, %2, %0, %3, %3 op_sel_hi:[0,0,0]" : "+v"(acc[ai][bj][m][n]) : "v"(Bt##8[n]), "v"(At##8[m]), "v"(f8sc)); } \
        else { _Pragma("unroll") for (int k = 0; k < 2; ++k) acc[ai][bj][m][n] = __builtin_amdgcn_mfma_f32_16x16x32_bf16(Bt[n][k], At[m][k], acc[ai][bj][m][n], 0, 0, 0); } } \
        __builtin_amdgcn_s_setprio(0); } while (0)
#define PG8_WAIT_V(n) asm volatile("s_waitcnt vmcnt(" #n ")" ::: "memory")
#define PG8_WAIT_L(n) asm volatile("s_waitcnt lgkmcnt(" #n ")" ::: "memory")
#define PG8_BAR __builtin_amdgcn_s_barrier()
#define PG8_SCHED __builtin_amdgcn_sched_barrier(0)
    Unit cur, nxt; int ui = 0;
    if (!S.next(0, cur)) return;
    f32x4 acc[2][2][4][2];
#pragma unroll
    for (int a = 0; a < 2; ++a)
#pragma unroll
        for (int b = 0; b < 2; ++b)
#pragma unroll
            for (int m = 0; m < 4; ++m)
#pragma unroll
                for (int n = 0; n < 2; ++n) acc[a][b][m][n] = (f32x4){0.f, 0.f, 0.f, 0.f};
    const int f8sc = 0x7f7f7f7f; (void)f8sc;
    bf16x8 At[4][2], B0[2][2], B1[2][2]; i32x8 At8[4], B08[2], B18[2]; (void)At; (void)B0; (void)B1; (void)At8; (void)B08; (void)B18;
    const char* cA = (const char*)g.A + (size_t)cur.pm * tstepA; const char* cB = (const char*)g.Bt + (size_t)cur.pn * tstepB;
    S.a_ready(cur);
    if constexpr (SP2) {
        PG8_STAGE(PG8_SB(0, 0), cB, voffB); PG8_STAGE(PG8_SB(0, 1), cB + hstepB, voffB); PG8_STAGE(PG8_SA(0, 0), cA, voffA); PG8_STAGE(PG8_SA(0, 1), cA + hstepA, voffA);
        if (wr == 1) PG8_BAR;
        PG8_WAIT_V(2); PG8_BAR;
        PG8_STAGE(PG8_SB(1, 0), cB + kstep, voffB); PG8_STAGE(PG8_SA(1, 0), cA + kstep, voffA); PG8_STAGE(PG8_SB(1, 1), cB + hstepB + kstep, voffB);
        PG8_WAIT_V(6); PG8_BAR;
    } else {
        PG8_STAGE(PG8_SB(0, 0), cB, voffB); PG8_STAGE(PG8_SA(0, 0), cA, voffA); PG8_STAGE(PG8_SB(0, 1), cB + hstepB, voffB); PG8_STAGE(PG8_SA(0, 1), cA + hstepA, voffA);
        if (wr == 1) PG8_BAR;
        PG8_WAIT_V(4); PG8_BAR;
        PG8_STAGE(PG8_SB(1, 0), cB + kstep, voffB); PG8_STAGE(PG8_SA(1, 0), cA + kstep, voffA); PG8_STAGE(PG8_SB(1, 1), cB + hstepB + kstep, voffB);
        PG8_WAIT_V(6); PG8_BAR;
    }
    for (;;) {
        const bool has_next = S.next(ui + 1, nxt);
        const char* nA = has_next ? (const char*)g.A + (size_t)nxt.pm * tstepA : cA; const char* nB = has_next ? (const char*)g.Bt + (size_t)nxt.pn * tstepB : cB;
        for (int t = 0; t < nt; t += 2) {
            const bool last = (t == nt - 2);
            const char* a1 = cA + (size_t)(t + 1) * kstep;
            const char* a2 = last ? nA : cA + (size_t)(t + 2) * kstep; const char* b2 = last ? nB : cB + (size_t)(t + 2) * kstep;
            const char* a3 = a2 + kstep; const char* b3 = b2 + kstep;
            if (last && has_next) S.a_ready(nxt);
            if constexpr (SP2) {
            PG8_LDB(B0, 0, 0); PG8_LDB(B1, 0, 1); PG8_SCHED; PG8_LDA(At, 0, 0); PG8_STAGE(PG8_SA(1, 1), a1 + hstepA, voffA);
            PG8_WAIT_V(8); PG8_WAIT_L(0); PG8_BAR; PG8_MMA(0, 0, At, B0); PG8_MMA(0, 1, At, B1); PG8_BAR; PG8_SCHED;
            PG8_LDA(At, 0, 1); PG8_STAGE(PG8_SB(0, 0), b2, voffB); PG8_STAGE(PG8_SB(0, 1), b2 + hstepB, voffB); PG8_STAGE(PG8_SA(0, 0), a2, voffA);
            PG8_WAIT_V(8); PG8_WAIT_L(0); PG8_BAR; PG8_MMA(1, 0, At, B0); PG8_MMA(1, 1, At, B1); PG8_BAR; PG8_SCHED;
            PG8_LDB(B0, 1, 0); PG8_LDB(B1, 1, 1); PG8_SCHED; PG8_LDA(At, 1, 0); PG8_STAGE(PG8_SA(0, 1), a2 + hstepA, voffA);
            PG8_WAIT_V(8); PG8_WAIT_L(0); PG8_BAR; PG8_MMA(0, 0, At, B0); PG8_MMA(0, 1, At, B1); PG8_BAR; PG8_SCHED;
            PG8_LDA(At, 1, 1); PG8_STAGE(PG8_SB(1, 0), b3, voffB); PG8_STAGE(PG8_SB(1, 1), b3 + hstepB, voffB); PG8_STAGE(PG8_SA(1, 0), a3, voffA);
            PG8_WAIT_V(8); PG8_WAIT_L(0); PG8_BAR; PG8_MMA(1, 0, At, B0); PG8_MMA(1, 1, At, B1); PG8_BAR; PG8_SCHED;
            } else {
            PG8_LDB(B0, 0, 0); PG8_SCHED; PG8_LDA(At, 0, 0); PG8_STAGE(PG8_SA(1, 1), a1 + hstepA, voffA);
            PG8_WAIT_L(8); PG8_BAR; PG8_WAIT_L(0); PG8_MMA(0, 0, At, B0); PG8_BAR; PG8_SCHED;
            PG8_LDB(B1, 0, 1); PG8_STAGE(PG8_SB(0, 0), b2, voffB);
            PG8_BAR; PG8_WAIT_L(0); PG8_MMA(0, 1, At, B1); PG8_BAR;
            PG8_LDA(At, 0, 1); PG8_STAGE(PG8_SA(0, 0), a2, voffA);
            PG8_BAR; PG8_WAIT_L(0); PG8_MMA(1, 0, At, B0); PG8_BAR; PG8_SCHED;
            PG8_STAGE(PG8_SB(0, 1), b2 + hstepB, voffB);
            PG8_WAIT_V(6); PG8_BAR; PG8_MMA(1, 1, At, B1); PG8_BAR;
            PG8_LDB(B0, 1, 0); PG8_SCHED; PG8_LDA(At, 1, 0); PG8_STAGE(PG8_SA(0, 1), a2 + hstepA, voffA);
            PG8_WAIT_L(8); PG8_BAR; PG8_WAIT_L(0); PG8_MMA(0, 0, At, B0); PG8_BAR; PG8_SCHED;
            PG8_LDB(B1, 1, 1); PG8_STAGE(PG8_SB(1, 0), b3, voffB);
            PG8_BAR; PG8_WAIT_L(0); PG8_MMA(0, 1, At, B1); PG8_BAR;
            PG8_LDA(At, 1, 1); PG8_STAGE(PG8_SA(1, 0), a3, voffA);
            PG8_BAR; PG8_WAIT_L(0); PG8_MMA(1, 0, At, B0); PG8_BAR; PG8_SCHED;
            PG8_STAGE(PG8_SB(1, 1), b3 + hstepB, voffB);
            PG8_WAIT_V(6); PG8_BAR; PG8_MMA(1, 1, At, B1); PG8_BAR;
            }
        }
        if constexpr (ALIGN_EPI) { if (wr == 0) PG8_BAR; }
        if constexpr (F8) asm volatile("s_nop 15\n\ts_nop 15" ::: "memory");
        E(acc, cur, wr, wc, fr, fq); S.done(cur);
        if (!has_next) break;
#pragma unroll
        for (int a = 0; a < 2; ++a)
#pragma unroll
            for (int b = 0; b < 2; ++b)
#pragma unroll
                for (int m = 0; m < 4; ++m)
#pragma unroll
                    for (int n = 0; n < 2; ++n) acc[a][b][m][n] = (f32x4){0.f, 0.f, 0.f, 0.f};
        cur = nxt; cA = nA; cB = nB; ++ui;
        if constexpr (ALIGN_EPI) { if (wr == 1) PG8_BAR; }
    }
    PG8_WAIT_V(0);
    if constexpr (!ALIGN_EPI) { if (wr == 0) PG8_BAR; }
    PG8_BAR;
#undef PG8_SA
#undef PG8_SB
#undef PG8_STAGE
#undef PG8_LDA
#undef PG8_LDB
#undef PG8_MMA
#undef PG8_WAIT_V
#undef PG8_WAIT_L
#undef PG8_BAR
#undef PG8_SCHED
}
}

constexpr int NB = 2, SEQ = 8192, T = NB * SEQ, D = 2048, DEPTH = 2;
constexpr int PW = 9728, IN_W = 9576;
constexpr int C_Q = 0, C_K = 1024, C_V = 1280, C_QI = 1536, C_KI = 2048, C_WI = 2112, C_SLAB = 2120, C_GA = 5480, C_GB = 7528;
constexpr size_t O_Q = 0, O_K = (size_t)T * 1024, O_V = O_K + (size_t)T * 256, O_QI = O_V + (size_t)T * 256, O_KI = O_QI + (size_t)T * 512, O_WI = O_KI + (size_t)T * 64, O_SL = O_WI + (size_t)T * 8,
                 O_GA = O_SL + (size_t)T * 3360, O_GB = O_GA + (size_t)T * 2048;
constexpr int S_R = 0, S_K = 1024, S_V = 2048, S_XW = 3072, SLAB_W = 3360;
constexpr int DFF = 5632, DFE = 7168, NE = 8;
constexpr int LRK = 384, LRN = 3072;
constexpr int MOE_ROWS = 34816;
constexpr int KPAD = 64;
constexpr int XGP = D + 2 * KPAD;
constexpr int NSEL = 256;
constexpr float MOE_AS = 8.0f, MOE_WS13 = 512.0f, MOE_WS2 = 1024.0f;
constexpr float PLE_AS = 8.0f, PLE_WS = 512.0f;
constexpr float RMS_EPS = 1e-6f, GN_EPS = 64e-5f;
constexpr int SREC = 896;

constexpr size_t MiB = 1u << 20;
constexpr size_t WS_CTL = 0, CTL_ZERO_BYTES = 65536;
constexpr size_t WS_ROUTE = 1 * MiB;
constexpr size_t WS_WIN = 4 * MiB, WS_UATT = 80 * MiB, WS_URW = 88 * MiB, WS_WOUT = 96 * MiB, WS_PLEG = 112 * MiB, WS_PLEP = 128 * MiB, WS_LRT = 130 * MiB;
constexpr size_t WS_F13 = 135 * MiB, WS_F2 = 179 * MiB, WS_M13 = 201 * MiB, WS_M2 = 649 * MiB, WS_PB = 873 * MiB, WS_XN = 889 * MiB, WS_ARENA = 953 * MiB;
constexpr size_t WS_PROJ = WS_ARENA, WS_SCANIN = WS_ARENA + 304 * MiB, WS_LR = WS_ARENA + 528 * MiB, WS_YS = WS_ARENA + 624 * MiB, WS_ATT = WS_ARENA + 688 * MiB, WS_IDX = WS_ARENA + 720 * MiB,
                 WS_CHK = WS_ARENA + 728 * MiB, WS_RW = WS_ARENA + 728 * MiB, WS_M1 = WS_ARENA + 760 * MiB;
constexpr size_t WS_UD = WS_ARENA, WS_XG = WS_ARENA, WS_UM = WS_ARENA + 136 * MiB, WS_YM = WS_ARENA + 612 * MiB, WS_PP = WS_ARENA, WS_LRA = WS_XN;
constexpr size_t WS_END = WS_ARENA + 920 * MiB;
constexpr size_t LRT_BYTES = (size_t)LRN * LRK * 2;
constexpr int CW_TMO = 0, CW_MOECNT = 64, CW_ATTQ = 8192, CW_BAR = 4096;
constexpr int RING_BYTES = 131072, MISC_OFF = RING_BYTES, BIAS_OFF = MISC_OFF + 256, JOB_OFF = MISC_OFF + 256, LDS_BYTES = 147456;

#define GAS __attribute__((address_space(1)))
#define LAS __attribute__((address_space(3)))
typedef unsigned short bf16;
typedef unsigned v4u __attribute__((ext_vector_type(4)));
typedef unsigned v2u __attribute__((ext_vector_type(2)));
typedef float f32x4 __attribute__((ext_vector_type(4)));
typedef float f32x16 __attribute__((ext_vector_type(16)));
typedef short bf16x8 __attribute__((ext_vector_type(8)));
#define LDS_WAIT() asm volatile("s_waitcnt lgkmcnt(0)" ::: "memory")
#define VM_WAIT() asm volatile("s_waitcnt vmcnt(0)" ::: "memory")
using pg8::cvt_pk_bf16; using pg8::bflo; using pg8::bfhi; using pg8::sigm;
__device__ __forceinline__ float bf2f(unsigned short b) { return __uint_as_float(((unsigned)b) << 16); }
__device__ __forceinline__ unsigned short f2bf(float f) { return (unsigned short)(cvt_pk_bf16(f, 0.f) & 0xffffu); }

#define XB_TMO      128
#define XB_XCNT(j)  (256  + 64 * (j))
#define XB_XSUB(j)  (1280 + 64 * (j))
#define XB_XGEN(j)  (2304 + 64 * (j))
#define XB_TOP      3328
#define XB_TOPGEN   3392
#define XCD_BAR_WORDS 3456
#define XB_SPIN_CAP (1u << 18)
__device__ __forceinline__ unsigned xb_ld(unsigned* p)              { return __hip_atomic_load(p, __ATOMIC_RELAXED, __HIP_MEMORY_SCOPE_AGENT); }
__device__ __forceinline__ unsigned xb_add(unsigned* p, unsigned v) { return __hip_atomic_fetch_add(p, v, __ATOMIC_RELAXED, __HIP_MEMORY_SCOPE_AGENT); }
__device__ __forceinline__ unsigned xb_xcc_id() { return (unsigned)__builtin_amdgcn_s_getreg((3 << 11) | 20) & 0xFu; }
#define XB_SPIN(cond, bar) do { unsigned _sp = 0; while (cond) { __builtin_amdgcn_s_sleep(1); \
    if ((++_sp & 255u) == 0u) { if (xb_ld(&(bar)[XB_TMO])) break; if (_sp > XB_SPIN_CAP) { atomicAdd(&(bar)[XB_TMO], 1u); break; } } } } while (0)
struct XcdBarrier { unsigned* bar; unsigned x; volatile LAS unsigned* st; };
__device__ __forceinline__ XcdBarrier xcd_barrier_post(unsigned* bar, volatile LAS unsigned* st) {
    XcdBarrier b; b.bar = bar; b.x = xb_xcc_id(); b.st = st;
    if (threadIdx.x == 0) (void)xb_add(&bar[XB_XCNT(b.x)], 1u);
    return b;
}
__device__ __forceinline__ void xcd_barrier_complete(unsigned* bar, unsigned x, unsigned& nloc, unsigned& nx) {
    const unsigned G = gridDim.x * gridDim.y * gridDim.z;
    unsigned sum, cnt, mine, sp = 0u;
    for (;;) {
        sum = 0u; cnt = 0u; mine = 0u;
#pragma unroll
        for (unsigned j = 0; j < 16; ++j) { const unsigned c = xb_ld(&bar[XB_XCNT(j)]); sum += c; cnt += (c > 0u) ? 1u : 0u; mine = (j == x) ? c : mine; }
        if (sum == G) break;
        __builtin_amdgcn_s_sleep(1);
        if ((++sp & 255u) == 0u) { if (xb_ld(&bar[XB_TMO])) break; if (sp > XB_SPIN_CAP) { atomicAdd(&bar[XB_TMO], 1u); break; } }
    }
    nloc = mine > 0u ? mine : 1u; nx = cnt > 0u ? cnt : 1u;
}
__device__ __forceinline__ void xcd_barrier(const XcdBarrier& b) {
    asm volatile("s_waitcnt vmcnt(0)" ::: "memory");
    __syncthreads();
    if (threadIdx.x == 0) {
        unsigned* bar = b.bar;
        __builtin_amdgcn_s_waitcnt(0);
        unsigned nloc = b.st[0], nx = b.st[1];
        if (nloc == 0u) { xcd_barrier_complete(bar, b.x, nloc, nx); b.st[0] = nloc; b.st[1] = nx; }
        const unsigned old = xb_add(&bar[XB_XSUB(b.x)], 1u);
        const unsigned gen = old / nloc;
        if (old + 1u == (gen + 1u) * nloc) {
            __builtin_amdgcn_fence(__ATOMIC_RELEASE, "agent");
            asm volatile("s_waitcnt vmcnt(0)" ::: "memory");
            const unsigned og = xb_add(&bar[XB_TOP], 1u);
            const unsigned tg = og / nx;
            if (og + 1u == (tg + 1u) * nx) xb_add(&bar[XB_TOPGEN], 1u);
            else XB_SPIN(xb_ld(&bar[XB_TOPGEN]) == tg, bar);
            __builtin_amdgcn_fence(__ATOMIC_ACQUIRE, "agent");
            xb_add(&bar[XB_XGEN(b.x)], 1u);
            asm volatile("s_waitcnt vmcnt(0)" ::: "memory");
        } else {
            XB_SPIN(xb_ld(&bar[XB_XGEN(b.x)]) == gen, bar);
            __builtin_amdgcn_fence(__ATOMIC_ACQUIRE, "agent");
            asm volatile("s_waitcnt vmcnt(0)" ::: "memory");
        }
    }
    __syncthreads();
}

__device__ __forceinline__ float wave_sum(float v) {
#pragma unroll
    for (int o = 1; o < 64; o <<= 1) v += __shfl_xor(v, o);
    return v;
}
__device__ __forceinline__ float wave_max(float v) {
#pragma unroll
    for (int o = 1; o < 64; o <<= 1) v = fmaxf(v, __shfl_xor(v, o));
    return v;
}
template <int CTRL> __device__ __forceinline__ float dpp_f(float x) { return __int_as_float(__builtin_amdgcn_update_dpp(0, __float_as_int(x), CTRL, 0xf, 0xf, true)); }
template <int CTRL> __device__ __forceinline__ unsigned dpp_u(unsigned x) { return (unsigned)__builtin_amdgcn_update_dpp(0, (int)x, CTRL, 0xf, 0xf, true); }
__device__ __forceinline__ float sum16(float x) { x += dpp_f<0xB1>(x); x += dpp_f<0x4E>(x); x += dpp_f<0x141>(x); x += dpp_f<0x140>(x); return x; }
__device__ __forceinline__ unsigned wave_sum_u(unsigned x) {
    x += dpp_u<0xB1>(x); x += dpp_u<0x4E>(x); x += dpp_u<0x141>(x); x += dpp_u<0x140>(x);
    return (unsigned)__builtin_amdgcn_readlane((int)x, 0) + (unsigned)__builtin_amdgcn_readlane((int)x, 16) + (unsigned)__builtin_amdgcn_readlane((int)x, 32) + (unsigned)__builtin_amdgcn_readlane((int)x, 48);
}

__device__ const unsigned char REL_BUCKET_TAB[113] = {0, 1, 2, 3, 4, 5, 6, 7, 8, 9, 10, 11, 12, 13, 14, 15, 16, 16, 16, 17, 17, 18, 18, 18, 19, 19, 19, 20, 20, 20, 20, 21, 21, 21, 21, 22, 22, 22, 22, 22, 23, 23, 23, 23, 23, 23,
    24, 24, 24, 24, 24, 24, 25, 25, 25, 25, 25, 25, 25, 26, 26, 26, 26, 26, 26, 26, 26, 27, 27, 27, 27, 27, 27, 27, 27, 27, 27, 28, 28, 28, 28, 28, 28, 28, 28, 28, 28, 29, 29, 29, 29, 29, 29, 29, 29, 29, 29, 29, 29,
    30, 30, 30, 30, 30, 30, 30, 30, 30, 30, 30, 30, 30, 30};

struct Args { const float* in[31]; float* out; unsigned char* ws; int ph_lo, ph_hi; };
enum { I_X = 0, I_P, I_WIN, I_UATT, I_URW, I_WOUT, I_RELB, I_MU, I_W0, I_WUP, I_A0, I_AUP, I_GUP, I_KK, I_KA, I_RK, I_GNW, I_GNB, I_NMIX, I_NFFN, I_NPLE, I_PLEP, I_PLEG, I_F1, I_F3, I_F2, I_ROUT, I_M1, I_M3, I_M2, I_FIN };

struct ConvJob { const float* src; bf16* dst; int K, N, mode, end; float f8scale; int pad; };
constexpr int NJOBS = 39;
__device__ __forceinline__ void tr_load(const float* W, int N, int item, int lane, f32x4 (&v)[8]) {
    const int nblk = (N + 31) >> 5, kb = item / nblk, nb = item - kb * nblk, k0 = 64 * kb, n0 = 32 * nb;
    const int rsub = lane >> 3, c4 = lane & 7, nr = n0 + 4 * c4;
    const GAS float* src = (const GAS float*)W + (size_t)(k0 + rsub) * N + (nr < N ? nr : 0);
#pragma unroll
    for (int i = 0; i < 8; ++i) v[i] = *(const GAS f32x4*)(src + (size_t)(8 * i) * N);
}
__device__ __forceinline__ void tr_store(int N, bf16* WT, int dpitch, int mode, LAS float* scr, int item, int lane, float f8scale, const f32x4 (&v)[8]) {
    const int nblk = (N + 31) >> 5, kb = item / nblk, nb = item - kb * nblk, k0 = 64 * kb, n0 = 32 * nb;
    const int rsub = lane >> 3, c4 = lane & 7, nr = n0 + 4 * c4;
    const bool inr = nr < N;
#pragma unroll
    for (int i = 0; i < 8; ++i) { LAS float* d = scr + (8 * i + rsub) * 33 + 4 * c4; d[0] = inr ? v[i][0] : 0.f; d[1] = inr ? v[i][1] : 0.f; d[2] = inr ? v[i][2] : 0.f; d[3] = inr ? v[i][3] : 0.f; }
    LDS_WAIT(); asm volatile("" ::: "memory");
    if (f8scale != 0.f) {
#pragma unroll
        for (int j = 0; j < 2; ++j) { const int ch = lane + 64 * j, nl = ch >> 2, c16 = ch & 3, n = n0 + nl; const LAS float* s = scr + (16 * c16) * 33 + nl;
            v4u o;
            o.x = pg8::pk_fp8x4(s[0 * 33] * f8scale, s[1 * 33] * f8scale, s[2 * 33] * f8scale, s[3 * 33] * f8scale); o.y = pg8::pk_fp8x4(s[4 * 33] * f8scale, s[5 * 33] * f8scale, s[6 * 33] * f8scale, s[7 * 33] * f8scale);
            o.z = pg8::pk_fp8x4(s[8 * 33] * f8scale, s[9 * 33] * f8scale, s[10 * 33] * f8scale, s[11 * 33] * f8scale); o.w = pg8::pk_fp8x4(s[12 * 33] * f8scale, s[13 * 33] * f8scale, s[14 * 33] * f8scale, s[15 * 33] * f8scale);
            if (n < N) { const int drow = mode == 0 ? n : ((n >> 7) * 256 + (n & 127) + (mode == 2 ? 128 : 0)); *(GAS v4u*)((GAS unsigned char*)WT + (size_t)drow * dpitch + k0 + 16 * c16) = o; } }
        LDS_WAIT(); asm volatile("" ::: "memory");
        return;
    }
    const int c = lane & 7;
#pragma unroll
    for (int j = 0; j < 4; ++j) { const int nl = (lane >> 3) + 8 * j, n = n0 + nl; const LAS float* s = scr + (8 * c) * 33 + nl;
        v4u o; o.x = cvt_pk_bf16(s[0 * 33], s[1 * 33]); o.y = cvt_pk_bf16(s[2 * 33], s[3 * 33]); o.z = cvt_pk_bf16(s[4 * 33], s[5 * 33]); o.w = cvt_pk_bf16(s[6 * 33], s[7 * 33]);
        if (n < N) { const int drow = mode == 0 ? n : ((n >> 7) * 256 + (n & 127) + (mode == 2 ? 128 : 0)); *(GAS v4u*)((GAS bf16*)WT + (size_t)drow * dpitch + k0 + 8 * c) = o; } }
    LDS_WAIT(); asm volatile("" ::: "memory");
}
__device__ __forceinline__ void p0_prologue(const Args& a, LAS unsigned char* lds, int tid, int lane, int wave, int G) {
    unsigned char* ws = a.ws;
    LAS ConvJob* jobs = (LAS ConvJob*)(lds + JOB_OFF);
    if (tid == 0) {
        int nj = 0, end = 0;
        { size_t zv = 0; asm volatile("" : "+v"(zv)); ws += zv; }
#define ADDJOB(src_, dst_, K_, N_, mode_) do { end += ((K_) / 64) * (((N_) + 31) / 32); jobs[nj].src = (src_); jobs[nj].dst = (dst_); jobs[nj].K = (K_); jobs[nj].N = (N_); jobs[nj].mode = (mode_); jobs[nj].end = end; jobs[nj].f8scale = 0.f; jobs[nj].pad = 0; ++nj; } while (0)
#define ADDJOB8(src_, dst_, K_, N_, mode_, sc_) do { ADDJOB(src_, dst_, K_, N_, mode_); jobs[nj - 1].f8scale = (sc_); } while (0)
        for (int e = 0; e < NE; ++e) {
            ADDJOB8(a.in[I_M1] + (size_t)e * D * DFE, (bf16*)(ws + WS_M13 + (size_t)e * 2 * DFE * XGP), D, DFE, 1, MOE_WS13); jobs[nj - 1].pad = 2 * KPAD;
            ADDJOB8(a.in[I_M3] + (size_t)e * D * DFE, (bf16*)(ws + WS_M13 + (size_t)e * 2 * DFE * XGP), D, DFE, 2, MOE_WS13); jobs[nj - 1].pad = 2 * KPAD;
            ADDJOB8(a.in[I_M2] + (size_t)e * DFE * D, (bf16*)(ws + WS_M2 + (size_t)e * D * DFE), DFE, D, 0, MOE_WS2);
        }
        ADDJOB(a.in[I_F1], (bf16*)(ws + WS_F13), D, DFF, 1);
        ADDJOB(a.in[I_F3], (bf16*)(ws + WS_F13), D, DFF, 2);
        ADDJOB8(a.in[I_F2], (bf16*)(ws + WS_F2), DFF, D, 0, MOE_WS2);
        for (int l = 0; l < DEPTH; ++l) {
            ADDJOB(a.in[I_WIN] + (size_t)l * D * IN_W, (bf16*)(ws + WS_WIN) + (size_t)l * PW * D, D, IN_W, 0);
            ADDJOB(a.in[I_UATT] + (size_t)l * 1024 * D, (bf16*)(ws + WS_UATT) + (size_t)l * D * 1024, 1024, D, 0);
            ADDJOB(a.in[I_URW] + (size_t)l * 1024 * D, (bf16*)(ws + WS_URW) + (size_t)l * D * 1024, 1024, D, 0);
            ADDJOB(a.in[I_WOUT] + (size_t)l * D * D, (bf16*)(ws + WS_WOUT) + (size_t)l * D * D, D, D, 0);
            if (l == DEPTH - 1) ADDJOB8(a.in[I_PLEG] + (size_t)l * D * D, (bf16*)(ws + WS_PLEG) + (size_t)l * D * D, D, D, 0, PLE_WS);
            else ADDJOB(a.in[I_PLEG] + (size_t)l * D * D, (bf16*)(ws + WS_PLEG) + (size_t)l * D * D, D, D, 0);
            ADDJOB(a.in[I_PLEP] + (size_t)l * 256 * D, (bf16*)(ws + WS_PLEP) + (size_t)l * D * 256, 256, D, 0);
        }
#undef ADDJOB8
#undef ADDJOB
    }
    __syncthreads();
    LAS float* scr = (LAS float*)(lds + wave * 8704);
    const int gw = blockIdx.x * 8 + wave, NGW = G * 8;
    const int total = jobs[NJOBS - 1].end;
    {
        int j = 0, jbeg = 0, it = gw;
        f32x4 va[8], vb[8];
        if (it < total) { while (it >= jobs[j].end) { jbeg = jobs[j].end; ++j; } tr_load(jobs[j].src, jobs[j].N, it - jbeg, lane, va); }
#define TRHALF_(CUR, NXT) { \
            int jn = j, jbn = jbeg; const int itn = it + NGW; \
            asm volatile("" : "+v"(CUR[0]), "+v"(CUR[1]), "+v"(CUR[2]), "+v"(CUR[3]), "+v"(CUR[4]), "+v"(CUR[5]), "+v"(CUR[6]), "+v"(CUR[7]) :: "memory"); \
            if (itn < total) { while (itn >= jobs[jn].end) { jbn = jobs[jn].end; ++jn; } tr_load(jobs[jn].src, jobs[jn].N, itn - jbn, lane, NXT); } \
            __builtin_amdgcn_sched_barrier(0); \
            asm volatile("" : "+v"(CUR[0]), "+v"(CUR[1]), "+v"(CUR[2]), "+v"(CUR[3]), "+v"(CUR[4]), "+v"(CUR[5]), "+v"(CUR[6]), "+v"(CUR[7])); \
            tr_store(jobs[j].N, jobs[j].dst, jobs[j].K + jobs[j].pad, jobs[j].mode, scr, it - jbeg, lane, jobs[j].f8scale, CUR); \
            j = jn; jbeg = jbn; it = itn; }
        while (it < total) {
            TRHALF_(va, vb);
            if (it >= total) break;
            TRHALF_(vb, va);
        }
#undef TRHALF_
    }
    const int gt = blockIdx.x * 512 + tid, NGT = G * 512;
    for (int l = 0; l < DEPTH; ++l) {
        bf16* lrt = (bf16*)(ws + WS_LRT + (size_t)l * LRT_BYTES);
        const float* wup = a.in[I_WUP] + (size_t)l * 64 * 1024; const float* aup = a.in[I_AUP] + (size_t)l * 64 * 1024; const float* gup = a.in[I_GUP] + (size_t)l * 160 * 1024;
        for (int i = gt; i < LRN * LRK; i += NGT) { const int n = i / LRK, k = i - n * LRK; float v = 0.f;
            if (n < 1024) { if (k < 64) v = wup[k * 1024 + n]; }
            else if (n < 2048) { if (k >= 64 && k < 128) v = aup[(k - 64) * 1024 + (n - 1024)]; }
            else { if (k >= 128 && k < 288) v = gup[(k - 128) * 1024 + (n - 2048)]; }
            lrt[i] = f2bf(v); }
    }
    { const f32x4* p4 = (const f32x4*)a.in[I_P]; v2u* o = (v2u*)(ws + WS_PB);
      for (int i = gt; i < DEPTH * T * 256 / 4; i += NGT) { const f32x4 v = p4[i]; v2u w; w.x = cvt_pk_bf16(v[0], v[1]); w.y = cvt_pk_bf16(v[2], v[3]); o[i] = w; } }
}

template <int MODE, bool F8OUT = false>
__device__ __forceinline__ void norm_phase(const float* hin, float* hout, const float* gain, bf16* xn, const float* router, unsigned* ctl, int* route, const bf16* ym, const LAS int* tab, int lane, int wave, int G) {
    const int gw = blockIdx.x * 8 + wave, NGW = G * 8;
    f32x4 gv[8];
    { const f32x4* g4 = (const f32x4*)gain + lane;
#pragma unroll
      for (int j = 0; j < 8; ++j) gv[j] = g4[64 * j]; }
    f32x4 vn[8]; int rn[6] = {0, 0, 0, 0, 0, 0};
    if (gw < T) { const f32x4* xr = (const f32x4*)(hin + (size_t)gw * D) + lane;
#pragma unroll
        for (int j = 0; j < 8; ++j) vn[j] = xr[64 * j];
        if (MODE == 2) { const int* rt = route + (size_t)gw * 8; rn[0] = rt[0]; rn[1] = rt[1]; rn[2] = rt[2]; rn[3] = rt[3]; rn[4] = rt[4]; rn[5] = rt[5]; } }
    for (int m = gw; m < T; m += NGW) {
        f32x4 v[8];
#pragma unroll
        for (int j = 0; j < 8; ++j) v[j] = vn[j];
        v2u ya[8], yb[8]; float g1 = 0.f, g2 = 0.f;
        if (MODE == 2) {
            const int e1 = rn[0], p1 = rn[1], e2 = rn[3], p2 = rn[4]; g1 = __int_as_float(rn[2]); g2 = __int_as_float(rn[5]);
            const v2u* y1 = (const v2u*)(ym + (size_t)(tab[e1] * 256 + p1) * D) + lane; const v2u* y2 = (const v2u*)(ym + (size_t)(tab[e2] * 256 + p2) * D) + lane;
#pragma unroll
            for (int j = 0; j < 8; ++j) { ya[j] = y1[64 * j]; yb[j] = y2[64 * j]; }
        }
        { const int mn = m + NGW;
          if (mn < T) { const f32x4* xr = (const f32x4*)(hin + (size_t)mn * D) + lane;
#pragma unroll
              for (int j = 0; j < 8; ++j) vn[j] = xr[64 * j];
              if (MODE == 2) { const int* rt = route + (size_t)mn * 8; rn[0] = rt[0]; rn[1] = rt[1]; rn[2] = rt[2]; rn[3] = rt[3]; rn[4] = rt[4]; rn[5] = rt[5]; } } }
        __builtin_amdgcn_sched_barrier(0);
        if (MODE == 2) {
            f32x4* ho = (f32x4*)(hout + (size_t)m * D) + lane;
#pragma unroll
            for (int j = 0; j < 8; ++j) { const v2u a = ya[j], b = yb[j];
                v[j][0] += g1 * bflo(a.x) + g2 * bflo(b.x); v[j][1] += g1 * bfhi(a.x) + g2 * bfhi(b.x); v[j][2] += g1 * bflo(a.y) + g2 * bflo(b.y); v[j][3] += g1 * bfhi(a.y) + g2 * bfhi(b.y); }
#pragma unroll
            for (int j = 0; j < 8; ++j) ho[64 * j] = v[j];
        }
        float s = 0.f;
#pragma unroll
        for (int j = 0; j < 8; ++j) s += (v[j][0] * v[j][0] + v[j][1] * v[j][1]) + (v[j][2] * v[j][2] + v[j][3] * v[j][3]);
        const float rs = rsqrtf(wave_sum(s) * (1.0f / D) + RMS_EPS);
#pragma unroll
        for (int j = 0; j < 8; ++j) v[j] = (v[j] * rs) * gv[j];
        if (F8OUT) { unsigned* o = (unsigned*)((unsigned char*)xn + (size_t)m * D) + lane;
#pragma unroll
            for (int j = 0; j < 8; ++j) o[64 * j] = pg8::pk_fp8x4(v[j][0] * PLE_AS, v[j][1] * PLE_AS, v[j][2] * PLE_AS, v[j][3] * PLE_AS);
        } else
        if (MODE == 4) { unsigned* o = (unsigned*)((unsigned char*)xn + (size_t)m * D) + lane;
#pragma unroll
            for (int j = 0; j < 8; ++j) o[64 * j] = pg8::pk_fp8x4(v[j][0] * MOE_AS, v[j][1] * MOE_AS, v[j][2] * MOE_AS, v[j][3] * MOE_AS);
        } else
        if (MODE == 3) { f32x4* o = (f32x4*)(hout + (size_t)m * D) + lane;
#pragma unroll
            for (int j = 0; j < 8; ++j) o[64 * j] = v[j];
        } else { v2u* o = (v2u*)(xn + (size_t)m * D) + lane;
#pragma unroll
            for (int j = 0; j < 8; ++j) { v2u w; w.x = cvt_pk_bf16(v[j][0], v[j][1]); w.y = cvt_pk_bf16(v[j][2], v[j][3]); o[64 * j] = w; } }
        if (MODE == 1) {
            float lg[8];
#pragma unroll
            for (int e = 0; e < 8; ++e) lg[e] = 0.f;
#pragma unroll
            for (int jp = 0; jp < 4; ++jp) {
                f32x4 rr[2][4][2];
#pragma unroll
                for (int jj = 0; jj < 2; ++jj)
#pragma unroll
                    for (int q = 0; q < 4; ++q) { const f32x4* rp = (const f32x4*)(router + (size_t)(4 * lane + 256 * (2 * jp + jj) + q) * 8); rr[jj][q][0] = rp[0]; rr[jj][q][1] = rp[1]; }
                __builtin_amdgcn_sched_barrier(0);
#pragma unroll
                for (int jj = 0; jj < 2; ++jj)
#pragma unroll
                    for (int q = 0; q < 4; ++q) { const f32x4 r0 = rr[jj][q][0], r1 = rr[jj][q][1]; const float x = v[2 * jp + jj][q];
                        lg[0] += x * r0[0]; lg[1] += x * r0[1]; lg[2] += x * r0[2]; lg[3] += x * r0[3]; lg[4] += x * r1[0]; lg[5] += x * r1[1]; lg[6] += x * r1[2]; lg[7] += x * r1[3]; }
                __builtin_amdgcn_sched_barrier(0);
            }
#pragma unroll
            for (int e = 0; e < 8; ++e) lg[e] = wave_sum(lg[e]);
            int i1 = 0; float v1 = lg[0];
#pragma unroll
            for (int e = 1; e < 8; ++e) if (lg[e] > v1) { v1 = lg[e]; i1 = e; }
            int i2 = -1; float v2 = -INFINITY;
#pragma unroll
            for (int e = 0; e < 8; ++e) if (e != i1 && lg[e] > v2) { v2 = lg[e]; i2 = e; }
            if (lane == 0) {
                const float ex = __expf(v2 - v1), g1r = 1.0f / (1.0f + ex), g2r = ex * g1r;
                const int p1 = (int)atomicAdd(ctl + CW_MOECNT + i1, 1u), p2 = (int)atomicAdd(ctl + CW_MOECNT + i2, 1u);
                int* rt = route + (size_t)m * 8; rt[0] = i1; rt[1] = p1; rt[2] = __float_as_int(g1r); rt[3] = i2; rt[4] = p2; rt[5] = __float_as_int(g2r); rt[6] = 0; rt[7] = 0;
            }
        }
    }
}
__device__ __forceinline__ void moe_table(const unsigned* ctl, LAS int* tab, int NT, int tid) {
    __syncthreads();
    if (tid == 0) { int tb = 0, ub = 0;
        for (int e = 0; e < NE; ++e) { tab[e] = tb; tab[9 + e] = ub; const int tiles = ((int)ctl[CW_MOECNT + e] + 255) >> 8; tb += tiles; ub += tiles * NT; }
        tab[8] = tb; tab[17] = ub; }
    __syncthreads();
}
__device__ __forceinline__ void moe_gather(const bf16* xn, unsigned char* xg, const int* route, const LAS int* tab, int lane, int wave, int G) {
    const int gw = blockIdx.x * 8 + wave, NGW = G * 8;
    for (int m = gw; m < T; m += NGW) {
        const int* rt = route + (size_t)m * 8; const int r1 = tab[rt[0]] * 256 + rt[1], r2 = tab[rt[3]] * 256 + rt[4];
        const v4u* s = (const v4u*)(xn + (size_t)m * D) + 4 * lane;
        float x[32];
#pragma unroll
        for (int j = 0; j < 4; ++j) { const v4u v = s[j]; x[8 * j] = bflo(v.x); x[8 * j + 1] = bfhi(v.x); x[8 * j + 2] = bflo(v.y); x[8 * j + 3] = bfhi(v.y); x[8 * j + 4] = bflo(v.z); x[8 * j + 5] = bfhi(v.z); x[8 * j + 6] = bflo(v.w); x[8 * j + 7] = bfhi(v.w); }
        v4u o0, o1;
        o0.x = pg8::pk_fp8x4(x[0] * MOE_AS, x[1] * MOE_AS, x[2] * MOE_AS, x[3] * MOE_AS); o0.y = pg8::pk_fp8x4(x[4] * MOE_AS, x[5] * MOE_AS, x[6] * MOE_AS, x[7] * MOE_AS);
        o0.z = pg8::pk_fp8x4(x[8] * MOE_AS, x[9] * MOE_AS, x[10] * MOE_AS, x[11] * MOE_AS); o0.w = pg8::pk_fp8x4(x[12] * MOE_AS, x[13] * MOE_AS, x[14] * MOE_AS, x[15] * MOE_AS);
        o1.x = pg8::pk_fp8x4(x[16] * MOE_AS, x[17] * MOE_AS, x[18] * MOE_AS, x[19] * MOE_AS); o1.y = pg8::pk_fp8x4(x[20] * MOE_AS, x[21] * MOE_AS, x[22] * MOE_AS, x[23] * MOE_AS);
        o1.z = pg8::pk_fp8x4(x[24] * MOE_AS, x[25] * MOE_AS, x[26] * MOE_AS, x[27] * MOE_AS); o1.w = pg8::pk_fp8x4(x[28] * MOE_AS, x[29] * MOE_AS, x[30] * MOE_AS, x[31] * MOE_AS);
        v4u* d1 = (v4u*)(xg + (size_t)r1 * XGP) + 2 * lane; v4u* d2 = (v4u*)(xg + (size_t)r2 * XGP) + 2 * lane;
        d1[0] = o0; d1[1] = o1; d2[0] = o0; d2[1] = o1;
    }
}

__device__ __forceinline__ void rwkv_prep_a(const bf16* proj, const float* mu, bf16* lra, int tid, int G) {
    const int gt = blockIdx.x * 512 + tid, NGT = G * 512;
    for (int i = gt; i < T * 48; i += NGT) {
        const int m = i / 48, j8 = i - m * 48, t = m & (SEQ - 1);
        v4u o = {0u, 0u, 0u, 0u};
        if (j8 < 36) {
            const int sc = S_XW + 8 * j8;
            const v4u cu = *(const v4u*)(proj + O_SL + (size_t)m * SLAB_W + sc);
            v4u pv = {0u, 0u, 0u, 0u}; if (t > 0) pv = *(const v4u*)(proj + O_SL + (size_t)(m - 1) * SLAB_W + sc);
            const f32x4 m0 = *(const f32x4*)(mu + sc), m1 = *(const f32x4*)(mu + sc + 4);
            float x[8];
            x[0] = bflo(cu.x) + (bflo(pv.x) - bflo(cu.x)) * m0[0]; x[1] = bfhi(cu.x) + (bfhi(pv.x) - bfhi(cu.x)) * m0[1];
            x[2] = bflo(cu.y) + (bflo(pv.y) - bflo(cu.y)) * m0[2]; x[3] = bfhi(cu.y) + (bfhi(pv.y) - bfhi(cu.y)) * m0[3];
            x[4] = bflo(cu.z) + (bflo(pv.z) - bflo(cu.z)) * m1[0]; x[5] = bfhi(cu.z) + (bfhi(pv.z) - bfhi(cu.z)) * m1[1];
            x[6] = bflo(cu.w) + (bflo(pv.w) - bflo(cu.w)) * m1[2]; x[7] = bfhi(cu.w) + (bfhi(pv.w) - bfhi(cu.w)) * m1[3];
            if (j8 < 8) {
#pragma unroll
                for (int q = 0; q < 8; ++q) x[q] = 1.0f - 2.0f * __builtin_amdgcn_rcpf(1.0f + __expf(2.0f * x[q]));
            } else if (j8 >= 16) {
#pragma unroll
                for (int q = 0; q < 8; ++q) x[q] = sigm(x[q]);
            }
            o.x = cvt_pk_bf16(x[0], x[1]); o.y = cvt_pk_bf16(x[2], x[3]); o.z = cvt_pk_bf16(x[4], x[5]); o.w = cvt_pk_bf16(x[6], x[7]);
        }
        *(v4u*)(lra + (size_t)m * LRK + 8 * j8) = o;
    }
}
__device__ __forceinline__ float sum8(float x) { x += dpp_f<0xB1>(x); x += dpp_f<0x4E>(x); x += dpp_f<0x141>(x); return x; }
__device__ __forceinline__ void unpack8(const v4u v, float (&o)[8]) { o[0] = bflo(v.x); o[1] = bfhi(v.x); o[2] = bflo(v.y); o[3] = bfhi(v.y); o[4] = bflo(v.z); o[5] = bfhi(v.z); o[6] = bflo(v.w); o[7] = bfhi(v.w); }
__device__ __forceinline__ v4u pack8(const float (&x)[8]) { v4u o; o.x = cvt_pk_bf16(x[0], x[1]); o.y = cvt_pk_bf16(x[2], x[3]); o.z = cvt_pk_bf16(x[4], x[5]); o.w = cvt_pk_bf16(x[6], x[7]); return o; }
__device__ __forceinline__ void load8f(const float* p, float (&o)[8]) { const f32x4 a = *(const f32x4*)p, b = *(const f32x4*)(p + 4); o[0] = a[0]; o[1] = a[1]; o[2] = a[2]; o[3] = a[3]; o[4] = b[0]; o[5] = b[1]; o[6] = b[2]; o[7] = b[3]; }
__device__ __forceinline__ void rwkv_prep_b(const bf16* proj_, const bf16* lr_, const float* mu, const float* w0, const float* a0, const float* k_k, const float* k_a, unsigned char* scanin, int tid, int G, int ntok) {
    const GAS bf16* proj = (const GAS bf16*)proj_; const GAS bf16* lr = (const GAS bf16*)lr_;
    const int gt = blockIdx.x * 512 + tid, NGT = G * 512;
    const int c8 = gt & 127, c = 8 * c8, h = c8 >> 3, sub = c8 & 7;
    float mur[8], muk[8], muv[8], w0v[8], a0v[8], kkv[8], kav[8];
    load8f(mu + S_R + c, mur); load8f(mu + S_K + c, muk); load8f(mu + S_V + c, muv); load8f(w0 + c, w0v); load8f(a0 + c, a0v); load8f(k_k + c, kkv); load8f(k_a + c, kav);
    for (int it = gt; it < ntok * 128; it += NGT) {
        const int m = it >> 7, b = m >> 13, t = m & (SEQ - 1);
        const GAS bf16* pc = proj + O_SL + (size_t)m * SLAB_W + c;
        float rc[8], kc[8], vc[8], rp[8], kp[8], vp[8], dp[8], ap[8];
        unpack8(*(const GAS v4u*)(pc + S_R), rc); unpack8(*(const GAS v4u*)(pc + S_K), kc); unpack8(*(const GAS v4u*)(pc + S_V), vc);
        if (t > 0) { unpack8(*(const GAS v4u*)(pc - SLAB_W + S_R), rp); unpack8(*(const GAS v4u*)(pc - SLAB_W + S_K), kp); unpack8(*(const GAS v4u*)(pc - SLAB_W + S_V), vp); }
        else {
#pragma unroll
            for (int j = 0; j < 8; ++j) { rp[j] = 0.f; kp[j] = 0.f; vp[j] = 0.f; } }
        unpack8(*(const GAS v4u*)(lr + (size_t)m * LRN + c), dp); unpack8(*(const GAS v4u*)(lr + (size_t)m * LRN + 1024 + c), ap);
        float r[8], kt[8], v[8], kk[8], bb[8], w[8], k[8], av[8]; float ss = 0.f;
#pragma unroll
        for (int j = 0; j < 8; ++j) { r[j] = rc[j] + (rp[j] - rc[j]) * mur[j]; k[j] = kc[j] + (kp[j] - kc[j]) * muk[j]; v[j] = vc[j] + (vp[j] - vc[j]) * muv[j];
            w[j] = __expf(-0.6065306597126334f * sigm(w0v[j] + dp[j])); av[j] = sigm(a0v[j] + ap[j]); kk[j] = k[j] * kkv[j]; ss += kk[j] * kk[j]; kt[j] = k[j] * (1.0f + (av[j] - 1.0f) * kav[j]); }
        const float rn = rsqrtf(fmaxf(sum8(ss), 1e-24f));
#pragma unroll
        for (int j = 0; j < 8; ++j) { kk[j] *= rn; bb[j] = kk[j] * av[j]; }
        unsigned char* rec = scanin + ((size_t)(b * 16 + h) * SEQ + t) * SREC;
        *(f32x4*)(rec + sub * 32) = (f32x4){w[0], w[1], w[2], w[3]}; *(f32x4*)(rec + sub * 32 + 16) = (f32x4){w[4], w[5], w[6], w[7]};
        *(v4u*)(rec + 256 + sub * 16) = pack8(r); *(v4u*)(rec + 384 + sub * 16) = pack8(kt); *(v4u*)(rec + 512 + sub * 16) = pack8(v); *(v4u*)(rec + 640 + sub * 16) = pack8(kk); *(v4u*)(rec + 768 + sub * 16) = pack8(bb);
    }
}
template <int RKV_REC> __device__ __forceinline__ void rwkv_post(const float* ys, const unsigned char* scanin, const bf16* lr_, const float* r_k, const float* gn_w, const float* gn_b, bf16* rw, int tid, int G) {
    const GAS bf16* lr = (const GAS bf16*)lr_;
    const int gt = blockIdx.x * 512 + tid, NGT = G * 512;
    const int c8 = gt & 127, c = 8 * c8, h = c8 >> 3, sub = c8 & 7;
    float rkv[8], gw[8], gb[8];
    load8f(r_k + c, rkv); load8f(gn_w + c, gw); load8f(gn_b + c, gb);
    for (int it = gt; it < T * 128; it += NGT) {
        const int m = it >> 7, b = m >> 13, t = m & (SEQ - 1);
        float y[8]; load8f(ys + (size_t)m * 1024 + c, y);
        float s = 0.f;
#pragma unroll
        for (int j = 0; j < 8; ++j) s += y[j];
        const float mean = sum8(s) * (1.0f / 64.0f); float q = 0.f;
#pragma unroll
        for (int j = 0; j < 8; ++j) { y[j] -= mean; q += y[j] * y[j]; }
        const float rstd = rsqrtf(sum8(q) * (1.0f / 64.0f) + GN_EPS);
        const unsigned char* rec = scanin + ((size_t)(b * 16 + h) * SEQ + t) * RKV_REC;
        float r[8], kt[8], v[8], g[8];
        unpack8(*(const v4u*)(rec + sub * 16), r); unpack8(*(const v4u*)(rec + 128 + sub * 16), kt); unpack8(*(const v4u*)(rec + 256 + sub * 16), v);
        unpack8(*(const GAS v4u*)(lr + (size_t)m * LRN + 2048 + c), g);
        float bs = 0.f;
#pragma unroll
        for (int j = 0; j < 8; ++j) bs += r[j] * kt[j] * rkv[j];
        bs = sum8(bs);
        float o[8];
#pragma unroll
        for (int j = 0; j < 8; ++j) o[j] = (y[j] * rstd * gw[j] + gb[j] + bs * v[j]) * g[j];
        *(v4u*)(rw + (size_t)m * 1024 + c) = pack8(o);
    }
}

#ifndef SEL_CHECK
#define SEL_CHECK 0
#endif
#ifndef PROBE_REPEAT
#define PROBE_REPEAT 0u
#endif
#define SUBREP(k) for (int rep_ = 0; rep_ < 1 + (int)(((PROBE_REPEAT) >> (k)) & 1u); ++rep_)
typedef float f32x2 __attribute__((ext_vector_type(2)));
__device__ __forceinline__ int f2ikey(float f) { const int u = __float_as_int(f); return u ^ ((u >> 31) & 0x7fffffff); }
__device__ __forceinline__ unsigned pk_ge_flags(unsigned xm1x2, unsigned d) {
    unsigned t; asm volatile("v_pk_sub_i16 %0, %1, %2 clamp\n\tv_pk_lshrrev_b16 %0, %3, %0" : "=&v"(t) : "v"(xm1x2), "v"(d), "v"(0x000f000fu)); return t; }
__device__ __forceinline__ unsigned pk_add16(unsigned a, unsigned b) { unsigned r; asm volatile("v_pk_add_u16 %0, %1, %2" : "=v"(r) : "v"(a), "v"(b)); return r; }
__device__ __forceinline__ unsigned wave_sum_pk(unsigned acc) {
    unsigned x = (acc & 0xffffu) + (acc >> 16);
    x += dpp_u<0xB1>(x); x += dpp_u<0x4E>(x); x += dpp_u<0x141>(x); x += dpp_u<0x140>(x);
    return (unsigned)__builtin_amdgcn_readlane((int)x, 0) + (unsigned)__builtin_amdgcn_readlane((int)x, 16) + (unsigned)__builtin_amdgcn_readlane((int)x, 32) + (unsigned)__builtin_amdgcn_readlane((int)x, 48);
}
__device__ __forceinline__ unsigned count_ge16(const LAS unsigned short* hrow, int ng, int x, int lane) {
    const unsigned xm = (unsigned)((x - 1) & 0xffff), xm1x2 = xm | (xm << 16);
    unsigned acc = 0u;
    v4u a = *(const LAS v4u*)(hrow + 8 * lane);
    for (int g = 1; g < ng; ++g) {
        const v4u b = *(const LAS v4u*)(hrow + 512 * g + 8 * lane);
        acc = pk_add16(acc, pk_ge_flags(xm1x2, a.x)); acc = pk_add16(acc, pk_ge_flags(xm1x2, a.y)); acc = pk_add16(acc, pk_ge_flags(xm1x2, a.z)); acc = pk_add16(acc, pk_ge_flags(xm1x2, a.w));
        a = b;
    }
    acc = pk_add16(acc, pk_ge_flags(xm1x2, a.x)); acc = pk_add16(acc, pk_ge_flags(xm1x2, a.y)); acc = pk_add16(acc, pk_ge_flags(xm1x2, a.z)); acc = pk_add16(acc, pk_ge_flags(xm1x2, a.w));
    return wave_sum_pk(acc);
}
__device__ __forceinline__ unsigned wave_scan_u(unsigned x) {
    x += (unsigned)__builtin_amdgcn_update_dpp(0, (int)x, 0x111, 0xf, 0xf, false); x += (unsigned)__builtin_amdgcn_update_dpp(0, (int)x, 0x112, 0xf, 0xf, false);
    x += (unsigned)__builtin_amdgcn_update_dpp(0, (int)x, 0x114, 0xf, 0xf, false); x += (unsigned)__builtin_amdgcn_update_dpp(0, (int)x, 0x118, 0xf, 0xf, false);
    x += (unsigned)__builtin_amdgcn_update_dpp(0, (int)x, 0x142, 0xa, 0xf, false); x += (unsigned)__builtin_amdgcn_update_dpp(0, (int)x, 0x143, 0xc, 0xf, false);
    return x;
}
__device__ __forceinline__ void select_phase(const bf16* proj_, unsigned short* idx, unsigned short* loscr, LAS unsigned char* lds, int tid, int lane, int wave, int G, unsigned* chk) {
    LAS unsigned short* hk = (LAS unsigned short*)lds;
    LAS unsigned short* olist = (LAS unsigned short*)(lds + MISC_OFF + 2048);
    LAS unsigned short* cand = (LAS unsigned short*)(lds + MISC_OFF + 8192);
    const GAS bf16* proj = (const GAS bf16*)proj_;
    GAS unsigned short* lo = (GAS unsigned short*)loscr + (size_t)blockIdx.x * 8 * SEQ;
#define LOIDX_(row, key) ((size_t)(key) * 8 + ((row) & 3) * 2 + ((row) >> 2))
    const int kq = lane >> 4, l15 = lane & 15;
    const bool mirror = ((T / 8) % G == 0);
    for (int u_ = blockIdx.x, rnd = 0; u_ < T / 8; u_ += G, ++rnd) {
        const int u = (mirror && (rnd & 1)) ? (u_ - (int)blockIdx.x) + (G - 1 - (int)blockIdx.x) : u_;
        const int m0 = 8 * u, b = m0 >> 13, t0 = m0 & (SEQ - 1);
        if (t0 < NSEL) {
            for (int r = 0; r < 8; ++r) for (int j = tid; j <= t0 + r; j += 512) idx[(size_t)(m0 + r) * NSEL + j] = (unsigned short)j;
            continue;
        }
        const int tmax = t0 + 7, ntiles = (tmax >> 4) + 1, n16 = ntiles * 16, ng = (n16 + 511) >> 9, npad = ng * 512 - n16;
        for (int i = tid; i < 8 * npad; i += 512) { const int r = i / npad, k = n16 + (i - r * npad); hk[r * SEQ + k] = (unsigned short)0x807f; }
        SUBREP(13) {
        bf16x8 af[2][2][2]; f32x2 w2[2][4];
#pragma unroll
        for (int rs = 0; rs < 2; ++rs) {
#pragma unroll
            for (int ps = 0; ps < 2; ++ps) { const GAS bf16* qrow = proj + O_QI + (size_t)(m0 + 4 * rs + (l15 >> 2)) * 512 + ((l15 & 3) + 4 * ps) * 64 + 16 * kq;
                af[rs][ps][0] = *(const GAS bf16x8*)qrow; af[rs][ps][1] = *(const GAS bf16x8*)(qrow + 8); }
            const v4u w = *(const GAS v4u*)(proj + O_WI + (size_t)(m0 + 4 * rs + kq) * 8);
            w2[rs][0] = (f32x2){bflo(w.x), bfhi(w.x)}; w2[rs][1] = (f32x2){bflo(w.y), bfhi(w.y)}; w2[rs][2] = (f32x2){bflo(w.z), bfhi(w.z)}; w2[rs][3] = (f32x2){bflo(w.w), bfhi(w.w)}; }
        const GAS bf16* kcol = proj + O_KI + (size_t)b * SEQ * 64 + (size_t)l15 * 64 + 16 * kq;
        const int kst2 = 8;
        const int rot = 0;
#define ROT_(x) ({ int r_ = min((x), ntiles - 1) + rot; r_ >= ntiles ? r_ - ntiles : r_; })
        bf16x8 frA[4][2], frB[4][2];
#pragma unroll
        for (int p = 0; p < 4; ++p) { const GAS bf16* kp = kcol + (size_t)(ROT_(wave + 8 * p) * 16) * 64; frA[p][0] = *(const GAS bf16x8*)kp; frA[p][1] = *(const GAS bf16x8*)(kp + kst2); }
        const unsigned lanoff = (unsigned)(kq * SEQ + l15) * 2u;
        const unsigned lanoff32 = (unsigned)(l15 * 16 + kq * 4);
        GAS unsigned char* const lodump = (GAS unsigned char*)loscr + (size_t)(64u << 20);
        unsigned pend[4] = {0u, 0u, 0u, 0u}; int ktp = -1;
#define RELU2_(x, y) (f32x2){__int_as_float(max(__float_as_int(x), 0)), __int_as_float(max(__float_as_int(y), 0))}
#define PENDST_() do { GAS unsigned char* pb_ = ktp < 0 ? lodump : (GAS unsigned char*)lo; const int kb_ = ktp < 0 ? 0 : ktp; \
        _Pragma("unroll") for (int p = 0; p < 4; ++p) { const int ktq = ROT_(kb_ + 8 * p); __builtin_nontemporal_store(pend[p], (GAS unsigned*)(pb_ + ktq * 256 + lanoff32)); } } while (0)
#define TILE4_(CUR, NXT, KT0, FK) do { \
        asm volatile("" : "+v"(CUR[0][0]), "+v"(CUR[0][1]), "+v"(CUR[1][0]), "+v"(CUR[1][1]), "+v"(CUR[2][0]), "+v"(CUR[2][1]), "+v"(CUR[3][0]), "+v"(CUR[3][1]) :: "memory"); \
        _Pragma("unroll") for (int p = 0; p < 4; ++p) { const GAS bf16* kp = kcol + (size_t)((((FK) & 2) ? 0 : ROT_((KT0) + 8 * p + 32)) * 16) * 64; NXT[p][0] = *(const GAS bf16x8*)kp; NXT[p][1] = *(const GAS bf16x8*)(kp + kst2); } \
        if (!((FK) & 8)) PENDST_(); \
        __builtin_amdgcn_sched_barrier(0); \
        asm volatile("" : "+v"(CUR[0][0]), "+v"(CUR[0][1]), "+v"(CUR[1][0]), "+v"(CUR[1][1]), "+v"(CUR[2][0]), "+v"(CUR[2][1]), "+v"(CUR[3][0]), "+v"(CUR[3][1])); \
        _Pragma("unroll") for (int p = 0; p < 4; ++p) { \
            const int kt = ROT_((KT0) + 8 * p); \
            const bf16x8 c0 = CUR[p][0], c1 = CUR[p][1]; \
            const bool lastt = (kt == ntiles - 1); \
            f32x4 a0[2], a1[2]; \
            _Pragma("unroll") for (int rs = 0; rs < 2; ++rs) { \
                a0[rs] = (f32x4){0.f, 0.f, 0.f, 0.f}; a1[rs] = (f32x4){0.f, 0.f, 0.f, 0.f}; \
                if ((FK) & 1) { a0[rs] = __builtin_bit_cast(f32x4, c0); a1[rs] = __builtin_bit_cast(f32x4, c1); } else { \
                a0[rs] = __builtin_amdgcn_mfma_f32_16x16x32_bf16(af[rs][0][0], c0, a0[rs], 0, 0, 0); a1[rs] = __builtin_amdgcn_mfma_f32_16x16x32_bf16(af[rs][1][0], c0, a1[rs], 0, 0, 0); \
                a0[rs] = __builtin_amdgcn_mfma_f32_16x16x32_bf16(af[rs][0][1], c1, a0[rs], 0, 0, 0); a1[rs] = __builtin_amdgcn_mfma_f32_16x16x32_bf16(af[rs][1][1], c1, a1[rs], 0, 0, 0); } } \
            LAS unsigned char* hkt = (LAS unsigned char*)hk + kt * 32 + lanoff; \
            int ikk[2]; \
            _Pragma("unroll") for (int rs = 0; rs < 2; ++rs) { \
                f32x2 acc = {0.f, 0.f}; \
                acc += RELU2_(a0[rs][0], a0[rs][1]) * w2[rs][0]; acc += RELU2_(a0[rs][2], a0[rs][3]) * w2[rs][1]; acc += RELU2_(a1[rs][0], a1[rs][1]) * w2[rs][2]; acc += RELU2_(a1[rs][2], a1[rs][3]) * w2[rs][3]; \
                float sc = acc[0] + acc[1]; \
                if (lastt) { if (kt * 16 + l15 > t0 + 4 * rs + kq) sc = -INFINITY; } \
                const int ik = f2ikey(sc); \
                if (!((FK) & 4)) *(LAS unsigned short*)(hkt + rs * 8 * SEQ) = (unsigned short)((unsigned)ik >> 16); ikk[rs] = ik; } \
            pend[p] = ((unsigned)ikk[0] & 0xffffu) | ((unsigned)ikk[1] << 16); } \
        ktp = (KT0); } while (0)
#ifdef SWEEP_FAKE
        if (rep_ == 0) {
        const int ntf_ = (SWEEP_FAKE & 16) ? (ntiles >> 1) : ntiles;
        for (int kt0 = wave; kt0 < ntf_; kt0 += 64) {
            TILE4_(frA, frB, kt0, SWEEP_FAKE);
            if (kt0 + 32 >= ntf_) break;
            TILE4_(frB, frA, kt0 + 32, SWEEP_FAKE);
        }
        } else
#endif
        for (int kt0 = wave; kt0 < ntiles; kt0 += 64) {
            TILE4_(frA, frB, kt0, 0);
            if (kt0 + 32 >= ntiles) break;
            TILE4_(frB, frA, kt0 + 32, 0);
        }
        if (ktp >= 0) PENDST_();
#undef TILE4_
#undef ROT_
#undef PENDST_
#undef RELU2_
        }
        asm volatile("s_waitcnt vmcnt(0)" ::: "memory");
        __syncthreads();
        {
            const int row = wave, m = m0 + row;
            const LAS unsigned short* hrow = hk + row * SEQ;
            LAS unsigned short* hroww = hk + row * SEQ;
            int thr16 = 0;
            unsigned lifted_idx = 0xffffffffu; int bucket = 0; bool skipchk = false; (void)lifted_idx; (void)bucket; (void)skipchk;
            SUBREP(14) {
            int klo = -32640, khi = 32641; unsigned cnt_hi = 0u, cnt_lo = 0u; bool exact = false;
            while (khi - klo > 1) {
                const int mid = (klo + khi) >> 1;
                const unsigned c = count_ge16(hrow, ng, mid, lane);
                if (c == (unsigned)NSEL) { klo = mid; exact = true; break; }
                if (c > (unsigned)NSEL) { klo = mid; cnt_lo = c; } else { khi = mid; cnt_hi = c; }
            }
            thr16 = klo;
            if (!exact) {
                if (cnt_lo == 0u) cnt_lo = count_ge16(hrow, ng, klo, lane);
                const unsigned need = (unsigned)NSEL - cnt_hi, cb = cnt_lo - cnt_hi;
                const bool small = cb <= 64u;
                bucket = klo; skipchk = !small;
                const unsigned bx = (unsigned)(klo & 0xffff), bxx = bx | (bx << 16);
                const unsigned dumpaddr = (unsigned)(size_t)(cand + row * 72 + 64);
                unsigned base = 0u; asm volatile("" : "+v"(base));
                for (int g = 0; g < ng; ++g) {
                    const v4u kv = *(const LAS v4u*)(hrow + 512 * g + 8 * lane);
                    const unsigned d[4] = {kv.x ^ bxx, kv.y ^ bxx, kv.z ^ bxx, kv.w ^ bxx};
                    unsigned eq[8], ce = 0u;
#pragma unroll
                    for (int q = 0; q < 4; ++q) { const unsigned l0 = d[q] & 0xffffu, h0 = d[q] >> 16; eq[2 * q] = 1u - ((l0 | (0u - l0)) >> 31); eq[2 * q + 1] = 1u - ((h0 | (0u - h0)) >> 31); ce += eq[2 * q] + eq[2 * q + 1]; }
                    const unsigned isc = wave_scan_u(ce);
                    unsigned pos = base + isc - ce;
#pragma unroll
                    for (int e = 0; e < 8; ++e) { const unsigned kidx = (unsigned)(512 * g + 8 * lane + e);
                        if (small) { const unsigned inb = ((unsigned)((int)pos - 64)) >> 31; const unsigned f = eq[e] & inb; const unsigned slot = 64u + f * (pos - 64u); cand[row * 72 + slot] = (unsigned short)kidx; }
                        else { const unsigned inb = ((unsigned)((int)pos - (int)need)) >> 31; const unsigned f = eq[e] & inb; const unsigned tgt = (unsigned)(size_t)(hroww + kidx);
                               *(LAS unsigned short*)(size_t)(dumpaddr + f * (tgt - dumpaddr)) = (unsigned short)(klo + 1); }
                        pos += eq[e]; }
                    base += (unsigned)__builtin_amdgcn_readlane((int)isc, 63);
                }
                LDS_WAIT(); asm volatile("" ::: "memory");
                if (small) {
                    const bool mine = (unsigned)lane < cb;
                    const unsigned myidx = mine ? (unsigned)cand[row * 72 + lane] : 0u;
                    const unsigned mylo = mine ? (unsigned)__hip_atomic_load(lo + LOIDX_(row, myidx), __ATOMIC_RELAXED, __HIP_MEMORY_SCOPE_AGENT) : 0u;
                    unsigned rank = 0u;
                    for (unsigned j = 0; j < cb; ++j) { const unsigned oj = (unsigned)__shfl((int)mylo, (int)j), ij = (unsigned)__shfl((int)myidx, (int)j);
                        rank += (oj > mylo || (oj == mylo && ij < myidx)) ? 1u : 0u; }
                    if (mine && rank < need) { hroww[myidx] = (unsigned short)(klo + 1); lifted_idx = myidx; }
                    LDS_WAIT(); asm volatile("" ::: "memory");
                }
                thr16 = klo + 1;
            }
            }
            SUBREP(15) {
            const unsigned xm = (unsigned)((thr16 - 1) & 0xffff), xm1x2 = xm | (xm << 16);
            unsigned sel_base = 0u; asm volatile("" : "+v"(sel_base));
            LAS unsigned short* ol = olist + row * 264;
            for (int g = 0; g < ng; ++g) {
                const v4u kv = *(const LAS v4u*)(hrow + 512 * g + 8 * lane);
                const unsigned f4[4] = {pk_ge_flags(xm1x2, kv.x), pk_ge_flags(xm1x2, kv.y), pk_ge_flags(xm1x2, kv.z), pk_ge_flags(xm1x2, kv.w)};
                unsigned cs = 0u;
#pragma unroll
                for (int q = 0; q < 4; ++q) cs += (f4[q] & 1u) + (f4[q] >> 16);
                const unsigned iss = wave_scan_u(cs);
                unsigned pos = sel_base + iss - cs;
#pragma unroll
                for (int e = 0; e < 8; ++e) { const unsigned fl = (e & 1) ? (f4[e >> 1] >> 16) : (f4[e >> 1] & 1u); const unsigned inb = ((unsigned)((int)pos - NSEL)) >> 31; const unsigned f = fl & inb;
                    const unsigned slot = 256u + f * (pos - 256u); ol[slot] = (unsigned short)(512 * g + 8 * lane + e); pos += fl; }
                sel_base += (unsigned)__builtin_amdgcn_readlane((int)iss, 63);
            }
            LDS_WAIT(); asm volatile("" ::: "memory");
            if (lane < 32) *(GAS v4u*)((GAS unsigned short*)idx + (size_t)m * NSEL + 8 * lane) = *(const LAS v4u*)(ol + 8 * lane);
#if SEL_CHECK
            {
                if (lifted_idx != 0xffffffffu) hroww[lifted_idx] = (unsigned short)bucket;
                LDS_WAIT(); asm volatile("" ::: "memory");
                unsigned bad = (sel_base != (unsigned)NSEL) ? 1u : 0u; int mn = 0x7fffffff;
                for (int e = 0; e < 4; ++e) { const int j = 4 * lane + e; const int id = (int)ol[j]; const int full = (int)(((unsigned)hrow[id] << 16) | (unsigned)__hip_atomic_load(lo + LOIDX_(row, id), __ATOMIC_RELAXED, __HIP_MEMORY_SCOPE_AGENT));
                    mn = full < mn ? full : mn; if (id > t0 + row) bad = 1u; if (j < 255 && (int)ol[j + 1] <= id) bad = 1u; }
                for (int o = 1; o < 64; o <<= 1) { const int v = __shfl_xor(mn, o); mn = v < mn ? v : mn; }
                unsigned cgt = 0u, cge = 0u;
                for (int j = lane; j < n16; j += 64) { const int full = (int)(((unsigned)hrow[j] << 16) | (unsigned)__hip_atomic_load(lo + LOIDX_(row, j), __ATOMIC_RELAXED, __HIP_MEMORY_SCOPE_AGENT)); cgt += (full > mn) ? 1u : 0u; cge += (full >= mn) ? 1u : 0u; }
                for (int o = 1; o < 64; o <<= 1) { cgt += __shfl_xor(cgt, o); cge += __shfl_xor(cge, o); }
                if (!skipchk && (cgt > 255u || cge < 256u)) bad = 1u;
                if (__ballot(bad != 0u) != 0ull && lane == 0) atomicAdd(chk + 34, 1u);
                if (lane == 0) { atomicAdd(chk + 35, 1u); if (skipchk) atomicAdd(chk + 36, 1u); }
            }
#endif
            }
        }
        __syncthreads();
    }
}

__device__ __forceinline__ void attn_phase_ref(const bf16* proj, const unsigned short* idx, const float* rel_bias, bf16* att, LAS unsigned char* lds, int tid, int lane, int wave, int G) {
    LAS float* btab = (LAS float*)(lds + BIAS_OFF);
    for (int i = tid; i < 129 * 8; i += 512) { const int d = i >> 3, hh = i & 7; const int bk = d < 113 ? (int)REL_BUCKET_TAB[d] : 31; btab[i] = rel_bias[bk * 8 + hh]; }
    __syncthreads();
    LAS unsigned char* base = lds + wave * 8192;
    LAS float* qf = (LAS float*)base;
    LAS f32x4* pl = (LAS f32x4*)(base + 2048);
    LAS unsigned short* il = (LAS unsigned short*)(base + 6144);
    const int gw = blockIdx.x * 8 + wave, NGW = G * 8;
    const float scale = 0.08838834764831845f;
    for (int item = gw; item < 2 * T; item += NGW) {
        const int m = item >> 1, c = item & 1, b = m >> 13, t = m & (SEQ - 1), nsel = (t + 1 < NSEL) ? t + 1 : NSEL;
        { const v4u qv = *(const v4u*)(proj + O_Q + (size_t)m * 1024 + c * 512 + 8 * lane);
          f32x4 q0 = {bflo(qv.x), bfhi(qv.x), bflo(qv.y), bfhi(qv.y)}, q1 = {bflo(qv.z), bfhi(qv.z), bflo(qv.w), bfhi(qv.w)};
          *(LAS f32x4*)(qf + 8 * lane) = q0; *(LAS f32x4*)(qf + 8 * lane + 4) = q1; }
        int id[4];
#pragma unroll
        for (int i2 = 0; i2 < 4; ++i2) { const int j = lane + 64 * i2; id[i2] = (j < nsel) ? (int)idx[(size_t)m * NSEL + j] : 0; il[j] = (unsigned short)id[i2]; }
        LDS_WAIT(); asm volatile("" ::: "memory");
        float lg[4][4];
#pragma unroll
        for (int i2 = 0; i2 < 4; ++i2)
#pragma unroll
            for (int g = 0; g < 4; ++g) lg[i2][g] = 0.f;
        const bf16* kbase = proj + O_K + (size_t)(b * 2 + c) * SEQ * 128;
#pragma unroll 2
        for (int dc = 0; dc < 16; ++dc) {
            v4u kv[4];
#pragma unroll
            for (int i2 = 0; i2 < 4; ++i2) kv[i2] = *(const v4u*)(kbase + (size_t)id[i2] * 128 + 8 * dc);
            f32x4 qa[4][2];
#pragma unroll
            for (int g = 0; g < 4; ++g) { qa[g][0] = *(const LAS f32x4*)(qf + g * 128 + 8 * dc); qa[g][1] = *(const LAS f32x4*)(qf + g * 128 + 8 * dc + 4); }
#pragma unroll
            for (int i2 = 0; i2 < 4; ++i2) { const float k0 = bflo(kv[i2].x), k1 = bfhi(kv[i2].x), k2 = bflo(kv[i2].y), k3 = bfhi(kv[i2].y), k4 = bflo(kv[i2].z), k5 = bfhi(kv[i2].z), k6 = bflo(kv[i2].w), k7 = bfhi(kv[i2].w);
#pragma unroll
                for (int g = 0; g < 4; ++g) lg[i2][g] += (qa[g][0][0] * k0 + qa[g][0][1] * k1) + (qa[g][0][2] * k2 + qa[g][0][3] * k3) + (qa[g][1][0] * k4 + qa[g][1][1] * k5) + (qa[g][1][2] * k6 + qa[g][1][3] * k7); }
        }
#pragma unroll
        for (int i2 = 0; i2 < 4; ++i2) { const int j = lane + 64 * i2; int dist = t - id[i2]; dist = dist > 128 ? 128 : dist;
#pragma unroll
            for (int g = 0; g < 4; ++g) { const float l = lg[i2][g] * scale + btab[dist * 8 + 4 * c + g]; lg[i2][g] = (j < nsel) ? l : -INFINITY; } }
#pragma unroll
        for (int g = 0; g < 4; ++g) {
            const float mx = wave_max(fmaxf(fmaxf(lg[0][g], lg[1][g]), fmaxf(lg[2][g], lg[3][g])));
            float e0 = __expf(lg[0][g] - mx), e1 = __expf(lg[1][g] - mx), e2 = __expf(lg[2][g] - mx), e3 = __expf(lg[3][g] - mx);
            const float inv = 1.0f / wave_sum((e0 + e1) + (e2 + e3));
            lg[0][g] = e0 * inv; lg[1][g] = e1 * inv; lg[2][g] = e2 * inv; lg[3][g] = e3 * inv;
        }
#pragma unroll
        for (int i2 = 0; i2 < 4; ++i2) { const f32x4 pv = {lg[i2][0], lg[i2][1], lg[i2][2], lg[i2][3]}; pl[lane + 64 * i2] = pv; }
        LDS_WAIT(); asm volatile("" ::: "memory");
        float o[4][2];
#pragma unroll
        for (int g = 0; g < 4; ++g) { o[g][0] = 0.f; o[g][1] = 0.f; }
        const bf16* vbase = proj + O_V + (size_t)(b * 2 + c) * SEQ * 128 + 2 * lane;
        for (int j0 = 0; j0 < NSEL; j0 += 8) {
            const v4u iv = *(const LAS v4u*)(il + j0);
            const int ids[8] = {(int)(iv.x & 0xffffu), (int)(iv.x >> 16), (int)(iv.y & 0xffffu), (int)(iv.y >> 16), (int)(iv.z & 0xffffu), (int)(iv.z >> 16), (int)(iv.w & 0xffffu), (int)(iv.w >> 16)};
            unsigned vv[8];
#pragma unroll
            for (int q = 0; q < 8; ++q) vv[q] = *(const unsigned*)(vbase + (size_t)ids[q] * 128);
#pragma unroll
            for (int q = 0; q < 8; ++q) { const f32x4 pj = pl[j0 + q]; const float v0 = bflo(vv[q]), v1 = bfhi(vv[q]);
#pragma unroll
                for (int g = 0; g < 4; ++g) { o[g][0] += pj[g] * v0; o[g][1] += pj[g] * v1; } }
        }
#pragma unroll
        for (int g = 0; g < 4; ++g) *(unsigned*)(att + (size_t)m * 1024 + (4 * c + g) * 128 + 2 * lane) = cvt_pk_bf16(o[g][0], o[g][1]);
        LDS_WAIT(); asm volatile("" ::: "memory");
    }
}

template <int CTRL> __device__ __forceinline__ float dpp_max(float x) { return fmaxf(x, dpp_f<CTRL>(x)); }
__device__ __forceinline__ float max16(float x) { x = dpp_max<0xB1>(x); x = dpp_max<0x4E>(x); x = dpp_max<0x141>(x); x = dpp_max<0x140>(x); return x; }
__device__ __forceinline__ void attn_phase(const bf16* proj, const unsigned short* idx, const float* rel_bias, bf16* att, LAS unsigned char* lds, int tid, int lane, int wave, int G, unsigned* queue) {
    LAS float* btab = (LAS float*)(lds + BIAS_OFF);
    for (int i = tid; i < 129 * 8; i += 512) { const int d = i >> 3, hh = i & 7; const int bk = d < 113 ? (int)REL_BUCKET_TAB[d] : 31; btab[i] = rel_bias[bk * 8 + hh]; }
    __syncthreads();
    LAS unsigned char* base = lds + wave * 8192;
    LAS unsigned char* p8 = base;
    LAS unsigned short* il = (LAS unsigned short*)(base + 4352);
    const int gq = lane >> 4, dl = lane & 15;
    const float scale = 0.08838834764831845f * (1.0f / 64.0f);
    const bool xmode = (G % 64 == 0);
    const int xcd = blockIdx.x & 7;
    const int gw = blockIdx.x * 8 + wave, NGW = G * 8;
    unsigned zoff = 0u; asm volatile("" : "+v"(zoff));
    constexpr int QG = 4;
    const int qsub = (xcd & 1) * QG + ((blockIdx.x >> 3) & (QG - 1));
    unsigned* qw = queue + (xcd * QG + ((blockIdx.x >> 3) & (QG - 1))) * 32 + zoff;
    unsigned ticket = 0u;
    int it = 0, m = -1, c = 0;
    if (xmode) { if (lane == 0) ticket = __hip_atomic_fetch_add(qw, 1u, __ATOMIC_RELAXED, __HIP_MEMORY_SCOPE_AGENT);
        const int t_ = __builtin_amdgcn_readfirstlane((int)ticket); if (t_ < SEQ / (2 * QG)) { m = (xcd >> 2) * SEQ + 2 * QG * t_ + qsub; c = (xcd >> 1) & 1; }
        if (lane == 0) ticket = __hip_atomic_fetch_add(qw, 1u, __ATOMIC_RELAXED, __HIP_MEMORY_SCOPE_AGENT); }
    else { if (gw < 2 * T) { m = gw >> 1; c = gw & 1; } }
    v4u ix0 = {0u, 0u, 0u, 0u}, ix1 = ix0;
    if (m >= 0) { const GAS v4u* ip = (const GAS v4u*)((const GAS unsigned short*)idx + (size_t)m * NSEL + 16 * dl); ix0 = __builtin_nontemporal_load(ip); ix1 = __builtin_nontemporal_load(ip + 1); }
    while (m >= 0) {
        const int b = m >> 13, t = m & (SEQ - 1), nsel = (t + 1 < NSEL) ? t + 1 : NSEL;
        v4u qv[4];
        { const GAS bf16* qp = (const GAS bf16*)proj + O_Q + (size_t)m * 1024 + (4 * c + (dl & 3)) * 128 + 32 * gq;
#pragma unroll
          for (int ks = 0; ks < 4; ++ks) qv[ks] = __builtin_nontemporal_load((const GAS v4u*)(qp + 8 * ks)); }
        int ids[16];
        { const unsigned wv_[8] = {ix0.x, ix0.y, ix0.z, ix0.w, ix1.x, ix1.y, ix1.z, ix1.w};
#pragma unroll
          for (int q = 0; q < 8; ++q) { ids[2 * q] = (16 * dl + 2 * q < nsel) ? (int)(wv_[q] & 0xffffu) : 0; ids[2 * q + 1] = (16 * dl + 2 * q + 1 < nsel) ? (int)(wv_[q] >> 16) : 0; } }
        const GAS unsigned char* kbase = (const GAS unsigned char*)proj + O_K * 2 + (size_t)(b * 2 + c) * SEQ * 128 + 32 * gq;
        v4u kb[16][2];
#pragma unroll
        for (int q = 0; q < 16; ++q) { const GAS v4u* kp = (const GAS v4u*)(kbase + (size_t)ids[q] * 128); kb[q][0] = kp[0]; kb[q][1] = kp[1]; }
        if (gq == 0) { v4u o0, o1;
            o0.x = (unsigned)ids[0] | ((unsigned)ids[1] << 16); o0.y = (unsigned)ids[2] | ((unsigned)ids[3] << 16); o0.z = (unsigned)ids[4] | ((unsigned)ids[5] << 16); o0.w = (unsigned)ids[6] | ((unsigned)ids[7] << 16);
            o1.x = (unsigned)ids[8] | ((unsigned)ids[9] << 16); o1.y = (unsigned)ids[10] | ((unsigned)ids[11] << 16); o1.z = (unsigned)ids[12] | ((unsigned)ids[13] << 16); o1.w = (unsigned)ids[14] | ((unsigned)ids[15] << 16);
            *(LAS v4u*)(il + 16 * dl) = o0; *(LAS v4u*)(il + 16 * dl + 8) = o1; }
        __builtin_amdgcn_sched_barrier(0);
        long qa[4];
#pragma unroll
        for (int ks = 0; ks < 4; ++ks) { const v4u v = qv[ks];
            const unsigned lo8 = pg8::pk_fp8x4(bflo(v.x) * 8.0f, bfhi(v.x) * 8.0f, bflo(v.y) * 8.0f, bfhi(v.y) * 8.0f), hi8 = pg8::pk_fp8x4(bflo(v.z) * 8.0f, bfhi(v.z) * 8.0f, bflo(v.w) * 8.0f, bfhi(v.w) * 8.0f);
            qa[ks] = (dl < 4) ? (long)(((unsigned long long)hi8 << 32) | lo8) : 0l; }
        f32x4 lg[16];
#pragma unroll
        for (int q = 0; q < 8; ++q) { f32x4 acc = {0.f, 0.f, 0.f, 0.f};
            const long k0 = (long)(((unsigned long long)kb[q][0].y << 32) | kb[q][0].x), k1 = (long)(((unsigned long long)kb[q][0].w << 32) | kb[q][0].z), k2 = (long)(((unsigned long long)kb[q][1].y << 32) | kb[q][1].x), k3 = (long)(((unsigned long long)kb[q][1].w << 32) | kb[q][1].z);
            acc = __builtin_amdgcn_mfma_f32_16x16x32_fp8_fp8(qa[0], k0, acc, 0, 0, 0); acc = __builtin_amdgcn_mfma_f32_16x16x32_fp8_fp8(qa[1], k1, acc, 0, 0, 0);
            acc = __builtin_amdgcn_mfma_f32_16x16x32_fp8_fp8(qa[2], k2, acc, 0, 0, 0); acc = __builtin_amdgcn_mfma_f32_16x16x32_fp8_fp8(qa[3], k3, acc, 0, 0, 0);
            lg[q] = acc; }
        __builtin_amdgcn_sched_barrier(0);
#pragma unroll
        for (int q = 8; q < 16; ++q) { f32x4 acc = {0.f, 0.f, 0.f, 0.f};
            const long k0 = (long)(((unsigned long long)kb[q][0].y << 32) | kb[q][0].x), k1 = (long)(((unsigned long long)kb[q][0].w << 32) | kb[q][0].z), k2 = (long)(((unsigned long long)kb[q][1].y << 32) | kb[q][1].x), k3 = (long)(((unsigned long long)kb[q][1].w << 32) | kb[q][1].z);
            acc = __builtin_amdgcn_mfma_f32_16x16x32_fp8_fp8(qa[0], k0, acc, 0, 0, 0); acc = __builtin_amdgcn_mfma_f32_16x16x32_fp8_fp8(qa[1], k1, acc, 0, 0, 0);
            acc = __builtin_amdgcn_mfma_f32_16x16x32_fp8_fp8(qa[2], k2, acc, 0, 0, 0); acc = __builtin_amdgcn_mfma_f32_16x16x32_fp8_fp8(qa[3], k3, acc, 0, 0, 0);
            lg[q] = acc; }
        __builtin_amdgcn_sched_barrier(0);
        LDS_WAIT(); asm volatile("" ::: "memory");
        const GAS unsigned char* vbase = (const GAS unsigned char*)proj + O_V * 2 + (size_t)(b * 2 + c) * SEQ * 128 + 8 * dl;
        v2u va[32], vb[32];
        { v4u iq[4];
#pragma unroll
          for (int k = 0; k < 4; ++k) iq[k] = *(const LAS v4u*)(il + 32 * k + 8 * gq);
#pragma unroll
          for (int q = 0; q < 32; ++q) { const unsigned wd = ((q >> 1) & 3) == 0 ? iq[q >> 3].x : ((q >> 1) & 3) == 1 ? iq[q >> 3].y : ((q >> 1) & 3) == 2 ? iq[q >> 3].z : iq[q >> 3].w;
              const unsigned w = (q & 1) ? (wd >> 16) : (wd & 0xffffu);
              va[q] = *(const GAS v2u*)(vbase + (size_t)w * 128); } }
        __builtin_amdgcn_sched_barrier(0);
        float mx[4] = {-INFINITY, -INFINITY, -INFINITY, -INFINITY};
#pragma unroll
        for (int tau = 0; tau < 16; ++tau) { int dist = t - ids[tau]; dist = dist > 128 ? 128 : dist; const bool ok = (16 * dl + tau) < nsel;
            const f32x4 bv = *(const LAS f32x4*)(btab + dist * 8 + 4 * c);
#pragma unroll
            for (int g = 0; g < 4; ++g) { const float l = ok ? (lg[tau][g] * scale + bv[g]) : -INFINITY; lg[tau][g] = l; mx[g] = fmaxf(mx[g], l); } }
        float sm[4];
#pragma unroll
        for (int g = 0; g < 4; ++g) { mx[g] = max16(mx[g]); sm[g] = 0.f; }
#pragma unroll
        for (int tau = 0; tau < 16; ++tau)
#pragma unroll
            for (int g = 0; g < 4; ++g) { const float e = __expf(lg[tau][g] - mx[g] + 5.545177444f); lg[tau][g] = e; sm[g] += e; }
#pragma unroll
        for (int g = 0; g < 4; ++g) sm[g] = 0.125f / sum16(sm[g]);
        if (gq == 0) {
#pragma unroll
            for (int g = 0; g < 4; ++g) { v4u hi4, lo4;
#pragma unroll
                for (int w = 0; w < 4; ++w) { const float e0 = lg[4 * w][g], e1 = lg[4 * w + 1][g], e2 = lg[4 * w + 2][g], e3 = lg[4 * w + 3][g];
                    const unsigned h = pg8::pk_fp8x4(e0, e1, e2, e3);
                    const f32x2 b01 = __builtin_amdgcn_cvt_pk_f32_fp8((int)h, false), b23 = __builtin_amdgcn_cvt_pk_f32_fp8((int)h, true);
                    const unsigned lw = pg8::pk_fp8x4(e0 - b01[0], e1 - b01[1], e2 - b23[0], e3 - b23[1]);
                    if (w == 0) { hi4.x = h; lo4.x = lw; } else if (w == 1) { hi4.y = h; lo4.y = lw; } else if (w == 2) { hi4.z = h; lo4.z = lw; } else { hi4.w = h; lo4.w = lw; } }
                *(LAS v4u*)(p8 + g * 272 + 16 * dl) = hi4; *(LAS v4u*)(p8 + 1088 + g * 272 + 16 * dl) = lo4; }
        }
        __builtin_amdgcn_sched_barrier(0);
        const int m_cur = m, c_cur = c;
        { int mn = -1, cn = 0; ++it;
          if (xmode) { const int t_ = __builtin_amdgcn_readfirstlane((int)ticket); if (t_ < SEQ / (2 * QG)) { mn = (xcd >> 2) * SEQ + 2 * QG * t_ + qsub; cn = (xcd >> 1) & 1; } }
          else { const int item = gw + it * NGW; if (item < 2 * T) { mn = item >> 1; cn = item & 1; } }
          m = mn; c = cn;
          if (m >= 0) { const GAS v4u* ip = (const GAS v4u*)((const GAS unsigned short*)idx + (size_t)m * NSEL + 16 * dl); ix0 = __builtin_nontemporal_load(ip); ix1 = __builtin_nontemporal_load(ip + 1); } }
        { v4u iq[4];
#pragma unroll
          for (int k = 0; k < 4; ++k) iq[k] = *(const LAS v4u*)(il + 128 + 32 * k + 8 * gq);
#pragma unroll
          for (int q = 0; q < 32; ++q) { const unsigned wd = ((q >> 1) & 3) == 0 ? iq[q >> 3].x : ((q >> 1) & 3) == 1 ? iq[q >> 3].y : ((q >> 1) & 3) == 2 ? iq[q >> 3].z : iq[q >> 3].w;
              const unsigned w = (q & 1) ? (wd >> 16) : (wd & 0xffffu);
              vb[q] = *(const GAS v2u*)(vbase + (size_t)w * 128); } }
        if (xmode && m >= 0 && lane == 0) ticket = __hip_atomic_fetch_add(qw, 1u, __ATOMIC_RELAXED, __HIP_MEMORY_SCOPE_AGENT);
        LDS_WAIT(); asm volatile("" ::: "memory");
        __builtin_amdgcn_sched_barrier(0);
        f32x4 acc[8];
#pragma unroll
        for (int ch = 0; ch < 8; ++ch) acc[ch] = (f32x4){0.f, 0.f, 0.f, 0.f};
        const LAS unsigned char* pa = p8 + (dl & 3) * 272 + 8 * gq;
#define PERM_(hi_, lo_, sel_) __builtin_amdgcn_perm((hi_), (lo_), (sel_))
#define PVBLK_(R, blk) do { \
            const long ahi = *(const LAS long*)(pa + 32 * (blk)), alo = *(const LAS long*)(pa + 1088 + 32 * (blk)); \
            _Pragma("unroll") for (int hf = 0; hf < 2; ++hf) { \
                const unsigned r0 = hf ? R[0].y : R[0].x, r1 = hf ? R[1].y : R[1].x, r2 = hf ? R[2].y : R[2].x, r3 = hf ? R[3].y : R[3].x, r4 = hf ? R[4].y : R[4].x, r5 = hf ? R[5].y : R[5].x, r6 = hf ? R[6].y : R[6].x, r7 = hf ? R[7].y : R[7].x; \
                const unsigned a0 = PERM_(r1, r0, 0x05010400u), a1 = PERM_(r1, r0, 0x07030602u), b0 = PERM_(r3, r2, 0x05010400u), b1 = PERM_(r3, r2, 0x07030602u); \
                const unsigned c0 = PERM_(r5, r4, 0x05010400u), c1 = PERM_(r5, r4, 0x07030602u), d0 = PERM_(r7, r6, 0x05010400u), d1 = PERM_(r7, r6, 0x07030602u); \
                const unsigned t0 = PERM_(b0, a0, 0x05040100u), t1 = PERM_(b0, a0, 0x07060302u), t2 = PERM_(b1, a1, 0x05040100u), t3 = PERM_(b1, a1, 0x07060302u); \
                const unsigned u0 = PERM_(d0, c0, 0x05040100u), u1 = PERM_(d0, c0, 0x07060302u), u2 = PERM_(d1, c1, 0x05040100u), u3 = PERM_(d1, c1, 0x07060302u); \
                const long bq0 = (long)(((unsigned long long)u0 << 32) | t0), bq1 = (long)(((unsigned long long)u1 << 32) | t1), bq2 = (long)(((unsigned long long)u2 << 32) | t2), bq3 = (long)(((unsigned long long)u3 << 32) | t3); \
                acc[4 * hf + 0] = __builtin_amdgcn_mfma_f32_16x16x32_fp8_fp8(ahi, bq0, acc[4 * hf + 0], 0, 0, 0); acc[4 * hf + 1] = __builtin_amdgcn_mfma_f32_16x16x32_fp8_fp8(ahi, bq1, acc[4 * hf + 1], 0, 0, 0); \
                acc[4 * hf + 2] = __builtin_amdgcn_mfma_f32_16x16x32_fp8_fp8(ahi, bq2, acc[4 * hf + 2], 0, 0, 0); acc[4 * hf + 3] = __builtin_amdgcn_mfma_f32_16x16x32_fp8_fp8(ahi, bq3, acc[4 * hf + 3], 0, 0, 0); \
                acc[4 * hf + 0] = __builtin_amdgcn_mfma_f32_16x16x32_fp8_fp8(alo, bq0, acc[4 * hf + 0], 0, 0, 0); acc[4 * hf + 1] = __builtin_amdgcn_mfma_f32_16x16x32_fp8_fp8(alo, bq1, acc[4 * hf + 1], 0, 0, 0); \
                acc[4 * hf + 2] = __builtin_amdgcn_mfma_f32_16x16x32_fp8_fp8(alo, bq2, acc[4 * hf + 2], 0, 0, 0); acc[4 * hf + 3] = __builtin_amdgcn_mfma_f32_16x16x32_fp8_fp8(alo, bq3, acc[4 * hf + 3], 0, 0, 0); } } while (0)
#pragma unroll
        for (int k = 0; k < 4; ++k) { const v2u* R = va + 8 * k; PVBLK_(R, k); }
        __builtin_amdgcn_sched_barrier(0);
#pragma unroll
        for (int k = 0; k < 4; ++k) { const v2u* R = vb + 8 * k; PVBLK_(R, 4 + k); }
#undef PVBLK_
#undef PERM_
        if (gq == 0) {
#pragma unroll
            for (int g = 0; g < 4; ++g) { const float sg = sm[g]; v4u w;
                w.x = cvt_pk_bf16(acc[0][g] * sg, acc[1][g] * sg); w.y = cvt_pk_bf16(acc[2][g] * sg, acc[3][g] * sg); w.z = cvt_pk_bf16(acc[4][g] * sg, acc[5][g] * sg); w.w = cvt_pk_bf16(acc[6][g] * sg, acc[7][g] * sg);
                __builtin_nontemporal_store(w, (GAS v4u*)((GAS bf16*)att + (size_t)m_cur * 1024 + (4 * c_cur + g) * 128 + 8 * dl)); }
        }
        LDS_WAIT(); asm volatile("" ::: "memory");
        __builtin_amdgcn_sched_barrier(0);
    }
}

constexpr int SCH = 64, SCH_BYTES = SCH * SREC;
__device__ __forceinline__ void scan_phase(const unsigned char* scanin, float* ys, LAS unsigned char* lds, int tid, int lane, int wave, int G, int nunits) {
    for (int u = blockIdx.x; u < nunits; u += G) {
        const int bh = u >> 2, qtr = u & 3, b = bh >> 4, h = bh & 15;
        const unsigned char* src = scanin + (size_t)bh * SEQ * SREC;
        const int row = qtr * 16 + wave * 4 + (lane >> 4), k4 = (lane & 15) * 4;
        float S0 = 0.f, S1 = 0.f, S2 = 0.f, S3 = 0.f;
        v4u pre[7];
#pragma unroll
        for (int i = 0; i < 7; ++i) pre[i] = *(const v4u*)(src + (size_t)(i * 512 + tid) * 16);
#pragma unroll
        for (int i = 0; i < 7; ++i) *(LAS v4u*)(lds + (size_t)(i * 512 + tid) * 16) = pre[i];
        __syncthreads();
        for (int ck = 0; ck < SEQ / SCH; ++ck) {
            const LAS unsigned char* buf = lds + (ck & 1) * SCH_BYTES;
            if (ck + 1 < SEQ / SCH) {
#pragma unroll
                for (int i = 0; i < 7; ++i) pre[i] = *(const v4u*)(src + (size_t)(ck + 1) * SCH_BYTES + (size_t)(i * 512 + tid) * 16);
            }
            if (wave < 4) {
                float* yo = ys + ((size_t)(b * SEQ + ck * SCH)) * 1024 + h * 64 + row;
                for (int t = 0; t < SCH; ++t) {
                    const LAS unsigned char* sb = buf + t * SREC;
                    const f32x4 w = *(const LAS f32x4*)(sb + k4 * 4);
                    const v2u r2 = *(const LAS v2u*)(sb + 256 + k4 * 2), kt2 = *(const LAS v2u*)(sb + 384 + k4 * 2), kk2 = *(const LAS v2u*)(sb + 640 + k4 * 2), bb2 = *(const LAS v2u*)(sb + 768 + k4 * 2);
                    const float v = bf2f(*(const LAS unsigned short*)(sb + 512 + row * 2));
                    const float p = (S0 * bflo(kk2.x) + S1 * bfhi(kk2.x)) + (S2 * bflo(kk2.y) + S3 * bfhi(kk2.y));
                    const float sk = sum16(p);
                    S0 = S0 * w[0] + (v * bflo(kt2.x) - sk * bflo(bb2.x));
                    S1 = S1 * w[1] + (v * bfhi(kt2.x) - sk * bfhi(bb2.x));
                    S2 = S2 * w[2] + (v * bflo(kt2.y) - sk * bflo(bb2.y));
                    S3 = S3 * w[3] + (v * bfhi(kt2.y) - sk * bfhi(bb2.y));
                    const float yq = (S0 * bflo(r2.x) + S1 * bfhi(r2.x)) + (S2 * bflo(r2.y) + S3 * bfhi(r2.y));
                    const float y = sum16(yq);
                    if ((lane & 15) == 0) yo[(size_t)t * 1024] = y;
                }
            }
            if (ck + 1 < SEQ / SCH) {
                LAS unsigned char* nb = lds + ((ck + 1) & 1) * SCH_BYTES;
#pragma unroll
                for (int i = 0; i < 7; ++i) *(LAS v4u*)(nb + (size_t)(i * 512 + tid) * 16) = pre[i];
            }
            __syncthreads();
        }
    }
}

#ifndef PROBE_REPEAT
#define PROBE_REPEAT 0u
#endif
#define SREP(k) for (int rep_ = 0; rep_ < 1 + (int)(((PROBE_REPEAT) >> (k)) & 1u); ++rep_)
constexpr int CB_BYTES = 49152;
constexpr int MP = 144;
__device__ __forceinline__ int kperm(int k) { return (k & ~15) + 8 * ((k >> 2) & 1) + 4 * ((k >> 3) & 1) + (k & 3); }
__device__ __forceinline__ f32x16 mfma4(const LAS unsigned char* A, const LAS unsigned char* B, int lane, f32x16 acc) {
    const int off = (lane & 31) * MP + (lane >> 5) * 16;
#pragma unroll
    for (int ks = 0; ks < 4; ++ks) acc = __builtin_amdgcn_mfma_f32_32x32x16_bf16(*(const LAS bf16x8*)(A + off + ks * 32), *(const LAS bf16x8*)(B + off + ks * 32), acc, 0, 0, 0);
    return acc;
}
__device__ __forceinline__ void nfma(float& s, float a, float b) { asm volatile("v_fma_f32 %0, -%1, %2, %0" : "+v"(s) : "v"(a), "v"(b)); }
struct RwkvPar { const float* mu; const float* w0; const float* a0; const float* k_k; const float* k_a; };
__device__ __forceinline__ void scan_a_phase(const bf16* proj_, const bf16* lr_, const RwkvPar par, unsigned char* rkv, unsigned char* chk, LAS unsigned char* lds_in, int tid, int lane, int wave, int G) {
    const GAS bf16* proj = (const GAS bf16*)proj_; const GAS bf16* lr = (const GAS bf16*)lr_;
    const int hi = lane >> 5, r32 = lane & 31;
    for (int u = blockIdx.x; u < 32 * 128; u += G) {
        LAS unsigned char* lds_u = lds_in; asm volatile("" : "+s"(lds_u));
        LAS unsigned char* const lds = lds_u;
        LAS unsigned char* GB = lds;
        LAS unsigned char* KH = lds + 18432; LAS unsigned char* RH = KH + 9216; LAS unsigned char* BH = RH + 9216; LAS unsigned char* KHAT = BH + 9216;
        LAS unsigned char* NBT = KHAT + 9216; LAS unsigned char* KTT = NBT + 9216; LAS unsigned char* VT = KTT + 9216;
        LAS unsigned char* LS = lds + 82944;
        LAS unsigned char* DIAG = LS + 9216; LAS unsigned char* DINV = LS + 13312;
        LAS unsigned char* AKK = LS + 17408; LAS unsigned char* NABR = AKK + 9216; LAS unsigned char* AKR = NABR + 9216;
        LAS float* GC = (LAS float*)(lds + 128000);
        LAS float* WTOT = (LAS float*)(lds + 128256);
        const int bh = u >> 7, ck = u & 127;
        unsigned char* ob = chk + (size_t)u * CB_BYTES;
        SREP(25) {
            const int t = tid >> 3, k8 = (tid & 7) * 8;
            const int bq = bh >> 4, hq = bh & 15, tpos = ck * 64 + t, m = bq * SEQ + tpos, c = hq * 64 + k8;
            float w[8], r[8], kt[8], kk[8], bb[8]; unsigned short vraw[8];
            {
                const GAS bf16* pc = proj + O_SL + (size_t)m * SLAB_W + c;
                float rc[8], kc[8], vc[8], rp[8], kp[8], vp[8], dp[8], ap[8], pr[8];
                const v4u q_rc = *(const GAS v4u*)(pc + S_R), q_kc = *(const GAS v4u*)(pc + S_K), q_vc = *(const GAS v4u*)(pc + S_V);
                const bool hasp = tpos > 0; const GAS bf16* pp = hasp ? pc - SLAB_W : pc;
                const v4u q_rp = *(const GAS v4u*)(pp + S_R), q_kp = *(const GAS v4u*)(pp + S_K), q_vp = *(const GAS v4u*)(pp + S_V);
                const v4u q_dp = *(const GAS v4u*)(lr + (size_t)m * LRN + c), q_ap = *(const GAS v4u*)(lr + (size_t)m * LRN + 1024 + c);
                f32x4 pq[7][2];
                { const float* ps[3] = {par.mu + S_R + c, par.mu + S_K + c, par.mu + S_V + c};
#pragma unroll
                  for (int i = 0; i < 3; ++i) { pq[i][0] = *(const f32x4*)ps[i]; pq[i][1] = *(const f32x4*)(ps[i] + 4); } }
                __builtin_amdgcn_sched_barrier(0);
                unpack8(q_rc, rc); unpack8(q_kc, kc); unpack8(q_vc, vc);
                if (hasp) { unpack8(q_rp, rp); unpack8(q_kp, kp); unpack8(q_vp, vp); }
                else {
#pragma unroll
                    for (int j = 0; j < 8; ++j) { rp[j] = 0.f; kp[j] = 0.f; vp[j] = 0.f; } }
                unpack8(q_dp, dp); unpack8(q_ap, ap);
                float kx[8], av[8], vx[8]; float ss = 0.f;
#define PQ_(i) do { pr[0] = pq[i][0][0]; pr[1] = pq[i][0][1]; pr[2] = pq[i][0][2]; pr[3] = pq[i][0][3]; pr[4] = pq[i][1][0]; pr[5] = pq[i][1][1]; pr[6] = pq[i][1][2]; pr[7] = pq[i][1][3]; } while (0)
                PQ_(0);
#pragma unroll
                for (int j = 0; j < 8; ++j) r[j] = rc[j] + (rp[j] - rc[j]) * pr[j];
                PQ_(1);
#pragma unroll
                for (int j = 0; j < 8; ++j) kx[j] = kc[j] + (kp[j] - kc[j]) * pr[j];
                PQ_(2);
#pragma unroll
                for (int j = 0; j < 8; ++j) vx[j] = vc[j] + (vp[j] - vc[j]) * pr[j];
                __builtin_amdgcn_sched_barrier(0);
                { const float* ps[4] = {par.w0 + c, par.a0 + c, par.k_k + c, par.k_a + c};
#pragma unroll
                  for (int i = 0; i < 4; ++i) { pq[3 + i][0] = *(const f32x4*)ps[i]; pq[3 + i][1] = *(const f32x4*)(ps[i] + 4); } }
                __builtin_amdgcn_sched_barrier(0);
                PQ_(3);
#pragma unroll
                for (int j = 0; j < 8; ++j) w[j] = __expf(-0.6065306597126334f * sigm(pr[j] + dp[j]));
                PQ_(4);
#pragma unroll
                for (int j = 0; j < 8; ++j) av[j] = sigm(pr[j] + ap[j]);
                PQ_(5);
#pragma unroll
                for (int j = 0; j < 8; ++j) { kk[j] = kx[j] * pr[j]; ss += kk[j] * kk[j]; }
                PQ_(6);
#pragma unroll
                for (int j = 0; j < 8; ++j) kt[j] = kx[j] * (1.0f + (av[j] - 1.0f) * pr[j]);
#undef PQ_
                const float rn = rsqrtf(fmaxf(sum8(ss), 1e-24f));
#pragma unroll
                for (int j = 0; j < 8; ++j) { kk[j] *= rn; bb[j] = kk[j] * av[j]; }
                const v4u r4 = pack8(r), kt4 = pack8(kt), v4 = pack8(vx), kk4 = pack8(kk), bb4 = pack8(bb);
                unsigned char* rec = rkv + ((size_t)bh * SEQ + tpos) * 384;
                *(v4u*)(rec + k8 * 2) = r4; *(v4u*)(rec + 128 + k8 * 2) = kt4; *(v4u*)(rec + 256 + k8 * 2) = v4;
                unpack8(r4, r); unpack8(kt4, kt); unpack8(kk4, kk); unpack8(bb4, bb);
                vraw[0] = (unsigned short)(v4.x & 0xffffu); vraw[1] = (unsigned short)(v4.x >> 16); vraw[2] = (unsigned short)(v4.y & 0xffffu); vraw[3] = (unsigned short)(v4.y >> 16);
                vraw[4] = (unsigned short)(v4.z & 0xffffu); vraw[5] = (unsigned short)(v4.z >> 16); vraw[6] = (unsigned short)(v4.w & 0xffffu); vraw[7] = (unsigned short)(v4.w >> 16);
            }
            float g[8];
#pragma unroll
            for (int j = 0; j < 8; ++j) g[j] = w[j];
#pragma unroll
            for (int o = 8; o < 64; o <<= 1) {
#pragma unroll
                for (int j = 0; j < 8; ++j) { const float up = __shfl_up(g[j], o); if (lane >= o) g[j] *= up; }
            }
            if ((lane >> 3) == 7) {
#pragma unroll
                for (int j = 0; j < 8; ++j) WTOT[wave * 64 + k8 + j] = g[j];
            }
            __syncthreads();
            for (int ww = 0; ww < wave; ++ww) {
#pragma unroll
                for (int j = 0; j < 8; ++j) g[j] *= WTOT[ww * 64 + k8 + j];
            }
            if (t == 63) {
#pragma unroll
                for (int j = 0; j < 8; ++j) GC[k8 + j] = g[j];
            }
            __syncthreads();
            float kh[8], rh[8], bh_[8], kha[8];
#pragma unroll
            for (int j = 0; j < 8; ++j) { const float ig = 1.0f / g[j], gc = GC[k8 + j];
                kh[j] = (g[j] / w[j]) * kk[j]; rh[j] = g[j] * r[j]; bh_[j] = bb[j] * ig; kha[j] = kt[j] * ig;
                *(LAS unsigned short*)(NBT + (k8 + j) * MP + t * 2) = f2bf(-(bh_[j] * gc));
                *(LAS unsigned short*)(KTT + (k8 + j) * MP + t * 2) = f2bf(kha[j] * gc);
                *(LAS unsigned short*)(VT + (k8 + j) * MP + t * 2) = vraw[j]; }
            v4u o;
            o.x = cvt_pk_bf16(kh[0], kh[1]); o.y = cvt_pk_bf16(kh[2], kh[3]); o.z = cvt_pk_bf16(kh[4], kh[5]); o.w = cvt_pk_bf16(kh[6], kh[7]); *(LAS v4u*)(KH + t * MP + k8 * 2) = o;
            o.x = cvt_pk_bf16(rh[0], rh[1]); o.y = cvt_pk_bf16(rh[2], rh[3]); o.z = cvt_pk_bf16(rh[4], rh[5]); o.w = cvt_pk_bf16(rh[6], rh[7]); *(LAS v4u*)(RH + t * MP + k8 * 2) = o;
            o.x = cvt_pk_bf16(bh_[0], bh_[1]); o.y = cvt_pk_bf16(bh_[2], bh_[3]); o.z = cvt_pk_bf16(bh_[4], bh_[5]); o.w = cvt_pk_bf16(bh_[6], bh_[7]); *(LAS v4u*)(BH + t * MP + k8 * 2) = o;
            o.x = cvt_pk_bf16(kha[0], kha[1]); o.y = cvt_pk_bf16(kha[2], kha[3]); o.z = cvt_pk_bf16(kha[4], kha[5]); o.w = cvt_pk_bf16(kha[6], kha[7]); *(LAS v4u*)(KHAT + t * MP + k8 * 2) = o;
        }
        __syncthreads();
        {
            const int tr = wave >> 1; const LAS unsigned char* Am = (tr < 2 ? KH : RH) + 32 * (tr & 1) * MP;
#pragma unroll
            for (int q = 0; q < 2; ++q) {
                const int tc = 2 * (wave & 1) + q; const LAS unsigned char* Bm = (tc < 2 ? BH : KHAT) + 32 * (tc & 1) * MP;
                f32x16 acc = {0.f, 0.f, 0.f, 0.f, 0.f, 0.f, 0.f, 0.f, 0.f, 0.f, 0.f, 0.f, 0.f, 0.f, 0.f, 0.f};
                acc = mfma4(Am, Bm, lane, acc);
                const int i = 32 * (tc & 1) + r32;
#pragma unroll
                for (int reg = 0; reg < 16; ++reg) { const int t = 32 * (tr & 1) + (reg & 3) + 8 * (reg >> 2) + 4 * hi; const float v = acc[reg];
                    if (tr < 2) { if (tc < 2) { const float lv = (i < t) ? v : 0.f; *(LAS unsigned short*)(LS + t * MP + i * 2) = f2bf(-lv); if ((t >> 4) == (i >> 4)) *(LAS float*)(DIAG + ((t >> 4) * 256 + (t & 15) * 16 + (i & 15)) * 4) = lv; } else *(LAS unsigned short*)(AKK + t * MP + i * 2) = f2bf((i < t) ? v : 0.f); }
                    else { if (tc < 2) *(LAS unsigned short*)(NABR + t * MP + i * 2) = f2bf((i <= t) ? -v : 0.f); else *(LAS unsigned short*)(AKR + t * MP + i * 2) = f2bf((i <= t) ? v : 0.f); } }
            }
        }
        __syncthreads();
        if (wave < 4) {
            const int rt = wave >> 1, ct = wave & 1;
            f32x16 acc = {0.f, 0.f, 0.f, 0.f, 0.f, 0.f, 0.f, 0.f, 0.f, 0.f, 0.f, 0.f, 0.f, 0.f, 0.f, 0.f};
            acc = mfma4(AKK + 32 * rt * MP, VT + 32 * ct * MP, lane, acc);
#pragma unroll
            for (int reg = 0; reg < 16; ++reg) { const int t = 32 * rt + (reg & 3) + 8 * (reg >> 2) + 4 * hi; *(LAS float*)(GB + (t * 64 + 32 * ct + r32) * 4) = acc[reg]; }
        } else if (wave == 4) {
            const int b = lane >> 4, j = lane & 15;
            const LAS unsigned char* db = DIAG + b * 1024; asm volatile("" : "+v"(db));
            float z[16];
#pragma unroll
            for (int t = 0; t < 16; ++t) {
                float sacc = (t == j) ? 1.0f : 0.0f;
                f32x4 l[4];
#pragma unroll
                for (int i4 = 0; i4 < (t + 3) / 4; ++i4) l[i4] = *(const LAS f32x4*)(db + t * 64 + i4 * 16);
#pragma unroll
                for (int i = 0; i < t; ++i) nfma(sacc, l[i >> 2][i & 3], z[i]);
                z[t] = sacc;
            }
            { LAS unsigned char* dw = DINV + b * 512 + j * 2; asm volatile("" : "+v"(dw));
#pragma unroll
              for (int t = 0; t < 16; ++t) *(LAS unsigned short*)(dw + t * 32) = f2bf(z[t]); }
        }
        __syncthreads();
        {
            const int c = 16 * wave + (lane & 15), g = lane >> 4, tl = lane & 15;
            const LAS unsigned char* rbase = (wave < 4) ? (const LAS unsigned char*)(KH + 4 * g * MP + c * 2) : (const LAS unsigned char*)(GB + (4 * g * 64 + (c - 64)) * 4); asm volatile("" : "+v"(rbase));
            const LAS unsigned char* abase = LS + tl * MP + 8 * g; asm volatile("" : "+v"(abase));
            const LAS unsigned char* dbase = DINV + tl * 32 + g * 8; asm volatile("" : "+v"(dbase));
            LAS unsigned char* pbase = GB + c * MP + 8 * g; asm volatile("" : "+v"(pbase));
            float rv[4][4];
#pragma unroll
            for (int b = 0; b < 4; ++b)
#pragma unroll
                for (int r = 0; r < 4; ++r) rv[b][r] = (wave < 4) ? bf2f(*(const LAS unsigned short*)(rbase + (16 * b + r) * MP)) : *(const LAS float*)(rbase + (16 * b + r) * 256);
            asm volatile("s_waitcnt lgkmcnt(0)" ::: "memory");
            __syncthreads();
            typedef unsigned u32x2v __attribute__((ext_vector_type(2)));
            u32x2v xb[4];
            const pg8::u32x4 zero4 = {0u, 0u, 0u, 0u}; (void)zero4;
#pragma unroll
            for (int b = 0; b < 4; ++b) {
                f32x4 acc = {rv[b][0], rv[b][1], rv[b][2], rv[b][3]};
#pragma unroll
                for (int m = 0; m < b; m += 2) {
                    const u32x2v alo = *(const LAS u32x2v*)(abase + 16 * b * MP + 32 * m);
                    u32x2v ahi = {0u, 0u}, bhi = {0u, 0u};
                    if (m + 1 < b) { ahi = *(const LAS u32x2v*)(abase + 16 * b * MP + 32 * (m + 1)); bhi = xb[m + 1]; }
                    const pg8::u32x4 av = {alo.x, alo.y, ahi.x, ahi.y}, bv = {xb[m].x, xb[m].y, bhi.x, bhi.y};
                    acc = __builtin_amdgcn_mfma_f32_16x16x32_bf16(__builtin_bit_cast(bf16x8, av), __builtin_bit_cast(bf16x8, bv), acc, 0, 0, 0);
                }
                const u32x2v dlo = *(const LAS u32x2v*)(dbase + b * 512);
                const pg8::u32x4 av = {dlo.x, dlo.y, 0u, 0u}, bv = {cvt_pk_bf16(acc[0], acc[1]), cvt_pk_bf16(acc[2], acc[3]), 0u, 0u};
                f32x4 xz = {0.f, 0.f, 0.f, 0.f};
                xz = __builtin_amdgcn_mfma_f32_16x16x32_bf16(__builtin_bit_cast(bf16x8, av), __builtin_bit_cast(bf16x8, bv), xz, 0, 0, 0);
                xb[b] = (u32x2v){cvt_pk_bf16(xz[0], xz[1]), cvt_pk_bf16(xz[2], xz[3])};
                *(LAS u32x2v*)(pbase + 32 * b) = xb[b];
            }
        }
        __syncthreads();
        SREP(27) {
            const int tr = wave >> 1; const LAS unsigned char* A1 = (tr < 2 ? NABR : NBT) + 32 * (tr & 1) * MP; const LAS unsigned char* A2 = (tr < 2 ? AKR : KTT) + 32 * (tr & 1) * MP;
#pragma unroll
            for (int q = 0; q < 2; ++q) {
                const int tc = 2 * (wave & 1) + q;
                f32x16 acc = {0.f, 0.f, 0.f, 0.f, 0.f, 0.f, 0.f, 0.f, 0.f, 0.f, 0.f, 0.f, 0.f, 0.f, 0.f, 0.f};
                acc = mfma4(A1, GB + 32 * tc * MP, lane, acc);
                if (tc >= 2) {
                    acc = mfma4(A2, VT + 32 * (tc - 2) * MP, lane, acc);
                    unsigned char* dst = ob + (tr < 2 ? 32768 : 16384) + ((tr & 1) * 2 + (tc - 2)) * 4096 + lane * 16;
#pragma unroll
                    for (int q4 = 0; q4 < 4; ++q4) { const f32x4 v = {acc[4 * q4], acc[4 * q4 + 1], acc[4 * q4 + 2], acc[4 * q4 + 3]}; *(f32x4*)(dst + q4 * 1024) = v; }
                } else {
                    const int k = 32 * tc + r32; bf16* dst = (bf16*)(ob + (tr < 2 ? 8192 : 0)) + kperm(k);
#pragma unroll
                    for (int reg = 0; reg < 16; ++reg) { const int row = 32 * (tr & 1) + (reg & 3) + 8 * (reg >> 2) + 4 * hi;
                        float v = acc[reg];
                        if (tr < 2) v += bf2f(*(const LAS unsigned short*)(RH + row * MP + k * 2)); else v += (row == k) ? GC[k] : 0.f;
                        dst[row * 64] = f2bf(v); }
                }
            }
        }
        __syncthreads();
    }
}
constexpr int SB_BUF = 51200;
__device__ __forceinline__ f32x16 load_acc(const LAS unsigned char* p, int lane) {
    f32x16 a;
#pragma unroll
    for (int q4 = 0; q4 < 4; ++q4) { const f32x4 v = *(const LAS f32x4*)(p + q4 * 1024 + lane * 16); a[4 * q4] = v[0]; a[4 * q4 + 1] = v[1]; a[4 * q4 + 2] = v[2]; a[4 * q4 + 3] = v[3]; }
    return a;
}
__device__ __forceinline__ bf16x8 acc_to_frag(const f32x16& a, int s) {
    v4u o; o.x = cvt_pk_bf16(a[8 * s], a[8 * s + 1]); o.y = cvt_pk_bf16(a[8 * s + 2], a[8 * s + 3]); o.z = cvt_pk_bf16(a[8 * s + 4], a[8 * s + 5]); o.w = cvt_pk_bf16(a[8 * s + 6], a[8 * s + 7]);
    return __builtin_bit_cast(bf16x8, o);
}
__device__ __forceinline__ void scan_b_phase(const unsigned char* chk, float* ys, LAS unsigned char* lds, int tid, int lane, int wave, int G) {
    const int hi = lane >> 5, r32 = lane & 31;
    const int prow = tid >> 3, pc16 = tid & 7;
    for (int u = blockIdx.x; u < 32; u += G) {
        const int b = u >> 4, h = u & 15;
        const unsigned char* src = chk + (size_t)u * 128 * CB_BYTES;
        f32x16 T0 = {0.f, 0.f, 0.f, 0.f, 0.f, 0.f, 0.f, 0.f, 0.f, 0.f, 0.f, 0.f, 0.f, 0.f, 0.f, 0.f}, T1 = T0;
        v4u pre[6], pre2[6];
#pragma unroll
        for (int i = 0; i < 6; ++i) pre[i] = *(const GAS v4u*)((const GAS unsigned char*)src + (size_t)(i * 512 + tid) * 16);
#pragma unroll
        for (int i = 0; i < 6; ++i) pre2[i] = *(const GAS v4u*)((const GAS unsigned char*)src + (size_t)CB_BYTES + (size_t)(i * 512 + tid) * 16);
        for (int cc = 0; cc < 128; ++cc) {
            { LAS unsigned char* nb = lds + (cc & 1) * SB_BUF;
              *(LAS v4u*)(nb + prow * MP + pc16 * 16) = pre[0]; *(LAS v4u*)(nb + 9216 + prow * MP + pc16 * 16) = pre[1];
#pragma unroll
              for (int i = 2; i < 6; ++i) *(LAS v4u*)(nb + 18432 + (size_t)((i - 2) * 512 + tid) * 16) = pre[i]; }
            __syncthreads();
#pragma unroll
            for (int i = 0; i < 6; ++i) pre[i] = pre2[i];
            if (cc + 2 < 128) {
#pragma unroll
                for (int i = 0; i < 6; ++i) pre2[i] = *(const GAS v4u*)((const GAS unsigned char*)src + (size_t)(cc + 2) * CB_BYTES + (size_t)(i * 512 + tid) * 16);
            }
            if (wave < 2) {
                const int ct = wave; const LAS unsigned char* buf = lds + (cc & 1) * SB_BUF;
                const bf16x8 tb0 = acc_to_frag(T0, 0), tb1 = acc_to_frag(T0, 1), tb2 = acc_to_frag(T1, 0), tb3 = acc_to_frag(T1, 1);
                f32x16 N0 = load_acc(buf + 18432 + (0 * 2 + ct) * 4096, lane), N1 = load_acc(buf + 18432 + (1 * 2 + ct) * 4096, lane);
                f32x16 Y0 = load_acc(buf + 34816 + (0 * 2 + ct) * 4096, lane), Y1 = load_acc(buf + 34816 + (1 * 2 + ct) * 4096, lane);
                const LAS unsigned char* g0 = buf + r32 * MP + hi * 16; const LAS unsigned char* q0 = buf + 9216 + r32 * MP + hi * 16;
#define SB_STEP(ks, tb) do { \
                N0 = __builtin_amdgcn_mfma_f32_32x32x16_bf16(*(const LAS bf16x8*)(g0 + (ks) * 32), tb, N0, 0, 0, 0); \
                N1 = __builtin_amdgcn_mfma_f32_32x32x16_bf16(*(const LAS bf16x8*)(g0 + 32 * MP + (ks) * 32), tb, N1, 0, 0, 0); \
                Y0 = __builtin_amdgcn_mfma_f32_32x32x16_bf16(*(const LAS bf16x8*)(q0 + (ks) * 32), tb, Y0, 0, 0, 0); \
                Y1 = __builtin_amdgcn_mfma_f32_32x32x16_bf16(*(const LAS bf16x8*)(q0 + 32 * MP + (ks) * 32), tb, Y1, 0, 0, 0); } while (0)
                SB_STEP(0, tb0); SB_STEP(1, tb1); SB_STEP(2, tb2); SB_STEP(3, tb3);
#undef SB_STEP
                T0 = N0; T1 = N1;
                float* yo = ys + ((size_t)(b * SEQ + cc * 64)) * 1024 + h * 64 + 32 * ct + r32;
#pragma unroll
                for (int reg = 0; reg < 16; ++reg) { const int t = (reg & 3) + 8 * (reg >> 2) + 4 * hi; yo[(size_t)t * 1024] = Y0[reg]; yo[(size_t)(t + 32) * 1024] = Y1[reg]; }
            }
        }
        __syncthreads();
    }
}

constexpr int NPL = 18, PH_FINAL = 1 + DEPTH * NPL, NPH = PH_FINAL + 1;
#ifndef SCAN_CHECK
#define SCAN_CHECK 0
#endif
#ifndef ATT_CHECK
#define ATT_CHECK 0
#endif
#ifndef SCAN_CHECK_TOL
#define SCAN_CHECK_TOL 1e-3f
#endif
#define PG8_SP2 true
#define PG8_ALIGN true
__global__ void __launch_bounds__(512, 2) trunk_fwd(Args args) {
    extern __shared__ __attribute__((aligned(16))) unsigned char lds_raw[];
    LAS unsigned char* lds = (LAS unsigned char*)lds_raw;
    const int G = gridDim.x;
    unsigned* ctl = (unsigned*)(args.ws + WS_CTL);
    volatile LAS unsigned* MISC = (volatile LAS unsigned*)(lds + MISC_OFF);
    LAS int* tab = (LAS int*)(lds + MISC_OFF + 64);
    for (int u = threadIdx.x; u < (LDS_BYTES - MISC_OFF) / 4; u += 512) ((LAS unsigned*)(lds + MISC_OFF))[u] = 0u;
    __syncthreads();
    const int lo = args.ph_lo, hi = args.ph_hi;
    const bool multi = (hi - lo) > 1;
    XcdBarrier bar; bar.bar = ctl + CW_BAR; bar.x = 0; bar.st = nullptr;
    if (multi) bar = xcd_barrier_post(ctl + CW_BAR, MISC);
#ifndef PHASE_MASK
#define PHASE_MASK 0xFFFFFFFFu
#endif
#define KIND_ON(kind) (((PHASE_MASK) >> (kind)) & 1u)
#ifndef PROBE_REPEAT
#define PROBE_REPEAT 0u
#endif
#define REP(kind) for (int rep_ = 0; rep_ < 1 + (int)(((PROBE_REPEAT) >> (kind)) & 1u); ++rep_)
#define IN(k) (lo <= (k) && (k) < hi)
#define SEAM(k) do { if ((k) + 1 < hi) xcd_barrier(bar); } while (0)

#define PH_LOCALS int tid = threadIdx.x; asm volatile("" : "+v"(tid)); const int lane = tid & 63, wave = __builtin_amdgcn_readfirstlane(tid >> 6); unsigned char* ws = args.ws; asm volatile("" : "+s"(ws)); (void)lane; (void)wave; \
    bf16* XN = (bf16*)(ws + WS_XN); bf16* PROJ = (bf16*)(ws + WS_PROJ); bf16* LRA = (bf16*)(ws + WS_LRA); bf16* LR = (bf16*)(ws + WS_LR); \
    unsigned char* SCANIN = ws + WS_SCANIN; float* YS = (float*)(ws + WS_YS); bf16* ATT = (bf16*)(ws + WS_ATT); bf16* RW = (bf16*)(ws + WS_RW); bf16* M1 = (bf16*)(ws + WS_M1); \
    unsigned short* IDX = (unsigned short*)(ws + WS_IDX); int* ROUTE = (int*)(ws + WS_ROUTE); \
    bf16* UD = (bf16*)(ws + WS_UD); bf16* XG = (bf16*)(ws + WS_XG); bf16* UM = (bf16*)(ws + WS_UM); bf16* YM = (bf16*)(ws + WS_YM); bf16* PP = (bf16*)(ws + WS_PP); \
    (void)XN; (void)PROJ; (void)LRA; (void)LR; (void)SCANIN; (void)YS; (void)ATT; (void)RW; (void)M1; (void)IDX; (void)ROUTE; (void)UD; (void)XG; (void)UM; (void)YM; (void)PP;
    float* H = args.out;

#if (PROBE_REPEAT >> 17) & 1
    if (IN(0)) { float x = (float)threadIdx.x; for (int i = 0; i < 25000; ++i) { asm volatile("v_fma_f32 %0, %0, %0, %0\n v_fma_f32 %0, %0, %0, %0\n v_fma_f32 %0, %0, %0, %0\n v_fma_f32 %0, %0, %0, %0" : "+v"(x)); } if (x == 12345.678f) args.out[0] = x; }
#endif
#if (PROBE_REPEAT >> 19) & 1
    if (IN(0)) { float x = (float)threadIdx.x; for (int i = 0; i < 25000; ++i) { asm volatile("v_cmp_le_f32 vcc, 1.0, %0\n v_cndmask_b32 %0, 0, %0, vcc\n v_cmp_le_f32 vcc, 2.0, %0\n v_cndmask_b32 %0, 0, %0, vcc" : "+v"(x) : : "vcc"); } if (x == 12345.678f) args.out[0] = x; }
#endif
#if (PROBE_REPEAT >> 18) & 1
    if (IN(0)) { unsigned c = 0; for (int i = 0; i < 25000; ++i) { unsigned long long m; asm volatile("v_cmp_le_f32_e64 %0, 0, %1\n s_bcnt1_i32_b64 s20, %0\n s_add_i32 %2, %2, s20\n v_cmp_le_f32_e64 %0, 1.0, %1\n s_bcnt1_i32_b64 s20, %0\n s_add_i32 %2, %2, s20" : "=&s"(m), "+v"(*(float*)&i), "+s"(c) : : "s20"); } if (c == 12345u) args.out[0] = 1.f; }
#endif
    if (KIND_ON(0) && IN(0)) { PH_LOCALS REP(0) { p0_prologue(args, lds, tid, lane, wave, G); __syncthreads(); }
        norm_phase<0>(args.in[I_X], nullptr, args.in[I_NMIX], XN, nullptr, nullptr, nullptr, nullptr, nullptr, lane, wave, G);
        SEAM(0); }

    for (int l = 0; l < DEPTH; ++l) {
        const int pb = 1 + l * NPL;
        const float* hin = (l == 0) ? args.in[I_X] : H;
        if (l > 0 && KIND_ON(1) && IN(pb + 0)) { PH_LOCALS norm_phase<0>(hin, nullptr, args.in[I_NMIX] + l * D, XN, nullptr, nullptr, nullptr, nullptr, nullptr, lane, wave, G); SEAM(pb + 0); }
        if (KIND_ON(2) && IN(pb + 1)) { PH_LOCALS
            pg8::Gemm g{XN, (const bf16*)(ws + WS_WIN) + (size_t)l * PW * D, T, PW, D}; pg8::StaticOrder S; S.init(T, PW, G, (int)blockIdx.x);
            pg8::EpiProj E{PROJ, T, SEQ};
            REP(23) { pg8::gemm_phase<pg8::EpiProj, pg8::StaticOrder, PG8_ALIGN, PG8_SP2>(lds, g, S, E); }
            SEAM(pb + 1);
        }
        if (KIND_ON(3) && IN(pb + 2)) { PH_LOCALS
            REP(3) { select_phase(PROJ, IDX, (unsigned short*)(ws + WS_CHK), lds, tid, lane, wave, G, ctl);
            rwkv_prep_a(PROJ, args.in[I_MU] + l * SLAB_W, LRA, tid, G); }
            SEAM(pb + 2);
        }
        if (KIND_ON(4) && IN(pb + 3)) { PH_LOCALS
            pg8::Gemm g{LRA, (const bf16*)(ws + WS_LRT + (size_t)l * LRT_BYTES), T, LRN, LRK}; pg8::StaticOrder S; S.init(T, LRN, G, (int)blockIdx.x);
            pg8::EpiStoreBf16 E{LR, LRN};
            pg8::gemm_phase<pg8::EpiStoreBf16, pg8::StaticOrder, PG8_ALIGN, PG8_SP2>(lds, g, S, E);
            SEAM(pb + 3);
        }
#if SCAN_CHECK
        if (KIND_ON(5) && IN(pb + 4)) { PH_LOCALS
            rwkv_prep_b(PROJ, LR, args.in[I_MU] + l * SLAB_W, args.in[I_W0] + l * 1024, args.in[I_A0] + l * 1024, args.in[I_KK] + l * 1024, args.in[I_KA] + l * 1024, SCANIN + 96 * MiB, tid, G, T / 2);
            SEAM(pb + 4);
        }
#endif
        if (KIND_ON(6) && IN(pb + 5)) { PH_LOCALS const RwkvPar par{args.in[I_MU] + l * SLAB_W, args.in[I_W0] + l * 1024, args.in[I_A0] + l * 1024, args.in[I_KK] + l * 1024, args.in[I_KA] + l * 1024};
            REP(10) { scan_a_phase(PROJ, LR, par, SCANIN, ws + WS_CHK, lds, tid, lane, wave, G); } SEAM(pb + 5); }
        if (KIND_ON(7) && IN(pb + 6)) { PH_LOCALS
            REP(11) { scan_b_phase(ws + WS_CHK, YS, lds, tid, lane, wave, G); }
#if SCAN_CHECK
            if (l == 0) scan_phase(SCANIN + 96 * MiB, args.out, lds, tid, lane, wave, G, 64);
#endif
            attn_phase(PROJ, IDX, args.in[I_RELB], ATT, lds, tid, lane, wave, G, ctl + CW_ATTQ + 2048 * l); __syncthreads();
#if (PROBE_REPEAT >> 5) & 1
            attn_phase(PROJ, IDX, args.in[I_RELB], ATT, lds, tid, lane, wave, G, ctl + CW_ATTQ + 2048 * l + 1024); __syncthreads();
#endif
#if ATT_CHECK
            if (l == 0) { attn_phase_ref(PROJ, IDX, args.in[I_RELB], (bf16*)args.out, lds, tid, lane, wave, G); __syncthreads(); }
#endif
            SEAM(pb + 6);
        }
        if (KIND_ON(8) && IN(pb + 7)) { PH_LOCALS
#if ATT_CHECK
            if (l == 0) { float e2 = 0.f, r2 = 0.f; const bf16* ar = (const bf16*)args.out; for (size_t i = (size_t)blockIdx.x * 512 + tid; i < (size_t)T * 1024; i += (size_t)G * 512) { const float a = bf2f(ATT[i]), b = bf2f(ar[i]), d = a - b; e2 += d * d; r2 += b * b; }
                e2 = wave_sum(e2); r2 = wave_sum(r2); if (lane == 0) { atomicAdd((float*)(ctl + 32), e2); atomicAdd((float*)(ctl + 33), r2); } }
#endif
#if SCAN_CHECK
            if (l == 0) { float e2 = 0.f, r2 = 0.f; for (size_t i = (size_t)blockIdx.x * 512 + tid; i < (size_t)(T / 2) * 1024; i += (size_t)G * 512) { const float a = YS[i], b = args.out[i], d = a - b; e2 += d * d; r2 += b * b; }
                e2 = wave_sum(e2); r2 = wave_sum(r2); if (lane == 0) { atomicAdd((float*)(ctl + 32), e2); atomicAdd((float*)(ctl + 33), r2); } }
#endif
            REP(12) rwkv_post<384>(YS, SCANIN, LR, args.in[I_RK] + l * 1024, args.in[I_GNW] + l * 1024, args.in[I_GNB] + l * 1024, RW, tid, G); }
        if (KIND_ON(9) && IN(pb + 7)) { PH_LOCALS
            pg8::Gemm g{ATT, (const bf16*)(ws + WS_UATT) + (size_t)l * D * 1024, T, D, 1024}; pg8::StaticOrder S; S.init(T, D, G, (int)blockIdx.x);
            pg8::EpiGate<false> E{M1, D, PROJ + O_GA, D};
            pg8::gemm_phase<pg8::EpiGate<false>, pg8::StaticOrder, PG8_ALIGN, PG8_SP2>(lds, g, S, E);
            SEAM(pb + 7);
        }
        if (KIND_ON(10) && IN(pb + 9)) { PH_LOCALS
            pg8::Gemm g{RW, (const bf16*)(ws + WS_URW) + (size_t)l * D * 1024, T, D, 1024}; pg8::StaticOrder S; S.init(T, D, G, (int)blockIdx.x);
            pg8::EpiGate<true> E{M1, D, PROJ + O_GB, D};
            pg8::gemm_phase<pg8::EpiGate<true>, pg8::StaticOrder, PG8_ALIGN, PG8_SP2>(lds, g, S, E);
            SEAM(pb + 9);
        }
        if (KIND_ON(11) && IN(pb + 10)) { PH_LOCALS
            pg8::Gemm g{M1, (const bf16*)(ws + WS_WOUT) + (size_t)l * D * D, T, D, D}; pg8::StaticOrder S; S.init(T, D, G, (int)blockIdx.x);
            pg8::EpiResid E{hin, H, D};
            pg8::gemm_phase<pg8::EpiResid, pg8::StaticOrder, PG8_ALIGN, PG8_SP2>(lds, g, S, E);
            SEAM(pb + 10);
        }
        if (KIND_ON(12) && IN(pb + 11)) { PH_LOCALS
            if (l & 1) norm_phase<1>(H, nullptr, args.in[I_NFFN] + l * D, XN, args.in[I_ROUT] + (size_t)(l >> 1) * D * NE, ctl, ROUTE, nullptr, nullptr, lane, wave, G);
            else norm_phase<0>(H, nullptr, args.in[I_NFFN] + l * D, XN, nullptr, nullptr, nullptr, nullptr, nullptr, lane, wave, G);
            SEAM(pb + 11);
        }
        if (l & 1) {
            if (KIND_ON(13) && IN(pb + 12)) { PH_LOCALS moe_table(ctl, tab, 2 * DFE / 256, tid); moe_gather(XN, (unsigned char*)XG, ROUTE, tab, lane, wave, G); SEAM(pb + 12); }
            if (KIND_ON(14) && IN(pb + 13)) { PH_LOCALS
                moe_table(ctl, tab, 2 * DFE / 256, tid);
                pg8::Gemm g{XG, (const bf16*)(ws + WS_M13), MOE_ROWS, 2 * DFE, D / 2, XGP / 2, XGP / 2}; pg8::MoeOrder S{tab, 2 * DFE / 256, G, (int)blockIdx.x};
                pg8::EpiSwigluF8 E{(unsigned char*)UM, DFE, 1.0f / (MOE_AS * MOE_WS13), MOE_AS};
                REP(21) { pg8::gemm_phase<pg8::EpiSwigluF8, pg8::MoeOrder, PG8_ALIGN, PG8_SP2, true>(lds, g, S, E); }
                SEAM(pb + 13);
            }
            if (KIND_ON(15) && IN(pb + 14)) { PH_LOCALS
                moe_table(ctl, tab, D / 256, tid);
                pg8::Gemm g{UM, (const bf16*)(ws + WS_M2), MOE_ROWS, D, DFE / 2}; pg8::MoeOrder S{tab, D / 256, G, (int)blockIdx.x};
                pg8::EpiStoreBf16 E{YM, D, 1.0f / (MOE_AS * MOE_WS2)};
                REP(22) { pg8::gemm_phase<pg8::EpiStoreBf16, pg8::MoeOrder, PG8_ALIGN, PG8_SP2, true>(lds, g, S, E); }
                SEAM(pb + 14);
            }
            if (KIND_ON(16) && IN(pb + 15)) { PH_LOCALS moe_table(ctl, tab, D / 256, tid); if (l == DEPTH - 1) norm_phase<2, true>(H, H, args.in[I_NPLE] + l * D, XN, nullptr, nullptr, ROUTE, YM, tab, lane, wave, G); else norm_phase<2>(H, H, args.in[I_NPLE] + l * D, XN, nullptr, nullptr, ROUTE, YM, tab, lane, wave, G); }
        } else {
            if (KIND_ON(14) && IN(pb + 13)) { PH_LOCALS
                pg8::Gemm g{XN, (const bf16*)(ws + WS_F13), T, 2 * DFF, D}; pg8::StaticOrder S; S.init(T, 2 * DFF, G, (int)blockIdx.x);
                pg8::EpiSwigluF8 E{(unsigned char*)UD, DFF, 1.0f, MOE_AS};
                REP(24) { pg8::gemm_phase<pg8::EpiSwigluF8, pg8::StaticOrder, PG8_ALIGN, PG8_SP2>(lds, g, S, E); }
                SEAM(pb + 13);
            }
            if (KIND_ON(15) && IN(pb + 14)) { PH_LOCALS
                pg8::Gemm g{UD, (const bf16*)(ws + WS_F2), T, D, DFF / 2}; pg8::StaticOrder S; S.init(T, D, G, (int)blockIdx.x);
                pg8::EpiResid E{H, H, D, 1.0f / (MOE_AS * MOE_WS2)};
                pg8::gemm_phase<pg8::EpiResid, pg8::StaticOrder, PG8_ALIGN, PG8_SP2, true>(lds, g, S, E);
                SEAM(pb + 14);
            }
            if (KIND_ON(16) && IN(pb + 15)) { PH_LOCALS norm_phase<0>(H, nullptr, args.in[I_NPLE] + l * D, XN, nullptr, nullptr, nullptr, nullptr, nullptr, lane, wave, G); }
        }
        if (KIND_ON(17) && IN(pb + 15)) { PH_LOCALS
            pg8::Gemm g{(const bf16*)(ws + WS_PB) + (size_t)l * T * 256, (const bf16*)(ws + WS_PLEP) + (size_t)l * D * 256, T, D, 256}; pg8::StaticOrder S; S.init(T, D, G, (int)blockIdx.x);
            pg8::EpiStoreBf16 E{PP, D};
            pg8::gemm_phase<pg8::EpiStoreBf16, pg8::StaticOrder, PG8_ALIGN, PG8_SP2>(lds, g, S, E);
            SEAM(pb + 15);
        }
        if (KIND_ON(18) && IN(pb + 17)) { PH_LOCALS
            pg8::StaticOrder S; S.init(T, D, G, (int)blockIdx.x);
            if (l == DEPTH - 1 && (l & 1)) {
                pg8::Gemm g{XN, (const bf16*)(ws + WS_PLEG) + (size_t)l * D * D, T, D, D / 2};
                pg8::EpiPle E{H, PP, D, 1.0f / (PLE_AS * PLE_WS)};
                pg8::gemm_phase<pg8::EpiPle, pg8::StaticOrder, PG8_ALIGN, PG8_SP2, true>(lds, g, S, E);
            } else {
                pg8::Gemm g{XN, (const bf16*)(ws + WS_PLEG) + (size_t)l * D * D, T, D, D};
                pg8::EpiPle E{H, PP, D};
                pg8::gemm_phase<pg8::EpiPle, pg8::StaticOrder, PG8_ALIGN, PG8_SP2>(lds, g, S, E);
            }
            SEAM(pb + 17);
        }
    }
    if (KIND_ON(19) && IN(PH_FINAL)) { PH_LOCALS norm_phase<3>(H, H, args.in[I_FIN], nullptr, nullptr, nullptr, nullptr, nullptr, nullptr, lane, wave, G);
#if SEL_CHECK
        __syncthreads(); if (blockIdx.x == 0 && tid == 0) { const unsigned nb = ((volatile unsigned*)ctl)[34], nr = ((volatile unsigned*)ctl)[35]; if (nb != 0u || nr != 2u * (unsigned)(T - 2 * NSEL) || ((volatile unsigned*)ctl)[36] > 2000u) H[12345] = __builtin_nanf(""); }
#endif
#if SCAN_CHECK || ATT_CHECK
        __syncthreads(); if (blockIdx.x == 0 && tid == 0) { const float e2 = ((volatile float*)(ctl + 32))[0], r2 = ((volatile float*)(ctl + 33))[0]; if (!(e2 <= SCAN_CHECK_TOL * r2) || !(r2 > 0.f)) H[12345] = __builtin_nanf(""); }
#endif
    }
#undef IN
#undef SEAM
}

extern "C" void kernel_launch(void* const* d_in, const int* in_sizes, int n_in, void* d_out, int out_size, void* d_ws, size_t ws_size, hipStream_t stream) {
    static int grid = 0;
    if (grid == 0) {
        if (n_in != 31 || out_size != T * D || ws_size < WS_END) { fprintf(stderr, "kernel_launch: unexpected problem: n_in %d out %d ws %zu (need %zu)\n", n_in, out_size, ws_size, (size_t)WS_END); grid = -1; return; }
        int dev = 0, cus = 0, per_cu = 0;
        if (hipGetDevice(&dev) != hipSuccess || hipDeviceGetAttribute(&cus, hipDeviceAttributeMultiprocessorCount, dev) != hipSuccess) { grid = -1; return; }
        if (hipFuncSetAttribute((const void*)trunk_fwd, hipFuncAttributeMaxDynamicSharedMemorySize, LDS_BYTES) != hipSuccess) { fprintf(stderr, "kernel_launch: hipFuncSetAttribute failed\n"); grid = -1; return; }
        if (hipOccupancyMaxActiveBlocksPerMultiprocessor(&per_cu, (const void*)trunk_fwd, 512, LDS_BYTES) != hipSuccess || per_cu < 1) { fprintf(stderr, "kernel_launch: occupancy query says %d\n", per_cu); }
        (void)hipGetLastError();
        grid = cus;
    }
    if (grid < 0) return;
    (void)hipMemsetAsync((char*)d_ws + WS_CTL, 0, CTL_ZERO_BYTES, stream);
    Args a{};
    for (int i = 0; i < 31; ++i) a.in[i] = (const float*)d_in[i];
    a.out = (float*)d_out; a.ws = (unsigned char*)d_ws;
#if MK_ONE_LAUNCH
    a.ph_lo = 0; a.ph_hi = NPH;
    hipLaunchKernelGGL(trunk_fwd, dim3(grid), dim3(512), LDS_BYTES, stream, a);
#else
    for (int ph = 0; ph < NPH; ++ph) {
        if (ph >= 1 && ph < PH_FINAL && ((ph - 1) % NPL) == 12 && (((ph - 1) / NPL) & 1) == 0) continue;
        a.ph_lo = ph; a.ph_hi = ph + 1;
        hipLaunchKernelGGL(trunk_fwd, dim3(grid), dim3(512), LDS_BYTES, stream, a);
    }
#endif
}
```

```cpp
#include <hip/hip_runtime.h>
#include <cstdio>
#include <cstdint>

#ifndef MK_ONE_LAUNCH
#define MK_ONE_LAUNCH 1
#endif

namespace pg8 {
#define PG8_LAS __attribute__((address_space(3)))
typedef unsigned short bf16_t;
typedef short bf16x8 __attribute__((ext_vector_type(8)));
typedef float f32x4 __attribute__((ext_vector_type(4)));
typedef unsigned u32x4 __attribute__((ext_vector_type(4)));
typedef unsigned u32x2 __attribute__((ext_vector_type(2)));
constexpr int BM = 256, BK = 64, HALF = 128, HTB = HALF * BK * 2, STAGE_BYTES = 8 * HTB, NXCD = 8, WGM = 4;

__host__ __device__ __forceinline__ int lds_byte(int r, int c) { const int st = (r >> 4) * 2 + (c >> 5), rr = r & 15, cc = c & 31, ob = rr * 64 + cc * 2; return st * 1024 + (ob ^ (((ob >> 9) & 1) << 5)); }
__host__ __device__ __forceinline__ void stage_rc(int b, int& R, int& C) { const int st = b / 1024, sb = b % 1024, swz = sb ^ (((sb >> 9) & 1) << 5); R = (st >> 1) * 16 + swz / 64; C = (st & 1) * 32 + (swz % 64) / 2; }
__host__ __device__ __forceinline__ int perm32(int rho) { const int n = rho >> 4, i = rho & 15; return 8 * (i >> 2) + 4 * n + (i & 3); }

struct Unit { int pm, pn, po; };
struct Gemm { const bf16_t* A; const bf16_t* Bt; int M, N, K; int lda = 0, ldb = 0; };

struct StaticOrder {
    int nM, nN, nwg, G, c;
    __device__ void init(int M, int N, int G_, int c_) { nM = M / BM; nN = N / BM; nwg = nM * nN; G = G_; c = c_; }
    __device__ bool next(int i, Unit& u) const {
        const long L = (long)i * G + c; if (L >= nwg) return false;
        int wgid = (int)L; { const int q = nwg / NXCD, r = nwg % NXCD, xcd = wgid % NXCD, off = wgid / NXCD; wgid = (xcd < r ? xcd * (q + 1) : r * (q + 1) + (xcd - r) * q) + off; }
        const int nig = WGM * nN, gid = wgid / nig, fm = gid * WGM, gsz = (nM - fm) < WGM ? (nM - fm) : WGM;
        u.pm = fm + ((wgid % nig) % gsz); u.pn = (wgid % nig) / gsz; u.po = u.pn; return true;
    }
    __device__ __forceinline__ void a_ready(const Unit&) const {}
    __device__ __forceinline__ void done(const Unit&) const {}
};
struct MoeOrder {
    const PG8_LAS int* tab; int NT, G, c;
    __device__ bool next(int i, Unit& u) const {
        const int L = i * G + c; if (L >= tab[17]) return false;
        int e = 0;
#pragma unroll
        for (int j = 1; j < 8; ++j) e += (L >= tab[9 + j]) ? 1 : 0;
        const int l = L - tab[9 + e], tiles = tab[e + 1] - tab[e];
        const int mt = l % tiles, pl = l / tiles;
        u.pm = tab[e] + mt; u.pn = e * NT + pl; u.po = pl; return true;
    }
    __device__ __forceinline__ void a_ready(const Unit&) const {}
    __device__ __forceinline__ void done(const Unit&) const {}
};

typedef float f32x2cv __attribute__((ext_vector_type(2))); typedef __bf16 bf16x2cv __attribute__((ext_vector_type(2)));
__device__ __forceinline__ unsigned cvt_pk_bf16(float lo, float hi) { const f32x2cv v = {lo, hi}; const bf16x2cv b = __builtin_convertvector(v, bf16x2cv); return __builtin_bit_cast(unsigned, b); }
typedef int i32x8 __attribute__((ext_vector_type(8)));
__device__ __forceinline__ i32x8 cat8(bf16x8 a, bf16x8 b) { const u32x4 x = __builtin_bit_cast(u32x4, a), y = __builtin_bit_cast(u32x4, b); return (i32x8){(int)x.x, (int)x.y, (int)x.z, (int)x.w, (int)y.x, (int)y.y, (int)y.z, (int)y.w}; }
__device__ __forceinline__ unsigned pk_fp8x4(float a, float b, float c, float d) {
    a = __builtin_amdgcn_fmed3f(a, -448.0f, 448.0f); b = __builtin_amdgcn_fmed3f(b, -448.0f, 448.0f); c = __builtin_amdgcn_fmed3f(c, -448.0f, 448.0f); d = __builtin_amdgcn_fmed3f(d, -448.0f, 448.0f);
    int r = __builtin_amdgcn_cvt_pk_fp8_f32(a, b, 0, false); r = __builtin_amdgcn_cvt_pk_fp8_f32(c, d, r, true); return (unsigned)r; }
__device__ __forceinline__ float bflo(unsigned w) { return __uint_as_float(w << 16); }
__device__ __forceinline__ float bfhi(unsigned w) { return __uint_as_float(w & 0xffff0000u); }
__device__ __forceinline__ float sigm(float x) { return __builtin_amdgcn_rcpf(1.0f + __expf(-x)); }

struct EpiStoreBf16 {
    static constexpr bool PERM = true, AFTER_DRAIN = false;
    bf16_t* O; int ldc; float scale = 1.0f;
    __device__ __forceinline__ void operator()(const f32x4 (&acc)[2][2][4][2], const Unit& u, int wr, int wc, int fr, int fq) const {
        const int row0 = u.pm * BM + wr * 64 + fr, col0 = u.po * BM + wc * 32 + 8 * fq;
#pragma unroll
        for (int ai = 0; ai < 2; ++ai)
#pragma unroll
            for (int m = 0; m < 4; ++m) { bf16_t* rowp = O + (size_t)(row0 + ai * HALF + m * 16) * ldc + col0;
#pragma unroll
                for (int bj = 0; bj < 2; ++bj) { const f32x4 v0 = acc[ai][bj][m][0] * scale, v1 = acc[ai][bj][m][1] * scale;
                    u32x4 w; w.x = cvt_pk_bf16(v0[0], v0[1]); w.y = cvt_pk_bf16(v0[2], v0[3]); w.z = cvt_pk_bf16(v1[0], v1[1]); w.w = cvt_pk_bf16(v1[2], v1[3]);
                    *(u32x4*)(rowp + bj * HALF) = w; } }
    }
};
struct EpiProj {
    static constexpr bool PERM = true, AFTER_DRAIN = false;
    bf16_t* base; int T_, SEQ_; float scale = 1.0f; float kvscale = 8.0f;
    __device__ __forceinline__ void seg(int col, int b, size_t& off, int& pitch, bool& f8) const {
        const size_t T = (size_t)T_; f8 = false;
        if (col < 1024) { off = (size_t)col * 2; pitch = 2048; }
        else if (col < 1536) { const int v = col >= 1280, cc = (col - (v ? 1280 : 1024)) >> 7, d = (col - (v ? 1280 : 1024)) & 127; off = T * (v ? 1280 : 1024) * 2 + (size_t)(b + cc) * SEQ_ * 128 + d; pitch = 128; f8 = true; }
        else if (col < 2048) { off = (T * 1536 + (col - 1536)) * 2; pitch = 1024; }
        else if (col < 2112) { off = (T * 2048 + (col - 2048)) * 2; pitch = 128; }
        else if (col < 2120) { off = (T * 2112 + (col - 2112)) * 2; pitch = 16; }
        else if (col < 5480) { off = (T * 2120 + (col - 2120)) * 2; pitch = 6720; }
        else if (col < 7528) { off = (T * 5480 + (col - 5480)) * 2; pitch = 4096; }
        else if (col < 9576) { off = (T * 7528 + (col - 7528)) * 2; pitch = 4096; }
        else { off = 0; pitch = 0; }
    }
    __device__ __forceinline__ void operator()(const f32x4 (&acc)[2][2][4][2], const Unit& u, int wr, int wc, int fr, int fq) const {
        const int row0 = u.pm * BM + wr * 64 + fr, col0 = u.po * BM + wc * 32 + 8 * fq, b = (u.pm * BM) / SEQ_;
        unsigned char* bb = (unsigned char*)base;
#pragma unroll
        for (int bj = 0; bj < 2; ++bj) { size_t off; int pitch; bool f8; seg(col0 + bj * HALF, b, off, pitch, f8);
            if (pitch) {
#pragma unroll
                for (int ai = 0; ai < 2; ++ai)
#pragma unroll
                    for (int m = 0; m < 4; ++m) { const f32x4 v0 = acc[ai][bj][m][0] * scale, v1 = acc[ai][bj][m][1] * scale; unsigned char* dst = bb + off + (size_t)(row0 + ai * HALF + m * 16) * pitch;
                        if (f8) { u32x2 w; w.x = pk_fp8x4(v0[0] * kvscale, v0[1] * kvscale, v0[2] * kvscale, v0[3] * kvscale); w.y = pk_fp8x4(v1[0] * kvscale, v1[1] * kvscale, v1[2] * kvscale, v1[3] * kvscale); *(u32x2*)dst = w; }
                        else { u32x4 w; w.x = cvt_pk_bf16(v0[0], v0[1]); w.y = cvt_pk_bf16(v0[2], v0[3]); w.z = cvt_pk_bf16(v1[0], v1[1]); w.w = cvt_pk_bf16(v1[2], v1[3]); *(u32x4*)dst = w; } } } }
    }
};
template <bool ADD> struct EpiGate {
    static constexpr bool PERM = true, AFTER_DRAIN = false;
    bf16_t* O; int ldc; const bf16_t* gate; int ldg; unsigned char* O8 = nullptr; float s8 = 1.0f; float ascale = 1.0f;
    __device__ __forceinline__ void operator()(const f32x4 (&acc)[2][2][4][2], const Unit& u, int wr, int wc, int fr, int fq) const {
        const int row0 = u.pm * BM + wr * 64 + fr, col0 = u.po * BM + wc * 32 + 8 * fq;
#pragma unroll
        for (int ai = 0; ai < 2; ++ai) {
            u32x4 g[4][2], o[4][2];
#pragma unroll
            for (int m = 0; m < 4; ++m) { const size_t row = (size_t)(row0 + ai * HALF + m * 16);
#pragma unroll
                for (int bj = 0; bj < 2; ++bj) { g[m][bj] = *(const u32x4*)(gate + row * ldg + col0 + bj * HALF); if (ADD) o[m][bj] = *(const u32x4*)(O + row * ldc + col0 + bj * HALF); } }
            __builtin_amdgcn_sched_barrier(0);
#pragma unroll
            for (int m = 0; m < 4; ++m) { const size_t row = (size_t)(row0 + ai * HALF + m * 16); bf16_t* rowp = O + row * ldc + col0;
#pragma unroll
                for (int bj = 0; bj < 2; ++bj) { const f32x4 v0 = acc[ai][bj][m][0] * ascale, v1 = acc[ai][bj][m][1] * ascale;
                    const u32x4 gg = g[m][bj];
                    float r[8];
                    r[0] = sigm(bflo(gg.x)) * v0[0]; r[1] = sigm(bfhi(gg.x)) * v0[1]; r[2] = sigm(bflo(gg.y)) * v0[2]; r[3] = sigm(bfhi(gg.y)) * v0[3];
                    r[4] = sigm(bflo(gg.z)) * v1[0]; r[5] = sigm(bfhi(gg.z)) * v1[1]; r[6] = sigm(bflo(gg.w)) * v1[2]; r[7] = sigm(bfhi(gg.w)) * v1[3];
                    if (ADD) { const u32x4 oo = o[m][bj];
                        r[0] += bflo(oo.x); r[1] += bfhi(oo.x); r[2] += bflo(oo.y); r[3] += bfhi(oo.y); r[4] += bflo(oo.z); r[5] += bfhi(oo.z); r[6] += bflo(oo.w); r[7] += bfhi(oo.w); }
                    if (ADD && O8) { u32x2 w8; w8.x = pk_fp8x4(r[0] * s8, r[1] * s8, r[2] * s8, r[3] * s8); w8.y = pk_fp8x4(r[4] * s8, r[5] * s8, r[6] * s8, r[7] * s8); *(u32x2*)(O8 + row * ldc + col0 + bj * HALF) = w8; }
                    else { u32x4 w; w.x = cvt_pk_bf16(r[0], r[1]); w.y = cvt_pk_bf16(r[2], r[3]); w.z = cvt_pk_bf16(r[4], r[5]); w.w = cvt_pk_bf16(r[6], r[7]);
                    *(u32x4*)(rowp + bj * HALF) = w; } } }
            __builtin_amdgcn_sched_barrier(0);
        }
    }
};
struct EpiResid {
    static constexpr bool PERM = false, AFTER_DRAIN = false;
    const float* in; float* out; int ldc; float scale = 1.0f;
    __device__ __forceinline__ void operator()(const f32x4 (&acc)[2][2][4][2], const Unit& u, int wr, int wc, int fr, int fq) const {
        const int row0 = u.pm * BM + wr * 64 + fr, col0 = u.po * BM + wc * 32 + 4 * fq;
#pragma unroll
        for (int ai = 0; ai < 2; ++ai) {
            f32x4 b[4][2][2];
#pragma unroll
            for (int m = 0; m < 4; ++m) { const size_t off = (size_t)(row0 + ai * HALF + m * 16) * ldc + col0;
#pragma unroll
                for (int bj = 0; bj < 2; ++bj)
#pragma unroll
                    for (int n = 0; n < 2; ++n) b[m][bj][n] = *(const f32x4*)(in + off + bj * HALF + n * 16); }
            __builtin_amdgcn_sched_barrier(0);
#pragma unroll
            for (int m = 0; m < 4; ++m) { const size_t off = (size_t)(row0 + ai * HALF + m * 16) * ldc + col0;
#pragma unroll
                for (int bj = 0; bj < 2; ++bj)
#pragma unroll
                    for (int n = 0; n < 2; ++n) *(f32x4*)(out + off + bj * HALF + n * 16) = b[m][bj][n] + acc[ai][bj][m][n] * scale; }
            __builtin_amdgcn_sched_barrier(0);
        }
    }
};
struct EpiSwiglu {
    static constexpr bool PERM = true, AFTER_DRAIN = false;
    bf16_t* U; int ldc;
    __device__ __forceinline__ void operator()(const f32x4 (&acc)[2][2][4][2], const Unit& u, int wr, int wc, int fr, int fq) const {
        const int row0 = u.pm * BM + wr * 64 + fr, col0 = u.po * HALF + wc * 32 + 8 * fq;
#pragma unroll
        for (int ai = 0; ai < 2; ++ai)
#pragma unroll
            for (int m = 0; m < 4; ++m) { bf16_t* rowp = U + (size_t)(row0 + ai * HALF + m * 16) * ldc + col0;
                float r[8];
#pragma unroll
                for (int n = 0; n < 2; ++n)
#pragma unroll
                    for (int j = 0; j < 4; ++j) { const float g = acc[ai][0][m][n][j], x = acc[ai][1][m][n][j]; r[4 * n + j] = g * sigm(g) * x; }
                u32x4 w; w.x = cvt_pk_bf16(r[0], r[1]); w.y = cvt_pk_bf16(r[2], r[3]); w.z = cvt_pk_bf16(r[4], r[5]); w.w = cvt_pk_bf16(r[6], r[7]);
                *(u32x4*)rowp = w; }
    }
};
struct EpiSwigluF8 {
    static constexpr bool PERM = true, AFTER_DRAIN = false;
    unsigned char* U; int ldc; float iscale, oscale;
    __device__ __forceinline__ void operator()(const f32x4 (&acc)[2][2][4][2], const Unit& u, int wr, int wc, int fr, int fq) const {
        const int row0 = u.pm * BM + wr * 64 + fr, col0 = u.po * HALF + wc * 32 + 8 * fq;
#pragma unroll
        for (int ai = 0; ai < 2; ++ai)
#pragma unroll
            for (int m = 0; m < 4; ++m) { unsigned char* rowp = U + (size_t)(row0 + ai * HALF + m * 16) * ldc + col0;
                float r[8];
#pragma unroll
                for (int n = 0; n < 2; ++n)
#pragma unroll
                    for (int j = 0; j < 4; ++j) { const float g = acc[ai][0][m][n][j] * iscale, x = acc[ai][1][m][n][j] * iscale; r[4 * n + j] = g * sigm(g) * x * oscale; }
                u32x2 w; w.x = pk_fp8x4(r[0], r[1], r[2], r[3]); w.y = pk_fp8x4(r[4], r[5], r[6], r[7]);
                *(u32x2*)rowp = w; }
    }
};
struct EpiPle {
    static constexpr bool PERM = false, AFTER_DRAIN = false;
    float* h; const bf16_t* pp; int ldc; float scale = 1.0f;
    __device__ __forceinline__ void operator()(const f32x4 (&acc)[2][2][4][2], const Unit& u, int wr, int wc, int fr, int fq) const {
        const int row0 = u.pm * BM + wr * 64 + fr, col0 = u.po * BM + wc * 32 + 4 * fq;
#pragma unroll
        for (int ai = 0; ai < 2; ++ai)
#pragma unroll
            for (int mh = 0; mh < 2; ++mh) {
                f32x4 b[2][2][2]; u32x2 p[2][2][2];
#pragma unroll
                for (int m = 0; m < 2; ++m) { const size_t off = (size_t)(row0 + ai * HALF + (2 * mh + m) * 16) * ldc + col0;
#pragma unroll
                    for (int bj = 0; bj < 2; ++bj)
#pragma unroll
                        for (int n = 0; n < 2; ++n) { const size_t o = off + bj * HALF + n * 16; b[m][bj][n] = *(const f32x4*)(h + o); p[m][bj][n] = *(const u32x2*)(pp + o); } }
                __builtin_amdgcn_sched_barrier(0);
#pragma unroll
                for (int m = 0; m < 2; ++m) { const size_t off = (size_t)(row0 + ai * HALF + (2 * mh + m) * 16) * ldc + col0;
#pragma unroll
                    for (int bj = 0; bj < 2; ++bj)
#pragma unroll
                        for (int n = 0; n < 2; ++n) { const size_t o = off + bj * HALF + n * 16; const f32x4 bb = b[m][bj][n]; const u32x2 pq = p[m][bj][n]; const f32x4 a = acc[ai][bj][2 * mh + m][n] * scale;
                            f32x4 r; r[0] = bb[0] + sigm(a[0]) * bflo(pq.x); r[1] = bb[1] + sigm(a[1]) * bfhi(pq.x); r[2] = bb[2] + sigm(a[2]) * bflo(pq.y); r[3] = bb[3] + sigm(a[3]) * bfhi(pq.y);
                            *(f32x4*)(h + o) = r; } }
                __builtin_amdgcn_sched_barrier(0);
            }
    }
};

template <class Epi, class Sched, bool ALIGN_EPI = false, bool SP2 = false, bool F8 = false>
__device__ __forceinline__ void gemm_phase(PG8_LAS unsigned char* lds, const Gemm g, const Sched& S, const Epi& E) {
    int tid_ = threadIdx.x; asm volatile("" : "+v"(tid_));
    const int tid = tid_, wid = __builtin_amdgcn_readfirstlane(tid >> 6), lane = tid & 63, wr = wid >> 2, wc = wid & 3, fr = lane & 15, fq = lane >> 4;
    const int K = g.K, nt = K / BK, lda = g.lda ? g.lda : K, ldb = g.ldb ? g.ldb : K;
    unsigned voffA[2], voffB[2];
#pragma unroll
    for (int i = 0; i < 2; ++i) { int R, C; stage_rc(tid * 16 + i * 8192, R, C); const int Rb = Epi::PERM ? ((R & ~31) + perm32(R & 31)) : R;
        voffA[i] = (unsigned)(R * lda + C) * 2u; voffB[i] = (unsigned)(Rb * ldb + C) * 2u; }
    const size_t kstep = (size_t)(BK * 2);
    const size_t hstepA = (size_t)HALF * lda * 2, hstepB = (size_t)HALF * ldb * 2;
    const size_t tstepA = 2 * hstepA, tstepB = 2 * hstepB;
    const unsigned ldsw = (unsigned)wid * 1024u;
    const int aoff = lds_byte(wr * 64 + fr, fq * 8), boff = lds_byte(wc * 32 + fr, fq * 8);
#define PG8_SA(b, h) (((b) * 2 + (h)) * HTB)
#define PG8_SB(b, h) ((4 + (b) * 2 + (h)) * HTB)
#define PG8_STAGE(bufoff, gbase, voff) do { _Pragma("unroll") for (int _i = 0; _i < 2; ++_i) \
        __builtin_amdgcn_global_load_lds((const unsigned*)((const char*)(gbase) + (voff)[_i]), (PG8_LAS unsigned*)(lds + (bufoff) + ldsw + _i * 8192), 16, 0, 0); } while (0)
#define PG8_LDA(dst, b, h) do { _Pragma("unroll") for (int m = 0; m < 4; ++m) { if constexpr (F8) { const u32x4 x_ = *(const PG8_LAS u32x4*)(lds + PG8_SA(b, h) + aoff + m * 2048), y_ = *(const PG8_LAS u32x4*)(lds + PG8_SA(b, h) + aoff + m * 2048 + 1024); \
        dst##8[m] = (i32x8){(int)x_.x, (int)x_.y, (int)x_.z, (int)x_.w, (int)y_.x, (int)y_.y, (int)y_.z, (int)y_.w}; } \
        else { _Pragma("unroll") for (int k = 0; k < 2; ++k) dst[m][k] = *(const PG8_LAS bf16x8*)(lds + PG8_SA(b, h) + aoff + m * 2048 + k * 1024); } } } while (0)
#define PG8_LDB(dst, b, h) do { _Pragma("unroll") for (int n = 0; n < 2; ++n) { if constexpr (F8) { const u32x4 x_ = *(const PG8_LAS u32x4*)(lds + PG8_SB(b, h) + boff + n * 2048), y_ = *(const PG8_LAS u32x4*)(lds + PG8_SB(b, h) + boff + n * 2048 + 1024); \
        dst##8[n] = (i32x8){(int)x_.x, (int)x_.y, (int)x_.z, (int)x_.w, (int)y_.x, (int)y_.y, (int)y_.z, (int)y_.w}; } \
        else { _Pragma("unroll") for (int k = 0; k < 2; ++k) dst[n][k] = *(const PG8_LAS bf16x8*)(lds + PG8_SB(b, h) + boff + n * 2048 + k * 1024); } } } while (0)
#define PG8_MMA(ai, bj, At, Bt) do { __builtin_amdgcn_s_setprio(1); _Pragma("unroll") for (int m = 0; m < 4; ++m) _Pragma("unroll") for (int n = 0; n < 2; ++n) { \
        if constexpr (F8) { asm volatile("v_mfma_scale_f32_16x16x128_f8f6f4 %0, %1, %2, %0, %3, %3 op_sel_hi:[0,0,0]" : "+v"(acc[ai][bj][m][n]) : "v"(Bt##8[n]), "v"(At##8[m]), "v"(f8sc)); } \
        else { _Pragma("unroll") for (int k = 0; k < 2; ++k) acc[ai][bj][m][n] = __builtin_amdgcn_mfma_f32_16x16x32_bf16(Bt[n][k], At[m][k], acc[ai][bj][m][n], 0, 0, 0); } } \
        __builtin_amdgcn_s_setprio(0); } while (0)
#define PG8_WAIT_V(n) asm volatile("s_waitcnt vmcnt(" #n ")" ::: "memory")
#define PG8_WAIT_L(n) asm volatile("s_waitcnt lgkmcnt(" #n ")" ::: "memory")
#define PG8_BAR __builtin_amdgcn_s_barrier()
#define PG8_SCHED __builtin_amdgcn_sched_barrier(0)
    Unit cur, nxt; int ui = 0;
    if (!S.next(0, cur)) return;
    f32x4 acc[2][2][4][2];
#pragma unroll
    for (int a = 0; a < 2; ++a)
#pragma unroll
        for (int b = 0; b < 2; ++b)
#pragma unroll
            for (int m = 0; m < 4; ++m)
#pragma unroll
                for (int n = 0; n < 2; ++n) acc[a][b][m][n] = (f32x4){0.f, 0.f, 0.f, 0.f};
    const int f8sc = 0x7f7f7f7f; (void)f8sc;
    bf16x8 At[4][2], B0[2][2], B1[2][2]; i32x8 At8[4], B08[2], B18[2]; (void)At; (void)B0; (void)B1; (void)At8; (void)B08; (void)B18;
    const char* cA = (const char*)g.A + (size_t)cur.pm * tstepA; const char* cB = (const char*)g.Bt + (size_t)cur.pn * tstepB;
    S.a_ready(cur);
    if constexpr (SP2) {
        PG8_STAGE(PG8_SB(0, 0), cB, voffB); PG8_STAGE(PG8_SB(0, 1), cB + hstepB, voffB); PG8_STAGE(PG8_SA(0, 0), cA, voffA); PG8_STAGE(PG8_SA(0, 1), cA + hstepA, voffA);
        if (wr == 1) PG8_BAR;
        PG8_WAIT_V(2); PG8_BAR;
        PG8_STAGE(PG8_SB(1, 0), cB + kstep, voffB); PG8_STAGE(PG8_SA(1, 0), cA + kstep, voffA); PG8_STAGE(PG8_SB(1, 1), cB + hstepB + kstep, voffB);
        PG8_WAIT_V(6); PG8_BAR;
    } else {
        PG8_STAGE(PG8_SB(0, 0), cB, voffB); PG8_STAGE(PG8_SA(0, 0), cA, voffA); PG8_STAGE(PG8_SB(0, 1), cB + hstepB, voffB); PG8_STAGE(PG8_SA(0, 1), cA + hstepA, voffA);
        if (wr == 1) PG8_BAR;
        PG8_WAIT_V(4); PG8_BAR;
        PG8_STAGE(PG8_SB(1, 0), cB + kstep, voffB); PG8_STAGE(PG8_SA(1, 0), cA + kstep, voffA); PG8_STAGE(PG8_SB(1, 1), cB + hstepB + kstep, voffB);
        PG8_WAIT_V(6); PG8_BAR;
    }
    for (;;) {
        const bool has_next = S.next(ui + 1, nxt);
        const char* nA = has_next ? (const char*)g.A + (size_t)nxt.pm * tstepA : cA; const char* nB = has_next ? (const char*)g.Bt + (size_t)nxt.pn * tstepB : cB;
        for (int t = 0; t < nt; t += 2) {
            const bool last = (t == nt - 2);
            const char* a1 = cA + (size_t)(t + 1) * kstep;
            const char* a2 = last ? nA : cA + (size_t)(t + 2) * kstep; const char* b2 = last ? nB : cB + (size_t)(t + 2) * kstep;
            const char* a3 = a2 + kstep; const char* b3 = b2 + kstep;
            if (last && has_next) S.a_ready(nxt);
            if constexpr (SP2) {
            PG8_LDB(B0, 0, 0); PG8_LDB(B1, 0, 1); PG8_SCHED; PG8_LDA(At, 0, 0); PG8_STAGE(PG8_SA(1, 1), a1 + hstepA, voffA);
            PG8_WAIT_V(8); PG8_WAIT_L(0); PG8_BAR; PG8_MMA(0, 0, At, B0); PG8_MMA(0, 1, At, B1); PG8_BAR; PG8_SCHED;
            PG8_LDA(At, 0, 1); PG8_STAGE(PG8_SB(0, 0), b2, voffB); PG8_STAGE(PG8_SB(0, 1), b2 + hstepB, voffB); PG8_STAGE(PG8_SA(0, 0), a2, voffA);
            PG8_WAIT_V(8); PG8_WAIT_L(0); PG8_BAR; PG8_MMA(1, 0, At, B0); PG8_MMA(1, 1, At, B1); PG8_BAR; PG8_SCHED;
            PG8_LDB(B0, 1, 0); PG8_LDB(B1, 1, 1); PG8_SCHED; PG8_LDA(At, 1, 0); PG8_STAGE(PG8_SA(0, 1), a2 + hstepA, voffA);
            PG8_WAIT_V(8); PG8_WAIT_L(0); PG8_BAR; PG8_MMA(0, 0, At, B0); PG8_MMA(0, 1, At, B1); PG8_BAR; PG8_SCHED;
            PG8_LDA(At, 1, 1); PG8_STAGE(PG8_SB(1, 0), b3, voffB); PG8_STAGE(PG8_SB(1, 1), b3 + hstepB, voffB); PG8_STAGE(PG8_SA(1, 0), a3, voffA);
            PG8_WAIT_V(8); PG8_WAIT_L(0); PG8_BAR; PG8_MMA(1, 0, At, B0); PG8_MMA(1, 1, At, B1); PG8_BAR; PG8_SCHED;
            } else {
            PG8_LDB(B0, 0, 0); PG8_SCHED; PG8_LDA(At, 0, 0); PG8_STAGE(PG8_SA(1, 1), a1 + hstepA, voffA);
            PG8_WAIT_L(8); PG8_BAR; PG8_WAIT_L(0); PG8_MMA(0, 0, At, B0); PG8_BAR; PG8_SCHED;
            PG8_LDB(B1, 0, 1); PG8_STAGE(PG8_SB(0, 0), b2, voffB);
            PG8_BAR; PG8_WAIT_L(0); PG8_MMA(0, 1, At, B1); PG8_BAR;
            PG8_LDA(At, 0, 1); PG8_STAGE(PG8_SA(0, 0), a2, voffA);
            PG8_BAR; PG8_WAIT_L(0); PG8_MMA(1, 0, At, B0); PG8_BAR; PG8_SCHED;
            PG8_STAGE(PG8_SB(0, 1), b2 + hstepB, voffB);
            PG8_WAIT_V(6); PG8_BAR; PG8_MMA(1, 1, At, B1); PG8_BAR;
            PG8_LDB(B0, 1, 0); PG8_SCHED; PG8_LDA(At, 1, 0); PG8_STAGE(PG8_SA(0, 1), a2 + hstepA, voffA);
            PG8_WAIT_L(8); PG8_BAR; PG8_WAIT_L(0); PG8_MMA(0, 0, At, B0); PG8_BAR; PG8_SCHED;
            PG8_LDB(B1, 1, 1); PG8_STAGE(PG8_SB(1, 0), b3, voffB);
            PG8_BAR; PG8_WAIT_L(0); PG8_MMA(0, 1, At, B1); PG8_BAR;
            PG8_LDA(At, 1, 1); PG8_STAGE(PG8_SA(1, 0), a3, voffA);
            PG8_BAR; PG8_WAIT_L(0); PG8_MMA(1, 0, At, B0); PG8_BAR; PG8_SCHED;
            PG8_STAGE(PG8_SB(1, 1), b3 + hstepB, voffB);
            PG8_WAIT_V(6); PG8_BAR; PG8_MMA(1, 1, At, B1); PG8_BAR;
            }
        }
        if constexpr (ALIGN_EPI) { if (wr == 0) PG8_BAR; }
        if constexpr (F8) asm volatile("s_nop 15\n\ts_nop 15" ::: "memory");
        E(acc, cur, wr, wc, fr, fq); S.done(cur);
        if (!has_next) break;
#pragma unroll
        for (int a = 0; a < 2; ++a)
#pragma unroll
            for (int b = 0; b < 2; ++b)
#pragma unroll
                for (int m = 0; m < 4; ++m)
#pragma unroll
                    for (int n = 0; n < 2; ++n) acc[a][b][m][n] = (f32x4){0.f, 0.f, 0.f, 0.f};
        cur = nxt; cA = nA; cB = nB; ++ui;
        if constexpr (ALIGN_EPI) { if (wr == 1) PG8_BAR; }
    }
    PG8_WAIT_V(0);
    if constexpr (!ALIGN_EPI) { if (wr == 0) PG8_BAR; }
    PG8_BAR;
#undef PG8_SA
#undef PG8_SB
#undef PG8_STAGE
#undef PG8_LDA
#undef PG8_LDB
#undef PG8_MMA
#undef PG8_WAIT_V
#undef PG8_WAIT_L
#undef PG8_BAR
#undef PG8_SCHED
}
}

constexpr int NB = 2, SEQ = 8192, T = NB * SEQ, D = 2048, DEPTH = 2;
constexpr int PW = 9728, IN_W = 9576;
constexpr int C_Q = 0, C_K = 1024, C_V = 1280, C_QI = 1536, C_KI = 2048, C_WI = 2112, C_SLAB = 2120, C_GA = 5480, C_GB = 7528;
constexpr size_t O_Q = 0, O_K = (size_t)T * 1024, O_V = O_K + (size_t)T * 256, O_QI = O_V + (size_t)T * 256, O_KI = O_QI + (size_t)T * 512, O_WI = O_KI + (size_t)T * 64, O_SL = O_WI + (size_t)T * 8,
                 O_GA = O_SL + (size_t)T * 3360, O_GB = O_GA + (size_t)T * 2048;
constexpr int S_R = 0, S_K = 1024, S_V = 2048, S_XW = 3072, SLAB_W = 3360;
constexpr int DFF = 5632, DFE = 7168, NE = 8;
constexpr int LRK = 384, LRN = 3072;
constexpr int MOE_ROWS = 34816;
constexpr int KPAD = 64;
constexpr int XGP = D + 2 * KPAD;
constexpr int NSEL = 256;
constexpr float MOE_AS = 8.0f, MOE_WS13 = 512.0f, MOE_WS2 = 1024.0f;
constexpr float PLE_AS = 8.0f, PLE_WS = 512.0f;
constexpr float RMS_EPS = 1e-6f, GN_EPS = 64e-5f;
constexpr int SREC = 896;

constexpr size_t MiB = 1u << 20;
constexpr size_t WS_CTL = 0, CTL_ZERO_BYTES = 65536;
constexpr size_t WS_ROUTE = 1 * MiB;
constexpr size_t WS_WIN = 4 * MiB, WS_UATT = 80 * MiB, WS_URW = 88 * MiB, WS_WOUT = 96 * MiB, WS_PLEG = 112 * MiB, WS_PLEP = 128 * MiB, WS_LRT = 130 * MiB;
constexpr size_t WS_F13 = 135 * MiB, WS_F2 = 179 * MiB, WS_M13 = 201 * MiB, WS_M2 = 649 * MiB, WS_PB = 873 * MiB, WS_XN = 889 * MiB, WS_ARENA = 953 * MiB;
constexpr size_t WS_PROJ = WS_ARENA, WS_SCANIN = WS_ARENA + 304 * MiB, WS_LR = WS_ARENA + 528 * MiB, WS_YS = WS_ARENA + 624 * MiB, WS_ATT = WS_ARENA + 688 * MiB, WS_IDX = WS_ARENA + 720 * MiB,
                 WS_CHK = WS_ARENA + 728 * MiB, WS_RW = WS_ARENA + 728 * MiB, WS_M1 = WS_ARENA + 760 * MiB;
constexpr size_t WS_UD = WS_ARENA, WS_XG = WS_ARENA, WS_UM = WS_ARENA + 136 * MiB, WS_YM = WS_ARENA + 612 * MiB, WS_PP = WS_M13 + 256 * MiB, WS_LRA = WS_XN;
constexpr size_t WS_END = WS_ARENA + 920 * MiB;
constexpr size_t LRT_BYTES = (size_t)LRN * LRK * 2;
constexpr int CW_TMO = 0, CW_MOECNT = 64, CW_ATTQ = 8192, CW_BAR = 4096;
constexpr int RING_BYTES = 131072, MISC_OFF = RING_BYTES, BIAS_OFF = MISC_OFF + 256, JOB_OFF = MISC_OFF + 256, LDS_BYTES = 147456;

#define GAS __attribute__((address_space(1)))
#define LAS __attribute__((address_space(3)))
typedef unsigned short bf16;
typedef unsigned v4u __attribute__((ext_vector_type(4)));
typedef unsigned v2u __attribute__((ext_vector_type(2)));
typedef float f32x4 __attribute__((ext_vector_type(4)));
typedef float f32x16 __attribute__((ext_vector_type(16)));
typedef short bf16x8 __attribute__((ext_vector_type(8)));
#define LDS_WAIT() asm volatile("s_waitcnt lgkmcnt(0)" ::: "memory")
#define VM_WAIT() asm volatile("s_waitcnt vmcnt(0)" ::: "memory")
using pg8::cvt_pk_bf16; using pg8::bflo; using pg8::bfhi; using pg8::sigm;
__device__ __forceinline__ float bf2f(unsigned short b) { return __uint_as_float(((unsigned)b) << 16); }
__device__ __forceinline__ unsigned short f2bf(float f) { return (unsigned short)(cvt_pk_bf16(f, 0.f) & 0xffffu); }

#define XB_TMO      128
#define XB_XCNT(j)  (256  + 64 * (j))
#define XB_XSUB(j)  (1280 + 64 * (j))
#define XB_XGEN(j)  (2304 + 64 * (j))
#define XB_TOP      3328
#define XB_TOPGEN   3392
#define XCD_BAR_WORDS 3456
#define XB_SPIN_CAP (1u << 18)
__device__ __forceinline__ unsigned xb_ld(unsigned* p)              { return __hip_atomic_load(p, __ATOMIC_RELAXED, __HIP_MEMORY_SCOPE_AGENT); }
__device__ __forceinline__ unsigned xb_add(unsigned* p, unsigned v) { return __hip_atomic_fetch_add(p, v, __ATOMIC_RELAXED, __HIP_MEMORY_SCOPE_AGENT); }
__device__ __forceinline__ unsigned xb_xcc_id() { return (unsigned)__builtin_amdgcn_s_getreg((3 << 11) | 20) & 0xFu; }
#define XB_SPIN(cond, bar) do { unsigned _sp = 0; while (cond) { __builtin_amdgcn_s_sleep(1); \
    if ((++_sp & 255u) == 0u) { if (xb_ld(&(bar)[XB_TMO])) break; if (_sp > XB_SPIN_CAP) { atomicAdd(&(bar)[XB_TMO], 1u); break; } } } } while (0)
struct XcdBarrier { unsigned* bar; unsigned x; volatile LAS unsigned* st; };
__device__ __forceinline__ XcdBarrier xcd_barrier_post(unsigned* bar, volatile LAS unsigned* st) {
    XcdBarrier b; b.bar = bar; b.x = xb_xcc_id(); b.st = st;
    if (threadIdx.x == 0) (void)xb_add(&bar[XB_XCNT(b.x)], 1u);
    return b;
}
__device__ __forceinline__ void xcd_barrier_complete(unsigned* bar, unsigned x, unsigned& nloc, unsigned& nx) {
    const unsigned G = gridDim.x * gridDim.y * gridDim.z;
    unsigned sum, cnt, mine, sp = 0u;
    for (;;) {
        sum = 0u; cnt = 0u; mine = 0u;
#pragma unroll
        for (unsigned j = 0; j < 16; ++j) { const unsigned c = xb_ld(&bar[XB_XCNT(j)]); sum += c; cnt += (c > 0u) ? 1u : 0u; mine = (j == x) ? c : mine; }
        if (sum == G) break;
        __builtin_amdgcn_s_sleep(1);
        if ((++sp & 255u) == 0u) { if (xb_ld(&bar[XB_TMO])) break; if (sp > XB_SPIN_CAP) { atomicAdd(&bar[XB_TMO], 1u); break; } }
    }
    nloc = mine > 0u ? mine : 1u; nx = cnt > 0u ? cnt : 1u;
}
__device__ __forceinline__ void xcd_barrier(const XcdBarrier& b) {
    asm volatile("s_waitcnt vmcnt(0)" ::: "memory");
    __syncthreads();
    if (threadIdx.x == 0) {
        unsigned* bar = b.bar;
        __builtin_amdgcn_s_waitcnt(0);
        unsigned nloc = b.st[0], nx = b.st[1];
        if (nloc == 0u) { xcd_barrier_complete(bar, b.x, nloc, nx); b.st[0] = nloc; b.st[1] = nx; }
        const unsigned old = xb_add(&bar[XB_XSUB(b.x)], 1u);
        const unsigned gen = old / nloc;
        if (old + 1u == (gen + 1u) * nloc) {
            __builtin_amdgcn_fence(__ATOMIC_RELEASE, "agent");
            asm volatile("s_waitcnt vmcnt(0)" ::: "memory");
            const unsigned og = xb_add(&bar[XB_TOP], 1u);
            const unsigned tg = og / nx;
            if (og + 1u == (tg + 1u) * nx) xb_add(&bar[XB_TOPGEN], 1u);
            else XB_SPIN(xb_ld(&bar[XB_TOPGEN]) == tg, bar);
            __builtin_amdgcn_fence(__ATOMIC_ACQUIRE, "agent");
            xb_add(&bar[XB_XGEN(b.x)], 1u);
            asm volatile("s_waitcnt vmcnt(0)" ::: "memory");
        } else {
            XB_SPIN(xb_ld(&bar[XB_XGEN(b.x)]) == gen, bar);
            __builtin_amdgcn_fence(__ATOMIC_ACQUIRE, "agent");
            asm volatile("s_waitcnt vmcnt(0)" ::: "memory");
        }
    }
    __syncthreads();
}

__device__ __forceinline__ float wave_sum(float v) {
#pragma unroll
    for (int o = 1; o < 64; o <<= 1) v += __shfl_xor(v, o);
    return v;
}
__device__ __forceinline__ float wave_max(float v) {
#pragma unroll
    for (int o = 1; o < 64; o <<= 1) v = fmaxf(v, __shfl_xor(v, o));
    return v;
}
template <int CTRL> __device__ __forceinline__ float dpp_f(float x) { return __int_as_float(__builtin_amdgcn_update_dpp(0, __float_as_int(x), CTRL, 0xf, 0xf, true)); }
template <int CTRL> __device__ __forceinline__ unsigned dpp_u(unsigned x) { return (unsigned)__builtin_amdgcn_update_dpp(0, (int)x, CTRL, 0xf, 0xf, true); }
__device__ __forceinline__ float sum16(float x) { x += dpp_f<0xB1>(x); x += dpp_f<0x4E>(x); x += dpp_f<0x141>(x); x += dpp_f<0x140>(x); return x; }
__device__ __forceinline__ unsigned wave_sum_u(unsigned x) {
    x += dpp_u<0xB1>(x); x += dpp_u<0x4E>(x); x += dpp_u<0x141>(x); x += dpp_u<0x140>(x);
    return (unsigned)__builtin_amdgcn_readlane((int)x, 0) + (unsigned)__builtin_amdgcn_readlane((int)x, 16) + (unsigned)__builtin_amdgcn_readlane((int)x, 32) + (unsigned)__builtin_amdgcn_readlane((int)x, 48);
}

__device__ const unsigned char REL_BUCKET_TAB[113] = {0, 1, 2, 3, 4, 5, 6, 7, 8, 9, 10, 11, 12, 13, 14, 15, 16, 16, 16, 17, 17, 18, 18, 18, 19, 19, 19, 20, 20, 20, 20, 21, 21, 21, 21, 22, 22, 22, 22, 22, 23, 23, 23, 23, 23, 23,
    24, 24, 24, 24, 24, 24, 25, 25, 25, 25, 25, 25, 25, 26, 26, 26, 26, 26, 26, 26, 26, 27, 27, 27, 27, 27, 27, 27, 27, 27, 27, 28, 28, 28, 28, 28, 28, 28, 28, 28, 28, 29, 29, 29, 29, 29, 29, 29, 29, 29, 29, 29, 29,
    30, 30, 30, 30, 30, 30, 30, 30, 30, 30, 30, 30, 30, 30};

struct Args { const float* in[31]; float* out; unsigned char* ws; int ph_lo, ph_hi; };
enum { I_X = 0, I_P, I_WIN, I_UATT, I_URW, I_WOUT, I_RELB, I_MU, I_W0, I_WUP, I_A0, I_AUP, I_GUP, I_KK, I_KA, I_RK, I_GNW, I_GNB, I_NMIX, I_NFFN, I_NPLE, I_PLEP, I_PLEG, I_F1, I_F3, I_F2, I_ROUT, I_M1, I_M3, I_M2, I_FIN };

struct ConvJob { const float* src; bf16* dst; int K, N, mode, end; float f8scale; int pad; };
constexpr int NJOBS = 39;
__device__ __forceinline__ void tr_load(const float* W, int N, int item, int lane, f32x4 (&v)[8]) {
    const int nblk = (N + 31) >> 5, kb = item / nblk, nb = item - kb * nblk, k0 = 64 * kb, n0 = 32 * nb;
    const int rsub = lane >> 3, c4 = lane & 7, nr = n0 + 4 * c4;
    const GAS float* src = (const GAS float*)W + (size_t)(k0 + rsub) * N + (nr < N ? nr : 0);
#pragma unroll
    for (int i = 0; i < 8; ++i) v[i] = *(const GAS f32x4*)(src + (size_t)(8 * i) * N);
}
__device__ __forceinline__ void tr_store(int N, bf16* WT, int dpitch, int mode, LAS float* scr, int item, int lane, float f8scale, const f32x4 (&v)[8]) {
    const int nblk = (N + 31) >> 5, kb = item / nblk, nb = item - kb * nblk, k0 = 64 * kb, n0 = 32 * nb;
    const int rsub = lane >> 3, c4 = lane & 7, nr = n0 + 4 * c4;
    const bool inr = nr < N;
#pragma unroll
    for (int i = 0; i < 8; ++i) { LAS float* d = scr + (8 * i + rsub) * 33 + 4 * c4; d[0] = inr ? v[i][0] : 0.f; d[1] = inr ? v[i][1] : 0.f; d[2] = inr ? v[i][2] : 0.f; d[3] = inr ? v[i][3] : 0.f; }
    LDS_WAIT(); asm volatile("" ::: "memory");
    if (f8scale != 0.f) {
#pragma unroll
        for (int j = 0; j < 2; ++j) { const int ch = lane + 64 * j, nl = ch >> 2, c16 = ch & 3, n = n0 + nl; const LAS float* s = scr + (16 * c16) * 33 + nl;
            v4u o;
            o.x = pg8::pk_fp8x4(s[0 * 33] * f8scale, s[1 * 33] * f8scale, s[2 * 33] * f8scale, s[3 * 33] * f8scale); o.y = pg8::pk_fp8x4(s[4 * 33] * f8scale, s[5 * 33] * f8scale, s[6 * 33] * f8scale, s[7 * 33] * f8scale);
            o.z = pg8::pk_fp8x4(s[8 * 33] * f8scale, s[9 * 33] * f8scale, s[10 * 33] * f8scale, s[11 * 33] * f8scale); o.w = pg8::pk_fp8x4(s[12 * 33] * f8scale, s[13 * 33] * f8scale, s[14 * 33] * f8scale, s[15 * 33] * f8scale);
            if (n < N) { const int drow = mode == 0 ? n : ((n >> 7) * 256 + (n & 127) + (mode == 2 ? 128 : 0)); *(GAS v4u*)((GAS unsigned char*)WT + (size_t)drow * dpitch + k0 + 16 * c16) = o; } }
        LDS_WAIT(); asm volatile("" ::: "memory");
        return;
    }
    const int c = lane & 7;
#pragma unroll
    for (int j = 0; j < 4; ++j) { const int nl = (lane >> 3) + 8 * j, n = n0 + nl; const LAS float* s = scr + (8 * c) * 33 + nl;
        v4u o; o.x = cvt_pk_bf16(s[0 * 33], s[1 * 33]); o.y = cvt_pk_bf16(s[2 * 33], s[3 * 33]); o.z = cvt_pk_bf16(s[4 * 33], s[5 * 33]); o.w = cvt_pk_bf16(s[6 * 33], s[7 * 33]);
        if (n < N) { const int drow = mode == 0 ? n : ((n >> 7) * 256 + (n & 127) + (mode == 2 ? 128 : 0)); *(GAS v4u*)((GAS bf16*)WT + (size_t)drow * dpitch + k0 + 8 * c) = o; } }
    LDS_WAIT(); asm volatile("" ::: "memory");
}
__device__ __forceinline__ void p0_prologue(const Args& a, LAS unsigned char* lds, int tid, int lane, int wave, int G) {
    unsigned char* ws = a.ws;
    LAS ConvJob* jobs = (LAS ConvJob*)(lds + JOB_OFF);
    if (tid == 0) {
        int nj = 0, end = 0;
        { size_t zv = 0; asm volatile("" : "+v"(zv)); ws += zv; }
#define ADDJOB(src_, dst_, K_, N_, mode_) do { end += ((K_) / 64) * (((N_) + 31) / 32); jobs[nj].src = (src_); jobs[nj].dst = (dst_); jobs[nj].K = (K_); jobs[nj].N = (N_); jobs[nj].mode = (mode_); jobs[nj].end = end; jobs[nj].f8scale = 0.f; jobs[nj].pad = 0; ++nj; } while (0)
#define ADDJOB8(src_, dst_, K_, N_, mode_, sc_) do { ADDJOB(src_, dst_, K_, N_, mode_); jobs[nj - 1].f8scale = (sc_); } while (0)
        for (int e = 0; e < NE; ++e) {
            ADDJOB8(a.in[I_M1] + (size_t)e * D * DFE, (bf16*)(ws + WS_M13 + (size_t)e * 2 * DFE * XGP), D, DFE, 1, MOE_WS13); jobs[nj - 1].pad = 2 * KPAD;
            ADDJOB8(a.in[I_M3] + (size_t)e * D * DFE, (bf16*)(ws + WS_M13 + (size_t)e * 2 * DFE * XGP), D, DFE, 2, MOE_WS13); jobs[nj - 1].pad = 2 * KPAD;
            ADDJOB8(a.in[I_M2] + (size_t)e * DFE * D, (bf16*)(ws + WS_M2 + (size_t)e * D * DFE), DFE, D, 0, MOE_WS2);
        }
        ADDJOB(a.in[I_F1], (bf16*)(ws + WS_F13), D, DFF, 1);
        ADDJOB(a.in[I_F3], (bf16*)(ws + WS_F13), D, DFF, 2);
        ADDJOB8(a.in[I_F2], (bf16*)(ws + WS_F2), DFF, D, 0, MOE_WS2);
        for (int l = 0; l < DEPTH; ++l) {
            ADDJOB(a.in[I_WIN] + (size_t)l * D * IN_W, (bf16*)(ws + WS_WIN) + (size_t)l * PW * D, D, IN_W, 0);
            ADDJOB8(a.in[I_UATT] + (size_t)l * 1024 * D, (bf16*)(ws + WS_UATT) + (size_t)l * D * 1024, 1024, D, 0, PLE_WS);
            ADDJOB8(a.in[I_URW] + (size_t)l * 1024 * D, (bf16*)(ws + WS_URW) + (size_t)l * D * 1024, 1024, D, 0, PLE_WS);
            ADDJOB8(a.in[I_WOUT] + (size_t)l * D * D, (bf16*)(ws + WS_WOUT) + (size_t)l * D * D, D, D, 0, PLE_WS);
            if (l == DEPTH - 1) ADDJOB8(a.in[I_PLEG] + (size_t)l * D * D, (bf16*)(ws + WS_PLEG) + (size_t)l * D * D, D, D, 0, PLE_WS);
            else ADDJOB(a.in[I_PLEG] + (size_t)l * D * D, (bf16*)(ws + WS_PLEG) + (size_t)l * D * D, D, D, 0);
            ADDJOB(a.in[I_PLEP] + (size_t)l * 256 * D, (bf16*)(ws + WS_PLEP) + (size_t)l * D * 256, 256, D, 0);
        }
#undef ADDJOB8
#undef ADDJOB
    }
    __syncthreads();
    LAS float* scr = (LAS float*)(lds + wave * 8704);
    const int gw = blockIdx.x * 8 + wave, NGW = G * 8;
    const int total = jobs[NJOBS - 1].end;
    {
        int j = 0, jbeg = 0, it = gw;
        f32x4 va[8], vb[8];
        if (it < total) { while (it >= jobs[j].end) { jbeg = jobs[j].end; ++j; } tr_load(jobs[j].src, jobs[j].N, it - jbeg, lane, va); }
#define TRHALF_(CUR, NXT) { \
            int jn = j, jbn = jbeg; const int itn = it + NGW; \
            asm volatile("" : "+v"(CUR[0]), "+v"(CUR[1]), "+v"(CUR[2]), "+v"(CUR[3]), "+v"(CUR[4]), "+v"(CUR[5]), "+v"(CUR[6]), "+v"(CUR[7]) :: "memory"); \
            if (itn < total) { while (itn >= jobs[jn].end) { jbn = jobs[jn].end; ++jn; } tr_load(jobs[jn].src, jobs[jn].N, itn - jbn, lane, NXT); } \
            __builtin_amdgcn_sched_barrier(0); \
            asm volatile("" : "+v"(CUR[0]), "+v"(CUR[1]), "+v"(CUR[2]), "+v"(CUR[3]), "+v"(CUR[4]), "+v"(CUR[5]), "+v"(CUR[6]), "+v"(CUR[7])); \
            tr_store(jobs[j].N, jobs[j].dst, jobs[j].K + jobs[j].pad, jobs[j].mode, scr, it - jbeg, lane, jobs[j].f8scale, CUR); \
            j = jn; jbeg = jbn; it = itn; }
        while (it < total) {
            TRHALF_(va, vb);
            if (it >= total) break;
            TRHALF_(vb, va);
        }
#undef TRHALF_
    }
    const int gt = blockIdx.x * 512 + tid, NGT = G * 512;
    for (int l = 0; l < DEPTH; ++l) {
        bf16* lrt = (bf16*)(ws + WS_LRT + (size_t)l * LRT_BYTES);
        const float* wup = a.in[I_WUP] + (size_t)l * 64 * 1024; const float* aup = a.in[I_AUP] + (size_t)l * 64 * 1024; const float* gup = a.in[I_GUP] + (size_t)l * 160 * 1024;
        for (int i = gt; i < LRN * LRK; i += NGT) { const int n = i / LRK, k = i - n * LRK; float v = 0.f;
            if (n < 1024) { if (k < 64) v = wup[k * 1024 + n]; }
            else if (n < 2048) { if (k >= 64 && k < 128) v = aup[(k - 64) * 1024 + (n - 1024)]; }
            else { if (k >= 128 && k < 288) v = gup[(k - 128) * 1024 + (n - 2048)]; }
            lrt[i] = f2bf(v); }
    }
    { const f32x4* p4 = (const f32x4*)a.in[I_P]; v2u* o = (v2u*)(ws + WS_PB);
      for (int i = gt; i < DEPTH * T * 256 / 4; i += NGT) { const f32x4 v = p4[i]; v2u w; w.x = cvt_pk_bf16(v[0], v[1]); w.y = cvt_pk_bf16(v[2], v[3]); o[i] = w; } }
}

template <int MODE, bool F8OUT = false>
__device__ __forceinline__ void norm_phase(const float* hin, float* hout, const float* gain, bf16* xn, const float* router, unsigned* ctl, int* route, const bf16* ym, const LAS int* tab, int lane, int wave, int G) {
    const int gw = blockIdx.x * 8 + wave, NGW = G * 8;
    f32x4 gv[8];
    { const f32x4* g4 = (const f32x4*)gain + lane;
#pragma unroll
      for (int j = 0; j < 8; ++j) gv[j] = g4[64 * j]; }
    f32x4 vn[8]; int rn[6] = {0, 0, 0, 0, 0, 0};
    if (gw < T) { const f32x4* xr = (const f32x4*)(hin + (size_t)gw * D) + lane;
#pragma unroll
        for (int j = 0; j < 8; ++j) vn[j] = xr[64 * j];
        if (MODE == 2) { const int* rt = route + (size_t)gw * 8; rn[0] = rt[0]; rn[1] = rt[1]; rn[2] = rt[2]; rn[3] = rt[3]; rn[4] = rt[4]; rn[5] = rt[5]; } }
    for (int m = gw; m < T; m += NGW) {
        f32x4 v[8];
#pragma unroll
        for (int j = 0; j < 8; ++j) v[j] = vn[j];
        v2u ya[8], yb[8]; float g1 = 0.f, g2 = 0.f;
        if (MODE == 2) {
            const int e1 = rn[0], p1 = rn[1], e2 = rn[3], p2 = rn[4]; g1 = __int_as_float(rn[2]); g2 = __int_as_float(rn[5]);
            const v2u* y1 = (const v2u*)(ym + (size_t)(tab[e1] * 256 + p1) * D) + lane; const v2u* y2 = (const v2u*)(ym + (size_t)(tab[e2] * 256 + p2) * D) + lane;
#pragma unroll
            for (int j = 0; j < 8; ++j) { ya[j] = y1[64 * j]; yb[j] = y2[64 * j]; }
        }
        { const int mn = m + NGW;
          if (mn < T) { const f32x4* xr = (const f32x4*)(hin + (size_t)mn * D) + lane;
#pragma unroll
              for (int j = 0; j < 8; ++j) vn[j] = xr[64 * j];
              if (MODE == 2) { const int* rt = route + (size_t)mn * 8; rn[0] = rt[0]; rn[1] = rt[1]; rn[2] = rt[2]; rn[3] = rt[3]; rn[4] = rt[4]; rn[5] = rt[5]; } } }
        __builtin_amdgcn_sched_barrier(0);
        if (MODE == 2) {
            f32x4* ho = (f32x4*)(hout + (size_t)m * D) + lane;
#pragma unroll
            for (int j = 0; j < 8; ++j) { const v2u a = ya[j], b = yb[j];
                v[j][0] += g1 * bflo(a.x) + g2 * bflo(b.x); v[j][1] += g1 * bfhi(a.x) + g2 * bfhi(b.x); v[j][2] += g1 * bflo(a.y) + g2 * bflo(b.y); v[j][3] += g1 * bfhi(a.y) + g2 * bfhi(b.y); }
#pragma unroll
            for (int j = 0; j < 8; ++j) ho[64 * j] = v[j];
        }
        float s = 0.f;
#pragma unroll
        for (int j = 0; j < 8; ++j) s += (v[j][0] * v[j][0] + v[j][1] * v[j][1]) + (v[j][2] * v[j][2] + v[j][3] * v[j][3]);
        const float rs = rsqrtf(wave_sum(s) * (1.0f / D) + RMS_EPS);
#pragma unroll
        for (int j = 0; j < 8; ++j) v[j] = (v[j] * rs) * gv[j];
        if (F8OUT) { unsigned* o = (unsigned*)((unsigned char*)xn + (size_t)m * D) + lane;
#pragma unroll
            for (int j = 0; j < 8; ++j) o[64 * j] = pg8::pk_fp8x4(v[j][0] * PLE_AS, v[j][1] * PLE_AS, v[j][2] * PLE_AS, v[j][3] * PLE_AS);
        } else
        if (MODE == 4) { unsigned* o = (unsigned*)((unsigned char*)xn + (size_t)m * D) + lane;
#pragma unroll
            for (int j = 0; j < 8; ++j) o[64 * j] = pg8::pk_fp8x4(v[j][0] * MOE_AS, v[j][1] * MOE_AS, v[j][2] * MOE_AS, v[j][3] * MOE_AS);
        } else
        if (MODE == 3) { f32x4* o = (f32x4*)(hout + (size_t)m * D) + lane;
#pragma unroll
            for (int j = 0; j < 8; ++j) o[64 * j] = v[j];
        } else { v2u* o = (v2u*)(xn + (size_t)m * D) + lane;
#pragma unroll
            for (int j = 0; j < 8; ++j) { v2u w; w.x = cvt_pk_bf16(v[j][0], v[j][1]); w.y = cvt_pk_bf16(v[j][2], v[j][3]); o[64 * j] = w; } }
        if (MODE == 1) {
            float lg[8];
#pragma unroll
            for (int e = 0; e < 8; ++e) lg[e] = 0.f;
#pragma unroll
            for (int jp = 0; jp < 4; ++jp) {
                f32x4 rr[2][4][2];
#pragma unroll
                for (int jj = 0; jj < 2; ++jj)
#pragma unroll
                    for (int q = 0; q < 4; ++q) { const f32x4* rp = (const f32x4*)(router + (size_t)(4 * lane + 256 * (2 * jp + jj) + q) * 8); rr[jj][q][0] = rp[0]; rr[jj][q][1] = rp[1]; }
                __builtin_amdgcn_sched_barrier(0);
#pragma unroll
                for (int jj = 0; jj < 2; ++jj)
#pragma unroll
                    for (int q = 0; q < 4; ++q) { const f32x4 r0 = rr[jj][q][0], r1 = rr[jj][q][1]; const float x = v[2 * jp + jj][q];
                        lg[0] += x * r0[0]; lg[1] += x * r0[1]; lg[2] += x * r0[2]; lg[3] += x * r0[3]; lg[4] += x * r1[0]; lg[5] += x * r1[1]; lg[6] += x * r1[2]; lg[7] += x * r1[3]; }
                __builtin_amdgcn_sched_barrier(0);
            }
#pragma unroll
            for (int e = 0; e < 8; ++e) lg[e] = wave_sum(lg[e]);
            int i1 = 0; float v1 = lg[0];
#pragma unroll
            for (int e = 1; e < 8; ++e) if (lg[e] > v1) { v1 = lg[e]; i1 = e; }
            int i2 = -1; float v2 = -INFINITY;
#pragma unroll
            for (int e = 0; e < 8; ++e) if (e != i1 && lg[e] > v2) { v2 = lg[e]; i2 = e; }
            if (lane == 0) {
                const float ex = __expf(v2 - v1), g1r = 1.0f / (1.0f + ex), g2r = ex * g1r;
                const int p1 = (int)atomicAdd(ctl + CW_MOECNT + i1, 1u), p2 = (int)atomicAdd(ctl + CW_MOECNT + i2, 1u);
                int* rt = route + (size_t)m * 8; rt[0] = i1; rt[1] = p1; rt[2] = __float_as_int(g1r); rt[3] = i2; rt[4] = p2; rt[5] = __float_as_int(g2r); rt[6] = 0; rt[7] = 0;
            }
        }
    }
}
__device__ __forceinline__ void moe_table(const unsigned* ctl, LAS int* tab, int NT, int tid) {
    __syncthreads();
    if (tid == 0) { int tb = 0, ub = 0;
        for (int e = 0; e < NE; ++e) { tab[e] = tb; tab[9 + e] = ub; const int tiles = ((int)ctl[CW_MOECNT + e] + 255) >> 8; tb += tiles; ub += tiles * NT; }
        tab[8] = tb; tab[17] = ub; }
    __syncthreads();
}
__device__ __forceinline__ void moe_gather(const unsigned char* xn8, unsigned char* xg, const int* route, const LAS int* tab, int lane, int wave, int G) {
    const int gw = blockIdx.x * 8 + wave, NGW = G * 8;
    for (int m = gw; m < T; m += NGW) {
        const int* rt = route + (size_t)m * 8; const int r1 = tab[rt[0]] * 256 + rt[1], r2 = tab[rt[3]] * 256 + rt[4];
        const v4u* s = (const v4u*)(xn8 + (size_t)m * D) + 2 * lane;
        const v4u o0 = s[0], o1 = s[1];
        v4u* d1 = (v4u*)(xg + (size_t)r1 * XGP) + 2 * lane; v4u* d2 = (v4u*)(xg + (size_t)r2 * XGP) + 2 * lane;
        d1[0] = o0; d1[1] = o1; d2[0] = o0; d2[1] = o1;
    }
}

__device__ __forceinline__ void rwkv_prep_a(const bf16* proj, const float* mu, bf16* lra, int tid, int G) {
    const int gt = blockIdx.x * 512 + tid, NGT = G * 512;
    for (int i = gt; i < T * 48; i += NGT) {
        const int m = i / 48, j8 = i - m * 48, t = m & (SEQ - 1);
        v4u o = {0u, 0u, 0u, 0u};
        if (j8 < 36) {
            const int sc = S_XW + 8 * j8;
            const v4u cu = *(const v4u*)(proj + O_SL + (size_t)m * SLAB_W + sc);
            v4u pv = {0u, 0u, 0u, 0u}; if (t > 0) pv = *(const v4u*)(proj + O_SL + (size_t)(m - 1) * SLAB_W + sc);
            const f32x4 m0 = *(const f32x4*)(mu + sc), m1 = *(const f32x4*)(mu + sc + 4);
            float x[8];
            x[0] = bflo(cu.x) + (bflo(pv.x) - bflo(cu.x)) * m0[0]; x[1] = bfhi(cu.x) + (bfhi(pv.x) - bfhi(cu.x)) * m0[1];
            x[2] = bflo(cu.y) + (bflo(pv.y) - bflo(cu.y)) * m0[2]; x[3] = bfhi(cu.y) + (bfhi(pv.y) - bfhi(cu.y)) * m0[3];
            x[4] = bflo(cu.z) + (bflo(pv.z) - bflo(cu.z)) * m1[0]; x[5] = bfhi(cu.z) + (bfhi(pv.z) - bfhi(cu.z)) * m1[1];
            x[6] = bflo(cu.w) + (bflo(pv.w) - bflo(cu.w)) * m1[2]; x[7] = bfhi(cu.w) + (bfhi(pv.w) - bfhi(cu.w)) * m1[3];
            if (j8 < 8) {
#pragma unroll
                for (int q = 0; q < 8; ++q) x[q] = 1.0f - 2.0f * __builtin_amdgcn_rcpf(1.0f + __expf(2.0f * x[q]));
            } else if (j8 >= 16) {
#pragma unroll
                for (int q = 0; q < 8; ++q) x[q] = sigm(x[q]);
            }
            o.x = cvt_pk_bf16(x[0], x[1]); o.y = cvt_pk_bf16(x[2], x[3]); o.z = cvt_pk_bf16(x[4], x[5]); o.w = cvt_pk_bf16(x[6], x[7]);
        }
        *(v4u*)(lra + (size_t)m * LRK + 8 * j8) = o;
    }
}
__device__ __forceinline__ float sum8(float x) { x += dpp_f<0xB1>(x); x += dpp_f<0x4E>(x); x += dpp_f<0x141>(x); return x; }
__device__ __forceinline__ void unpack8(const v4u v, float (&o)[8]) { o[0] = bflo(v.x); o[1] = bfhi(v.x); o[2] = bflo(v.y); o[3] = bfhi(v.y); o[4] = bflo(v.z); o[5] = bfhi(v.z); o[6] = bflo(v.w); o[7] = bfhi(v.w); }
__device__ __forceinline__ v4u pack8(const float (&x)[8]) { v4u o; o.x = cvt_pk_bf16(x[0], x[1]); o.y = cvt_pk_bf16(x[2], x[3]); o.z = cvt_pk_bf16(x[4], x[5]); o.w = cvt_pk_bf16(x[6], x[7]); return o; }
__device__ __forceinline__ void load8f(const float* p, float (&o)[8]) { const f32x4 a = *(const f32x4*)p, b = *(const f32x4*)(p + 4); o[0] = a[0]; o[1] = a[1]; o[2] = a[2]; o[3] = a[3]; o[4] = b[0]; o[5] = b[1]; o[6] = b[2]; o[7] = b[3]; }
__device__ __forceinline__ void rwkv_prep_b(const bf16* proj_, const bf16* lr_, const float* mu, const float* w0, const float* a0, const float* k_k, const float* k_a, unsigned char* scanin, int tid, int G, int ntok) {
    const GAS bf16* proj = (const GAS bf16*)proj_; const GAS bf16* lr = (const GAS bf16*)lr_;
    const int gt = blockIdx.x * 512 + tid, NGT = G * 512;
    const int c8 = gt & 127, c = 8 * c8, h = c8 >> 3, sub = c8 & 7;
    float mur[8], muk[8], muv[8], w0v[8], a0v[8], kkv[8], kav[8];
    load8f(mu + S_R + c, mur); load8f(mu + S_K + c, muk); load8f(mu + S_V + c, muv); load8f(w0 + c, w0v); load8f(a0 + c, a0v); load8f(k_k + c, kkv); load8f(k_a + c, kav);
    for (int it = gt; it < ntok * 128; it += NGT) {
        const int m = it >> 7, b = m >> 13, t = m & (SEQ - 1);
        const GAS bf16* pc = proj + O_SL + (size_t)m * SLAB_W + c;
        float rc[8], kc[8], vc[8], rp[8], kp[8], vp[8], dp[8], ap[8];
        unpack8(*(const GAS v4u*)(pc + S_R), rc); unpack8(*(const GAS v4u*)(pc + S_K), kc); unpack8(*(const GAS v4u*)(pc + S_V), vc);
        if (t > 0) { unpack8(*(const GAS v4u*)(pc - SLAB_W + S_R), rp); unpack8(*(const GAS v4u*)(pc - SLAB_W + S_K), kp); unpack8(*(const GAS v4u*)(pc - SLAB_W + S_V), vp); }
        else {
#pragma unroll
            for (int j = 0; j < 8; ++j) { rp[j] = 0.f; kp[j] = 0.f; vp[j] = 0.f; } }
        unpack8(*(const GAS v4u*)(lr + (size_t)m * LRN + c), dp); unpack8(*(const GAS v4u*)(lr + (size_t)m * LRN + 1024 + c), ap);
        float r[8], kt[8], v[8], kk[8], bb[8], w[8], k[8], av[8]; float ss = 0.f;
#pragma unroll
        for (int j = 0; j < 8; ++j) { r[j] = rc[j] + (rp[j] - rc[j]) * mur[j]; k[j] = kc[j] + (kp[j] - kc[j]) * muk[j]; v[j] = vc[j] + (vp[j] - vc[j]) * muv[j];
            w[j] = __expf(-0.6065306597126334f * sigm(w0v[j] + dp[j])); av[j] = sigm(a0v[j] + ap[j]); kk[j] = k[j] * kkv[j]; ss += kk[j] * kk[j]; kt[j] = k[j] * (1.0f + (av[j] - 1.0f) * kav[j]); }
        const float rn = rsqrtf(fmaxf(sum8(ss), 1e-24f));
#pragma unroll
        for (int j = 0; j < 8; ++j) { kk[j] *= rn; bb[j] = kk[j] * av[j]; }
        unsigned char* rec = scanin + ((size_t)(b * 16 + h) * SEQ + t) * SREC;
        *(f32x4*)(rec + sub * 32) = (f32x4){w[0], w[1], w[2], w[3]}; *(f32x4*)(rec + sub * 32 + 16) = (f32x4){w[4], w[5], w[6], w[7]};
        *(v4u*)(rec + 256 + sub * 16) = pack8(r); *(v4u*)(rec + 384 + sub * 16) = pack8(kt); *(v4u*)(rec + 512 + sub * 16) = pack8(v); *(v4u*)(rec + 640 + sub * 16) = pack8(kk); *(v4u*)(rec + 768 + sub * 16) = pack8(bb);
    }
}
template <int RKV_REC> __device__ __forceinline__ void rwkv_post(const float* ys, const unsigned char* scanin, const bf16* lr_, const float* r_k, const float* gn_w, const float* gn_b, bf16* rw, int tid, int G) {
    const GAS bf16* lr = (const GAS bf16*)lr_;
    const int gt = blockIdx.x * 512 + tid, NGT = G * 512;
    const int c8 = gt & 127, c = 8 * c8, h = c8 >> 3, sub = c8 & 7;
    float rkv[8], gw[8], gb[8];
    load8f(r_k + c, rkv); load8f(gn_w + c, gw); load8f(gn_b + c, gb);
    for (int it = gt; it < T * 128; it += NGT) {
        const int m = it >> 7, b = m >> 13, t = m & (SEQ - 1);
        float y[8]; load8f(ys + (size_t)m * 1024 + c, y);
        float s = 0.f;
#pragma unroll
        for (int j = 0; j < 8; ++j) s += y[j];
        const float mean = sum8(s) * (1.0f / 64.0f); float q = 0.f;
#pragma unroll
        for (int j = 0; j < 8; ++j) { y[j] -= mean; q += y[j] * y[j]; }
        const float rstd = rsqrtf(sum8(q) * (1.0f / 64.0f) + GN_EPS);
        const unsigned char* rec = scanin + ((size_t)(b * 16 + h) * SEQ + t) * RKV_REC;
        float r[8], kt[8], v[8], g[8];
        unpack8(*(const v4u*)(rec + sub * 16), r); unpack8(*(const v4u*)(rec + 128 + sub * 16), kt); unpack8(*(const v4u*)(rec + 256 + sub * 16), v);
        unpack8(*(const GAS v4u*)(lr + (size_t)m * LRN + 2048 + c), g);
        float bs = 0.f;
#pragma unroll
        for (int j = 0; j < 8; ++j) bs += r[j] * kt[j] * rkv[j];
        bs = sum8(bs);
        float o[8];
#pragma unroll
        for (int j = 0; j < 8; ++j) o[j] = (y[j] * rstd * gw[j] + gb[j] + bs * v[j]) * g[j];
        { v2u w8; w8.x = pg8::pk_fp8x4(o[0] * 8.0f, o[1] * 8.0f, o[2] * 8.0f, o[3] * 8.0f); w8.y = pg8::pk_fp8x4(o[4] * 8.0f, o[5] * 8.0f, o[6] * 8.0f, o[7] * 8.0f);
          *(v2u*)((unsigned char*)rw + (size_t)m * 1024 + c) = w8; }
    }
}

#ifndef SEL_CHECK
#define SEL_CHECK 0
#endif
#ifndef PROBE_REPEAT
#define PROBE_REPEAT 0u
#endif
#define SUBREP(k) for (int rep_ = 0; rep_ < 1 + (int)(((PROBE_REPEAT) >> (k)) & 1u); ++rep_)
typedef float f32x2 __attribute__((ext_vector_type(2)));
__device__ __forceinline__ int f2ikey(float f) { const int u = __float_as_int(f); return u ^ ((u >> 31) & 0x7fffffff); }
__device__ __forceinline__ unsigned pk_ge_flags(unsigned xm1x2, unsigned d) {
    unsigned t; asm volatile("v_pk_sub_i16 %0, %1, %2 clamp\n\tv_pk_lshrrev_b16 %0, %3, %0" : "=&v"(t) : "v"(xm1x2), "v"(d), "v"(0x000f000fu)); return t; }
__device__ __forceinline__ unsigned pk_add16(unsigned a, unsigned b) { unsigned r; asm volatile("v_pk_add_u16 %0, %1, %2" : "=v"(r) : "v"(a), "v"(b)); return r; }
__device__ __forceinline__ unsigned wave_sum_pk(unsigned acc) {
    unsigned x = (acc & 0xffffu) + (acc >> 16);
    x += dpp_u<0xB1>(x); x += dpp_u<0x4E>(x); x += dpp_u<0x141>(x); x += dpp_u<0x140>(x);
    return (unsigned)__builtin_amdgcn_readlane((int)x, 0) + (unsigned)__builtin_amdgcn_readlane((int)x, 16) + (unsigned)__builtin_amdgcn_readlane((int)x, 32) + (unsigned)__builtin_amdgcn_readlane((int)x, 48);
}
__device__ __forceinline__ unsigned count_ge16(const LAS unsigned short* hrow, int ng, int x, int lane) {
    const unsigned xm = (unsigned)((x - 1) & 0xffff), xm1x2 = xm | (xm << 16);
    unsigned acc = 0u;
    v4u a = *(const LAS v4u*)(hrow + 8 * lane);
    for (int g = 1; g < ng; ++g) {
        const v4u b = *(const LAS v4u*)(hrow + 512 * g + 8 * lane);
        acc = pk_add16(acc, pk_ge_flags(xm1x2, a.x)); acc = pk_add16(acc, pk_ge_flags(xm1x2, a.y)); acc = pk_add16(acc, pk_ge_flags(xm1x2, a.z)); acc = pk_add16(acc, pk_ge_flags(xm1x2, a.w));
        a = b;
    }
    acc = pk_add16(acc, pk_ge_flags(xm1x2, a.x)); acc = pk_add16(acc, pk_ge_flags(xm1x2, a.y)); acc = pk_add16(acc, pk_ge_flags(xm1x2, a.z)); acc = pk_add16(acc, pk_ge_flags(xm1x2, a.w));
    return wave_sum_pk(acc);
}
__device__ __forceinline__ unsigned wave_scan_u(unsigned x) {
    x += (unsigned)__builtin_amdgcn_update_dpp(0, (int)x, 0x111, 0xf, 0xf, false); x += (unsigned)__builtin_amdgcn_update_dpp(0, (int)x, 0x112, 0xf, 0xf, false);
    x += (unsigned)__builtin_amdgcn_update_dpp(0, (int)x, 0x114, 0xf, 0xf, false); x += (unsigned)__builtin_amdgcn_update_dpp(0, (int)x, 0x118, 0xf, 0xf, false);
    x += (unsigned)__builtin_amdgcn_update_dpp(0, (int)x, 0x142, 0xa, 0xf, false); x += (unsigned)__builtin_amdgcn_update_dpp(0, (int)x, 0x143, 0xc, 0xf, false);
    return x;
}
__device__ __forceinline__ void select_phase(const bf16* proj_, unsigned short* idx, unsigned short* loscr, LAS unsigned char* lds, int tid, int lane, int wave, int G, unsigned* chk) {
    LAS unsigned short* hk = (LAS unsigned short*)lds;
    LAS unsigned short* olist = (LAS unsigned short*)(lds + MISC_OFF + 2048);
    LAS unsigned short* cand = (LAS unsigned short*)(lds + MISC_OFF + 8192);
    const GAS bf16* proj = (const GAS bf16*)proj_;
    GAS unsigned short* lo = (GAS unsigned short*)loscr + (size_t)blockIdx.x * 8 * SEQ;
#define LOIDX_(row, key) ((size_t)(key) * 8 + ((row) & 3) * 2 + ((row) >> 2))
    const int kq = lane >> 4, l15 = lane & 15;
    const bool mirror = ((T / 8) % G == 0);
    for (int u_ = blockIdx.x, rnd = 0; u_ < T / 8; u_ += G, ++rnd) {
        const int u = (mirror && (rnd & 1)) ? (u_ - (int)blockIdx.x) + (G - 1 - (int)blockIdx.x) : u_;
        const int m0 = 8 * u, b = m0 >> 13, t0 = m0 & (SEQ - 1);
        if (t0 < NSEL) {
            for (int r = 0; r < 8; ++r) for (int j = tid; j <= t0 + r; j += 512) idx[(size_t)(m0 + r) * NSEL + j] = (unsigned short)j;
            continue;
        }
        const int tmax = t0 + 7, ntiles = (tmax >> 4) + 1, n16 = ntiles * 16, ng = (n16 + 511) >> 9, npad = ng * 512 - n16;
        for (int i = tid; i < 8 * npad; i += 512) { const int r = i / npad, k = n16 + (i - r * npad); hk[r * SEQ + k] = (unsigned short)0x807f; }
        SUBREP(13) {
        bf16x8 af[2][2][2]; f32x2 w2[2][4];
#pragma unroll
        for (int rs = 0; rs < 2; ++rs) {
#pragma unroll
            for (int ps = 0; ps < 2; ++ps) { const GAS bf16* qrow = proj + O_QI + (size_t)(m0 + 4 * rs + (l15 >> 2)) * 512 + ((l15 & 3) + 4 * ps) * 64 + 16 * kq;
                af[rs][ps][0] = *(const GAS bf16x8*)qrow; af[rs][ps][1] = *(const GAS bf16x8*)(qrow + 8); }
            const v4u w = *(const GAS v4u*)(proj + O_WI + (size_t)(m0 + 4 * rs + kq) * 8);
            w2[rs][0] = (f32x2){bflo(w.x), bfhi(w.x)}; w2[rs][1] = (f32x2){bflo(w.y), bfhi(w.y)}; w2[rs][2] = (f32x2){bflo(w.z), bfhi(w.z)}; w2[rs][3] = (f32x2){bflo(w.w), bfhi(w.w)}; }
        const GAS bf16* kcol = proj + O_KI + (size_t)b * SEQ * 64 + (size_t)l15 * 64 + 16 * kq;
        const int kst2 = 8;
        const int rot = 0;
#define ROT_(x) ({ int r_ = min((x), ntiles - 1) + rot; r_ >= ntiles ? r_ - ntiles : r_; })
        bf16x8 frA[4][2], frB[4][2];
#pragma unroll
        for (int p = 0; p < 4; ++p) { const GAS bf16* kp = kcol + (size_t)(ROT_(wave + 8 * p) * 16) * 64; frA[p][0] = *(const GAS bf16x8*)kp; frA[p][1] = *(const GAS bf16x8*)(kp + kst2); }
        const unsigned lanoff = (unsigned)(kq * SEQ + l15) * 2u;
        const unsigned lanoff32 = (unsigned)(l15 * 16 + kq * 4);
        GAS unsigned char* const lodump = (GAS unsigned char*)loscr + (size_t)(64u << 20);
        unsigned pend[4] = {0u, 0u, 0u, 0u}; int ktp = -1;
#define RELU2_(x, y) (f32x2){__int_as_float(max(__float_as_int(x), 0)), __int_as_float(max(__float_as_int(y), 0))}
#define PENDST_() do { GAS unsigned char* pb_ = ktp < 0 ? lodump : (GAS unsigned char*)lo; const int kb_ = ktp < 0 ? 0 : ktp; \
        _Pragma("unroll") for (int p = 0; p < 4; ++p) { const int ktq = ROT_(kb_ + 8 * p); __builtin_nontemporal_store(pend[p], (GAS unsigned*)(pb_ + ktq * 256 + lanoff32)); } } while (0)
#define TILE4_(CUR, NXT, KT0, FK) do { \
        asm volatile("" : "+v"(CUR[0][0]), "+v"(CUR[0][1]), "+v"(CUR[1][0]), "+v"(CUR[1][1]), "+v"(CUR[2][0]), "+v"(CUR[2][1]), "+v"(CUR[3][0]), "+v"(CUR[3][1]) :: "memory"); \
        _Pragma("unroll") for (int p = 0; p < 4; ++p) { const GAS bf16* kp = kcol + (size_t)((((FK) & 2) ? 0 : ROT_((KT0) + 8 * p + 32)) * 16) * 64; NXT[p][0] = *(const GAS bf16x8*)kp; NXT[p][1] = *(const GAS bf16x8*)(kp + kst2); } \
        if (!((FK) & 8)) PENDST_(); \
        __builtin_amdgcn_sched_barrier(0); \
        asm volatile("" : "+v"(CUR[0][0]), "+v"(CUR[0][1]), "+v"(CUR[1][0]), "+v"(CUR[1][1]), "+v"(CUR[2][0]), "+v"(CUR[2][1]), "+v"(CUR[3][0]), "+v"(CUR[3][1])); \
        _Pragma("unroll") for (int p = 0; p < 4; ++p) { \
            const int kt = ROT_((KT0) + 8 * p); \
            const bf16x8 c0 = CUR[p][0], c1 = CUR[p][1]; \
            const bool lastt = (kt == ntiles - 1); \
            f32x4 a0[2], a1[2]; \
            _Pragma("unroll") for (int rs = 0; rs < 2; ++rs) { \
                a0[rs] = (f32x4){0.f, 0.f, 0.f, 0.f}; a1[rs] = (f32x4){0.f, 0.f, 0.f, 0.f}; \
                if ((FK) & 1) { a0[rs] = __builtin_bit_cast(f32x4, c0); a1[rs] = __builtin_bit_cast(f32x4, c1); } else { \
                a0[rs] = __builtin_amdgcn_mfma_f32_16x16x32_bf16(af[rs][0][0], c0, a0[rs], 0, 0, 0); a1[rs] = __builtin_amdgcn_mfma_f32_16x16x32_bf16(af[rs][1][0], c0, a1[rs], 0, 0, 0); \
                a0[rs] = __builtin_amdgcn_mfma_f32_16x16x32_bf16(af[rs][0][1], c1, a0[rs], 0, 0, 0); a1[rs] = __builtin_amdgcn_mfma_f32_16x16x32_bf16(af[rs][1][1], c1, a1[rs], 0, 0, 0); } } \
            LAS unsigned char* hkt = (LAS unsigned char*)hk + kt * 32 + lanoff; \
            int ikk[2]; \
            _Pragma("unroll") for (int rs = 0; rs < 2; ++rs) { \
                f32x2 acc = {0.f, 0.f}; \
                acc += RELU2_(a0[rs][0], a0[rs][1]) * w2[rs][0]; acc += RELU2_(a0[rs][2], a0[rs][3]) * w2[rs][1]; acc += RELU2_(a1[rs][0], a1[rs][1]) * w2[rs][2]; acc += RELU2_(a1[rs][2], a1[rs][3]) * w2[rs][3]; \
                float sc = acc[0] + acc[1]; \
                if (lastt) { if (kt * 16 + l15 > t0 + 4 * rs + kq) sc = -INFINITY; } \
                const int ik = f2ikey(sc); \
                if (!((FK) & 4)) *(LAS unsigned short*)(hkt + rs * 8 * SEQ) = (unsigned short)((unsigned)ik >> 16); ikk[rs] = ik; } \
            pend[p] = ((unsigned)ikk[0] & 0xffffu) | ((unsigned)ikk[1] << 16); } \
        ktp = (KT0); } while (0)
#ifdef SWEEP_FAKE
        if (rep_ == 0) {
        const int ntf_ = (SWEEP_FAKE & 16) ? (ntiles >> 1) : ntiles;
        for (int kt0 = wave; kt0 < ntf_; kt0 += 64) {
            TILE4_(frA, frB, kt0, SWEEP_FAKE);
            if (kt0 + 32 >= ntf_) break;
            TILE4_(frB, frA, kt0 + 32, SWEEP_FAKE);
        }
        } else
#endif
        for (int kt0 = wave; kt0 < ntiles; kt0 += 64) {
            TILE4_(frA, frB, kt0, 0);
            if (kt0 + 32 >= ntiles) break;
            TILE4_(frB, frA, kt0 + 32, 0);
        }
        if (ktp >= 0) PENDST_();
#undef TILE4_
#undef ROT_
#undef PENDST_
#undef RELU2_
        }
        asm volatile("s_waitcnt vmcnt(0)" ::: "memory");
        __syncthreads();
        {
            const int row = wave, m = m0 + row;
            const LAS unsigned short* hrow = hk + row * SEQ;
            LAS unsigned short* hroww = hk + row * SEQ;
            int thr16 = 0;
            unsigned lifted_idx = 0xffffffffu; int bucket = 0; bool skipchk = false; (void)lifted_idx; (void)bucket; (void)skipchk;
            SUBREP(14) {
            int klo = -32640, khi = 32641; unsigned cnt_hi = 0u, cnt_lo = 0u; bool exact = false;
            while (khi - klo > 1) {
                const int mid = (klo + khi) >> 1;
                const unsigned c = count_ge16(hrow, ng, mid, lane);
                if (c == (unsigned)NSEL) { klo = mid; exact = true; break; }
                if (c > (unsigned)NSEL) { klo = mid; cnt_lo = c; } else { khi = mid; cnt_hi = c; }
            }
            thr16 = klo;
            if (!exact) {
                if (cnt_lo == 0u) cnt_lo = count_ge16(hrow, ng, klo, lane);
                const unsigned need = (unsigned)NSEL - cnt_hi, cb = cnt_lo - cnt_hi;
                const bool small = cb <= 64u;
                bucket = klo; skipchk = !small;
                const unsigned bx = (unsigned)(klo & 0xffff), bxx = bx | (bx << 16);
                const unsigned dumpaddr = (unsigned)(size_t)(cand + row * 72 + 64);
                unsigned base = 0u; asm volatile("" : "+v"(base));
                for (int g = 0; g < ng; ++g) {
                    const v4u kv = *(const LAS v4u*)(hrow + 512 * g + 8 * lane);
                    const unsigned d[4] = {kv.x ^ bxx, kv.y ^ bxx, kv.z ^ bxx, kv.w ^ bxx};
                    unsigned eq[8], ce = 0u;
#pragma unroll
                    for (int q = 0; q < 4; ++q) { const unsigned l0 = d[q] & 0xffffu, h0 = d[q] >> 16; eq[2 * q] = 1u - ((l0 | (0u - l0)) >> 31); eq[2 * q + 1] = 1u - ((h0 | (0u - h0)) >> 31); ce += eq[2 * q] + eq[2 * q + 1]; }
                    const unsigned isc = wave_scan_u(ce);
                    unsigned pos = base + isc - ce;
#pragma unroll
                    for (int e = 0; e < 8; ++e) { const unsigned kidx = (unsigned)(512 * g + 8 * lane + e);
                        if (small) { const unsigned inb = ((unsigned)((int)pos - 64)) >> 31; const unsigned f = eq[e] & inb; const unsigned slot = 64u + f * (pos - 64u); cand[row * 72 + slot] = (unsigned short)kidx; }
                        else { const unsigned inb = ((unsigned)((int)pos - (int)need)) >> 31; const unsigned f = eq[e] & inb; const unsigned tgt = (unsigned)(size_t)(hroww + kidx);
                               *(LAS unsigned short*)(size_t)(dumpaddr + f * (tgt - dumpaddr)) = (unsigned short)(klo + 1); }
                        pos += eq[e]; }
                    base += (unsigned)__builtin_amdgcn_readlane((int)isc, 63);
                }
                LDS_WAIT(); asm volatile("" ::: "memory");
                if (small) {
                    const bool mine = (unsigned)lane < cb;
                    const unsigned myidx = mine ? (unsigned)cand[row * 72 + lane] : 0u;
                    const unsigned mylo = mine ? (unsigned)__hip_atomic_load(lo + LOIDX_(row, myidx), __ATOMIC_RELAXED, __HIP_MEMORY_SCOPE_AGENT) : 0u;
                    unsigned rank = 0u;
                    for (unsigned j = 0; j < cb; ++j) { const unsigned oj = (unsigned)__shfl((int)mylo, (int)j), ij = (unsigned)__shfl((int)myidx, (int)j);
                        rank += (oj > mylo || (oj == mylo && ij < myidx)) ? 1u : 0u; }
                    if (mine && rank < need) { hroww[myidx] = (unsigned short)(klo + 1); lifted_idx = myidx; }
                    LDS_WAIT(); asm volatile("" ::: "memory");
                }
                thr16 = klo + 1;
            }
            }
            SUBREP(15) {
            const unsigned xm = (unsigned)((thr16 - 1) & 0xffff), xm1x2 = xm | (xm << 16);
            unsigned sel_base = 0u; asm volatile("" : "+v"(sel_base));
            LAS unsigned short* ol = olist + row * 264;
            for (int g = 0; g < ng; ++g) {
                const v4u kv = *(const LAS v4u*)(hrow + 512 * g + 8 * lane);
                const unsigned f4[4] = {pk_ge_flags(xm1x2, kv.x), pk_ge_flags(xm1x2, kv.y), pk_ge_flags(xm1x2, kv.z), pk_ge_flags(xm1x2, kv.w)};
                unsigned cs = 0u;
#pragma unroll
                for (int q = 0; q < 4; ++q) cs += (f4[q] & 1u) + (f4[q] >> 16);
                const unsigned iss = wave_scan_u(cs);
                unsigned pos = sel_base + iss - cs;
#pragma unroll
                for (int e = 0; e < 8; ++e) { const unsigned fl = (e & 1) ? (f4[e >> 1] >> 16) : (f4[e >> 1] & 1u); const unsigned inb = ((unsigned)((int)pos - NSEL)) >> 31; const unsigned f = fl & inb;
                    const unsigned slot = 256u + f * (pos - 256u); ol[slot] = (unsigned short)(512 * g + 8 * lane + e); pos += fl; }
                sel_base += (unsigned)__builtin_amdgcn_readlane((int)iss, 63);
            }
            LDS_WAIT(); asm volatile("" ::: "memory");
            if (lane < 32) *(GAS v4u*)((GAS unsigned short*)idx + (size_t)m * NSEL + 8 * lane) = *(const LAS v4u*)(ol + 8 * lane);
#if SEL_CHECK
            {
                if (lifted_idx != 0xffffffffu) hroww[lifted_idx] = (unsigned short)bucket;
                LDS_WAIT(); asm volatile("" ::: "memory");
                unsigned bad = (sel_base != (unsigned)NSEL) ? 1u : 0u; int mn = 0x7fffffff;
                for (int e = 0; e < 4; ++e) { const int j = 4 * lane + e; const int id = (int)ol[j]; const int full = (int)(((unsigned)hrow[id] << 16) | (unsigned)__hip_atomic_load(lo + LOIDX_(row, id), __ATOMIC_RELAXED, __HIP_MEMORY_SCOPE_AGENT));
                    mn = full < mn ? full : mn; if (id > t0 + row) bad = 1u; if (j < 255 && (int)ol[j + 1] <= id) bad = 1u; }
                for (int o = 1; o < 64; o <<= 1) { const int v = __shfl_xor(mn, o); mn = v < mn ? v : mn; }
                unsigned cgt = 0u, cge = 0u;
                for (int j = lane; j < n16; j += 64) { const int full = (int)(((unsigned)hrow[j] << 16) | (unsigned)__hip_atomic_load(lo + LOIDX_(row, j), __ATOMIC_RELAXED, __HIP_MEMORY_SCOPE_AGENT)); cgt += (full > mn) ? 1u : 0u; cge += (full >= mn) ? 1u : 0u; }
                for (int o = 1; o < 64; o <<= 1) { cgt += __shfl_xor(cgt, o); cge += __shfl_xor(cge, o); }
                if (!skipchk && (cgt > 255u || cge < 256u)) bad = 1u;
                if (__ballot(bad != 0u) != 0ull && lane == 0) atomicAdd(chk + 34, 1u);
                if (lane == 0) { atomicAdd(chk + 35, 1u); if (skipchk) atomicAdd(chk + 36, 1u); }
            }
#endif
            }
        }
        __syncthreads();
    }
}

__device__ __forceinline__ void attn_phase_ref(const bf16* proj, const unsigned short* idx, const float* rel_bias, bf16* att, LAS unsigned char* lds, int tid, int lane, int wave, int G) {
    LAS float* btab = (LAS float*)(lds + BIAS_OFF);
    for (int i = tid; i < 129 * 8; i += 512) { const int d = i >> 3, hh = i & 7; const int bk = d < 113 ? (int)REL_BUCKET_TAB[d] : 31; btab[i] = rel_bias[bk * 8 + hh]; }
    __syncthreads();
    LAS unsigned char* base = lds + wave * 8192;
    LAS float* qf = (LAS float*)base;
    LAS f32x4* pl = (LAS f32x4*)(base + 2048);
    LAS unsigned short* il = (LAS unsigned short*)(base + 6144);
    const int gw = blockIdx.x * 8 + wave, NGW = G * 8;
    const float scale = 0.08838834764831845f;
    for (int item = gw; item < 2 * T; item += NGW) {
        const int m = item >> 1, c = item & 1, b = m >> 13, t = m & (SEQ - 1), nsel = (t + 1 < NSEL) ? t + 1 : NSEL;
        { const v4u qv = *(const v4u*)(proj + O_Q + (size_t)m * 1024 + c * 512 + 8 * lane);
          f32x4 q0 = {bflo(qv.x), bfhi(qv.x), bflo(qv.y), bfhi(qv.y)}, q1 = {bflo(qv.z), bfhi(qv.z), bflo(qv.w), bfhi(qv.w)};
          *(LAS f32x4*)(qf + 8 * lane) = q0; *(LAS f32x4*)(qf + 8 * lane + 4) = q1; }
        int id[4];
#pragma unroll
        for (int i2 = 0; i2 < 4; ++i2) { const int j = lane + 64 * i2; id[i2] = (j < nsel) ? (int)idx[(size_t)m * NSEL + j] : 0; il[j] = (unsigned short)id[i2]; }
        LDS_WAIT(); asm volatile("" ::: "memory");
        float lg[4][4];
#pragma unroll
        for (int i2 = 0; i2 < 4; ++i2)
#pragma unroll
            for (int g = 0; g < 4; ++g) lg[i2][g] = 0.f;
        const bf16* kbase = proj + O_K + (size_t)(b * 2 + c) * SEQ * 128;
#pragma unroll 2
        for (int dc = 0; dc < 16; ++dc) {
            v4u kv[4];
#pragma unroll
            for (int i2 = 0; i2 < 4; ++i2) kv[i2] = *(const v4u*)(kbase + (size_t)id[i2] * 128 + 8 * dc);
            f32x4 qa[4][2];
#pragma unroll
            for (int g = 0; g < 4; ++g) { qa[g][0] = *(const LAS f32x4*)(qf + g * 128 + 8 * dc); qa[g][1] = *(const LAS f32x4*)(qf + g * 128 + 8 * dc + 4); }
#pragma unroll
            for (int i2 = 0; i2 < 4; ++i2) { const float k0 = bflo(kv[i2].x), k1 = bfhi(kv[i2].x), k2 = bflo(kv[i2].y), k3 = bfhi(kv[i2].y), k4 = bflo(kv[i2].z), k5 = bfhi(kv[i2].z), k6 = bflo(kv[i2].w), k7 = bfhi(kv[i2].w);
#pragma unroll
                for (int g = 0; g < 4; ++g) lg[i2][g] += (qa[g][0][0] * k0 + qa[g][0][1] * k1) + (qa[g][0][2] * k2 + qa[g][0][3] * k3) + (qa[g][1][0] * k4 + qa[g][1][1] * k5) + (qa[g][1][2] * k6 + qa[g][1][3] * k7); }
        }
#pragma unroll
        for (int i2 = 0; i2 < 4; ++i2) { const int j = lane + 64 * i2; int dist = t - id[i2]; dist = dist > 128 ? 128 : dist;
#pragma unroll
            for (int g = 0; g < 4; ++g) { const float l = lg[i2][g] * scale + btab[dist * 8 + 4 * c + g]; lg[i2][g] = (j < nsel) ? l : -INFINITY; } }
#pragma unroll
        for (int g = 0; g < 4; ++g) {
            const float mx = wave_max(fmaxf(fmaxf(lg[0][g], lg[1][g]), fmaxf(lg[2][g], lg[3][g])));
            float e0 = __expf(lg[0][g] - mx), e1 = __expf(lg[1][g] - mx), e2 = __expf(lg[2][g] - mx), e3 = __expf(lg[3][g] - mx);
            const float inv = 1.0f / wave_sum((e0 + e1) + (e2 + e3));
            lg[0][g] = e0 * inv; lg[1][g] = e1 * inv; lg[2][g] = e2 * inv; lg[3][g] = e3 * inv;
        }
#pragma unroll
        for (int i2 = 0; i2 < 4; ++i2) { const f32x4 pv = {lg[i2][0], lg[i2][1], lg[i2][2], lg[i2][3]}; pl[lane + 64 * i2] = pv; }
        LDS_WAIT(); asm volatile("" ::: "memory");
        float o[4][2];
#pragma unroll
        for (int g = 0; g < 4; ++g) { o[g][0] = 0.f; o[g][1] = 0.f; }
        const bf16* vbase = proj + O_V + (size_t)(b * 2 + c) * SEQ * 128 + 2 * lane;
        for (int j0 = 0; j0 < NSEL; j0 += 8) {
            const v4u iv = *(const LAS v4u*)(il + j0);
            const int ids[8] = {(int)(iv.x & 0xffffu), (int)(iv.x >> 16), (int)(iv.y & 0xffffu), (int)(iv.y >> 16), (int)(iv.z & 0xffffu), (int)(iv.z >> 16), (int)(iv.w & 0xffffu), (int)(iv.w >> 16)};
            unsigned vv[8];
#pragma unroll
            for (int q = 0; q < 8; ++q) vv[q] = *(const unsigned*)(vbase + (size_t)ids[q] * 128);
#pragma unroll
            for (int q = 0; q < 8; ++q) { const f32x4 pj = pl[j0 + q]; const float v0 = bflo(vv[q]), v1 = bfhi(vv[q]);
#pragma unroll
                for (int g = 0; g < 4; ++g) { o[g][0] += pj[g] * v0; o[g][1] += pj[g] * v1; } }
        }
#pragma unroll
        for (int g = 0; g < 4; ++g) *(unsigned*)(att + (size_t)m * 1024 + (4 * c + g) * 128 + 2 * lane) = cvt_pk_bf16(o[g][0], o[g][1]);
        LDS_WAIT(); asm volatile("" ::: "memory");
    }
}

template <int CTRL> __device__ __forceinline__ float dpp_max(float x) { return fmaxf(x, dpp_f<CTRL>(x)); }
__device__ __forceinline__ float max16(float x) { x = dpp_max<0xB1>(x); x = dpp_max<0x4E>(x); x = dpp_max<0x141>(x); x = dpp_max<0x140>(x); return x; }
__device__ __forceinline__ void attn_phase(const bf16* proj, const unsigned short* idx, const float* rel_bias, bf16* att, LAS unsigned char* lds, int tid, int lane, int wave, int G, unsigned* queue) {
    LAS float* btab = (LAS float*)(lds + BIAS_OFF);
    for (int i = tid; i < 129 * 8; i += 512) { const int d = i >> 3, hh = i & 7; const int bk = d < 113 ? (int)REL_BUCKET_TAB[d] : 31; btab[i] = rel_bias[bk * 8 + hh]; }
    __syncthreads();
    LAS unsigned char* base = lds + wave * 8192;
    LAS unsigned char* p8 = base;
    LAS unsigned short* il = (LAS unsigned short*)(base + 4352);
    const int gq = lane >> 4, dl = lane & 15;
    const float scale = 0.08838834764831845f * (1.0f / 64.0f);
    const bool xmode = (G % 64 == 0);
    const int xcd = blockIdx.x & 7;
    const int gw = blockIdx.x * 8 + wave, NGW = G * 8;
    unsigned zoff = 0u; asm volatile("" : "+v"(zoff));
    constexpr int QG = 4;
    const int qsub = (xcd & 1) * QG + ((blockIdx.x >> 3) & (QG - 1));
    unsigned* qw = queue + (xcd * QG + ((blockIdx.x >> 3) & (QG - 1))) * 32 + zoff;
    unsigned ticket = 0u;
    int it = 0, m = -1, c = 0;
    if (xmode) { if (lane == 0) ticket = __hip_atomic_fetch_add(qw, 1u, __ATOMIC_RELAXED, __HIP_MEMORY_SCOPE_AGENT);
        const int t_ = __builtin_amdgcn_readfirstlane((int)ticket); if (t_ < SEQ / (2 * QG)) { m = (xcd >> 2) * SEQ + 2 * QG * t_ + qsub; c = (xcd >> 1) & 1; }
        if (lane == 0) ticket = __hip_atomic_fetch_add(qw, 1u, __ATOMIC_RELAXED, __HIP_MEMORY_SCOPE_AGENT); }
    else { if (gw < 2 * T) { m = gw >> 1; c = gw & 1; } }
    v4u ix0 = {0u, 0u, 0u, 0u}, ix1 = ix0;
    if (m >= 0) { const GAS v4u* ip = (const GAS v4u*)((const GAS unsigned short*)idx + (size_t)m * NSEL + 16 * dl); ix0 = __builtin_nontemporal_load(ip); ix1 = __builtin_nontemporal_load(ip + 1); }
    while (m >= 0) {
        const int b = m >> 13, t = m & (SEQ - 1), nsel = (t + 1 < NSEL) ? t + 1 : NSEL;
        v4u qv[4];
        { const GAS bf16* qp = (const GAS bf16*)proj + O_Q + (size_t)m * 1024 + (4 * c + (dl & 3)) * 128 + 32 * gq;
#pragma unroll
          for (int ks = 0; ks < 4; ++ks) qv[ks] = __builtin_nontemporal_load((const GAS v4u*)(qp + 8 * ks)); }
        int ids[16];
        { const unsigned wv_[8] = {ix0.x, ix0.y, ix0.z, ix0.w, ix1.x, ix1.y, ix1.z, ix1.w};
#pragma unroll
          for (int q = 0; q < 8; ++q) { ids[2 * q] = (16 * dl + 2 * q < nsel) ? (int)(wv_[q] & 0xffffu) : 0; ids[2 * q + 1] = (16 * dl + 2 * q + 1 < nsel) ? (int)(wv_[q] >> 16) : 0; } }
        const GAS unsigned char* kbase = (const GAS unsigned char*)proj + O_K * 2 + (size_t)(b * 2 + c) * SEQ * 128 + 32 * gq;
        v4u kb[16][2];
#pragma unroll
        for (int q = 0; q < 16; ++q) { const GAS v4u* kp = (const GAS v4u*)(kbase + (size_t)ids[q] * 128); kb[q][0] = kp[0]; kb[q][1] = kp[1]; }
        if (gq == 0) { v4u o0, o1;
            o0.x = (unsigned)ids[0] | ((unsigned)ids[1] << 16); o0.y = (unsigned)ids[2] | ((unsigned)ids[3] << 16); o0.z = (unsigned)ids[4] | ((unsigned)ids[5] << 16); o0.w = (unsigned)ids[6] | ((unsigned)ids[7] << 16);
            o1.x = (unsigned)ids[8] | ((unsigned)ids[9] << 16); o1.y = (unsigned)ids[10] | ((unsigned)ids[11] << 16); o1.z = (unsigned)ids[12] | ((unsigned)ids[13] << 16); o1.w = (unsigned)ids[14] | ((unsigned)ids[15] << 16);
            *(LAS v4u*)(il + 16 * dl) = o0; *(LAS v4u*)(il + 16 * dl + 8) = o1; }
        __builtin_amdgcn_sched_barrier(0);
        long qa[4];
#pragma unroll
        for (int ks = 0; ks < 4; ++ks) { const v4u v = qv[ks];
            const unsigned lo8 = pg8::pk_fp8x4(bflo(v.x) * 8.0f, bfhi(v.x) * 8.0f, bflo(v.y) * 8.0f, bfhi(v.y) * 8.0f), hi8 = pg8::pk_fp8x4(bflo(v.z) * 8.0f, bfhi(v.z) * 8.0f, bflo(v.w) * 8.0f, bfhi(v.w) * 8.0f);
            qa[ks] = (dl < 4) ? (long)(((unsigned long long)hi8 << 32) | lo8) : 0l; }
        f32x4 lg[16];
#pragma unroll
        for (int q = 0; q < 8; ++q) { f32x4 acc = {0.f, 0.f, 0.f, 0.f};
            const long k0 = (long)(((unsigned long long)kb[q][0].y << 32) | kb[q][0].x), k1 = (long)(((unsigned long long)kb[q][0].w << 32) | kb[q][0].z), k2 = (long)(((unsigned long long)kb[q][1].y << 32) | kb[q][1].x), k3 = (long)(((unsigned long long)kb[q][1].w << 32) | kb[q][1].z);
            acc = __builtin_amdgcn_mfma_f32_16x16x32_fp8_fp8(qa[0], k0, acc, 0, 0, 0); acc = __builtin_amdgcn_mfma_f32_16x16x32_fp8_fp8(qa[1], k1, acc, 0, 0, 0);
            acc = __builtin_amdgcn_mfma_f32_16x16x32_fp8_fp8(qa[2], k2, acc, 0, 0, 0); acc = __builtin_amdgcn_mfma_f32_16x16x32_fp8_fp8(qa[3], k3, acc, 0, 0, 0);
            lg[q] = acc; }
        __builtin_amdgcn_sched_barrier(0);
#pragma unroll
        for (int q = 8; q < 16; ++q) { f32x4 acc = {0.f, 0.f, 0.f, 0.f};
            const long k0 = (long)(((unsigned long long)kb[q][0].y << 32) | kb[q][0].x), k1 = (long)(((unsigned long long)kb[q][0].w << 32) | kb[q][0].z), k2 = (long)(((unsigned long long)kb[q][1].y << 32) | kb[q][1].x), k3 = (long)(((unsigned long long)kb[q][1].w << 32) | kb[q][1].z);
            acc = __builtin_amdgcn_mfma_f32_16x16x32_fp8_fp8(qa[0], k0, acc, 0, 0, 0); acc = __builtin_amdgcn_mfma_f32_16x16x32_fp8_fp8(qa[1], k1, acc, 0, 0, 0);
            acc = __builtin_amdgcn_mfma_f32_16x16x32_fp8_fp8(qa[2], k2, acc, 0, 0, 0); acc = __builtin_amdgcn_mfma_f32_16x16x32_fp8_fp8(qa[3], k3, acc, 0, 0, 0);
            lg[q] = acc; }
        __builtin_amdgcn_sched_barrier(0);
        LDS_WAIT(); asm volatile("" ::: "memory");
        const GAS unsigned char* vbase = (const GAS unsigned char*)proj + O_V * 2 + (size_t)(b * 2 + c) * SEQ * 128 + 8 * dl;
        v2u va[32], vb[32];
        { v4u iq[4];
#pragma unroll
          for (int k = 0; k < 4; ++k) iq[k] = *(const LAS v4u*)(il + 32 * k + 8 * gq);
#pragma unroll
          for (int q = 0; q < 32; ++q) { const unsigned wd = ((q >> 1) & 3) == 0 ? iq[q >> 3].x : ((q >> 1) & 3) == 1 ? iq[q >> 3].y : ((q >> 1) & 3) == 2 ? iq[q >> 3].z : iq[q >> 3].w;
              const unsigned w = (q & 1) ? (wd >> 16) : (wd & 0xffffu);
              va[q] = *(const GAS v2u*)(vbase + (size_t)w * 128); } }
        __builtin_amdgcn_sched_barrier(0);
        float mx[4] = {-INFINITY, -INFINITY, -INFINITY, -INFINITY};
#pragma unroll
        for (int tau = 0; tau < 16; ++tau) { int dist = t - ids[tau]; dist = dist > 128 ? 128 : dist; const bool ok = (16 * dl + tau) < nsel;
            const f32x4 bv = *(const LAS f32x4*)(btab + dist * 8 + 4 * c);
#pragma unroll
            for (int g = 0; g < 4; ++g) { const float l = ok ? (lg[tau][g] * scale + bv[g]) : -INFINITY; lg[tau][g] = l; mx[g] = fmaxf(mx[g], l); } }
        float sm[4];
#pragma unroll
        for (int g = 0; g < 4; ++g) { mx[g] = max16(mx[g]); sm[g] = 0.f; }
#pragma unroll
        for (int tau = 0; tau < 16; ++tau)
#pragma unroll
            for (int g = 0; g < 4; ++g) { const float e = __expf(lg[tau][g] - mx[g] + 5.545177444f); lg[tau][g] = e; sm[g] += e; }
#pragma unroll
        for (int g = 0; g < 4; ++g) sm[g] = 0.125f / sum16(sm[g]);
        if (gq == 0) {
#pragma unroll
            for (int g = 0; g < 4; ++g) { v4u hi4, lo4;
#pragma unroll
                for (int w = 0; w < 4; ++w) { const float e0 = lg[4 * w][g], e1 = lg[4 * w + 1][g], e2 = lg[4 * w + 2][g], e3 = lg[4 * w + 3][g];
                    const unsigned h = pg8::pk_fp8x4(e0, e1, e2, e3);
                    const f32x2 b01 = __builtin_amdgcn_cvt_pk_f32_fp8((int)h, false), b23 = __builtin_amdgcn_cvt_pk_f32_fp8((int)h, true);
                    const unsigned lw = pg8::pk_fp8x4(e0 - b01[0], e1 - b01[1], e2 - b23[0], e3 - b23[1]);
                    if (w == 0) { hi4.x = h; lo4.x = lw; } else if (w == 1) { hi4.y = h; lo4.y = lw; } else if (w == 2) { hi4.z = h; lo4.z = lw; } else { hi4.w = h; lo4.w = lw; } }
                *(LAS v4u*)(p8 + g * 272 + 16 * dl) = hi4; *(LAS v4u*)(p8 + 1088 + g * 272 + 16 * dl) = lo4; }
        }
        __builtin_amdgcn_sched_barrier(0);
        const int m_cur = m, c_cur = c;
        { int mn = -1, cn = 0; ++it;
          if (xmode) { const int t_ = __builtin_amdgcn_readfirstlane((int)ticket); if (t_ < SEQ / (2 * QG)) { mn = (xcd >> 2) * SEQ + 2 * QG * t_ + qsub; cn = (xcd >> 1) & 1; } }
          else { const int item = gw + it * NGW; if (item < 2 * T) { mn = item >> 1; cn = item & 1; } }
          m = mn; c = cn;
          if (m >= 0) { const GAS v4u* ip = (const GAS v4u*)((const GAS unsigned short*)idx + (size_t)m * NSEL + 16 * dl); ix0 = __builtin_nontemporal_load(ip); ix1 = __builtin_nontemporal_load(ip + 1); } }
        { v4u iq[4];
#pragma unroll
          for (int k = 0; k < 4; ++k) iq[k] = *(const LAS v4u*)(il + 128 + 32 * k + 8 * gq);
#pragma unroll
          for (int q = 0; q < 32; ++q) { const unsigned wd = ((q >> 1) & 3) == 0 ? iq[q >> 3].x : ((q >> 1) & 3) == 1 ? iq[q >> 3].y : ((q >> 1) & 3) == 2 ? iq[q >> 3].z : iq[q >> 3].w;
              const unsigned w = (q & 1) ? (wd >> 16) : (wd & 0xffffu);
              vb[q] = *(const GAS v2u*)(vbase + (size_t)w * 128); } }
        if (xmode && m >= 0 && lane == 0) ticket = __hip_atomic_fetch_add(qw, 1u, __ATOMIC_RELAXED, __HIP_MEMORY_SCOPE_AGENT);
        LDS_WAIT(); asm volatile("" ::: "memory");
        __builtin_amdgcn_sched_barrier(0);
        f32x4 acc[8];
#pragma unroll
        for (int ch = 0; ch < 8; ++ch) acc[ch] = (f32x4){0.f, 0.f, 0.f, 0.f};
        const LAS unsigned char* pa = p8 + (dl & 3) * 272 + 8 * gq;
#define PERM_(hi_, lo_, sel_) __builtin_amdgcn_perm((hi_), (lo_), (sel_))
#define PVBLK_(R, blk) do { \
            const long ahi = *(const LAS long*)(pa + 32 * (blk)), alo = *(const LAS long*)(pa + 1088 + 32 * (blk)); \
            _Pragma("unroll") for (int hf = 0; hf < 2; ++hf) { \
                const unsigned r0 = hf ? R[0].y : R[0].x, r1 = hf ? R[1].y : R[1].x, r2 = hf ? R[2].y : R[2].x, r3 = hf ? R[3].y : R[3].x, r4 = hf ? R[4].y : R[4].x, r5 = hf ? R[5].y : R[5].x, r6 = hf ? R[6].y : R[6].x, r7 = hf ? R[7].y : R[7].x; \
                const unsigned a0 = PERM_(r1, r0, 0x05010400u), a1 = PERM_(r1, r0, 0x07030602u), b0 = PERM_(r3, r2, 0x05010400u), b1 = PERM_(r3, r2, 0x07030602u); \
                const unsigned c0 = PERM_(r5, r4, 0x05010400u), c1 = PERM_(r5, r4, 0x07030602u), d0 = PERM_(r7, r6, 0x05010400u), d1 = PERM_(r7, r6, 0x07030602u); \
                const unsigned t0 = PERM_(b0, a0, 0x05040100u), t1 = PERM_(b0, a0, 0x07060302u), t2 = PERM_(b1, a1, 0x05040100u), t3 = PERM_(b1, a1, 0x07060302u); \
                const unsigned u0 = PERM_(d0, c0, 0x05040100u), u1 = PERM_(d0, c0, 0x07060302u), u2 = PERM_(d1, c1, 0x05040100u), u3 = PERM_(d1, c1, 0x07060302u); \
                const long bq0 = (long)(((unsigned long long)u0 << 32) | t0), bq1 = (long)(((unsigned long long)u1 << 32) | t1), bq2 = (long)(((unsigned long long)u2 << 32) | t2), bq3 = (long)(((unsigned long long)u3 << 32) | t3); \
                acc[4 * hf + 0] = __builtin_amdgcn_mfma_f32_16x16x32_fp8_fp8(ahi, bq0, acc[4 * hf + 0], 0, 0, 0); acc[4 * hf + 1] = __builtin_amdgcn_mfma_f32_16x16x32_fp8_fp8(ahi, bq1, acc[4 * hf + 1], 0, 0, 0); \
                acc[4 * hf + 2] = __builtin_amdgcn_mfma_f32_16x16x32_fp8_fp8(ahi, bq2, acc[4 * hf + 2], 0, 0, 0); acc[4 * hf + 3] = __builtin_amdgcn_mfma_f32_16x16x32_fp8_fp8(ahi, bq3, acc[4 * hf + 3], 0, 0, 0); \
                acc[4 * hf + 0] = __builtin_amdgcn_mfma_f32_16x16x32_fp8_fp8(alo, bq0, acc[4 * hf + 0], 0, 0, 0); acc[4 * hf + 1] = __builtin_amdgcn_mfma_f32_16x16x32_fp8_fp8(alo, bq1, acc[4 * hf + 1], 0, 0, 0); \
                acc[4 * hf + 2] = __builtin_amdgcn_mfma_f32_16x16x32_fp8_fp8(alo, bq2, acc[4 * hf + 2], 0, 0, 0); acc[4 * hf + 3] = __builtin_amdgcn_mfma_f32_16x16x32_fp8_fp8(alo, bq3, acc[4 * hf + 3], 0, 0, 0); } } while (0)
#pragma unroll
        for (int k = 0; k < 4; ++k) { const v2u* R = va + 8 * k; PVBLK_(R, k); }
        __builtin_amdgcn_sched_barrier(0);
#pragma unroll
        for (int k = 0; k < 4; ++k) { const v2u* R = vb + 8 * k; PVBLK_(R, 4 + k); }
#undef PVBLK_
#undef PERM_
        if (gq == 0) {
#pragma unroll
            for (int g = 0; g < 4; ++g) { const float sg = sm[g] * 8.0f; v2u w;
                w.x = pg8::pk_fp8x4(acc[0][g] * sg, acc[1][g] * sg, acc[2][g] * sg, acc[3][g] * sg); w.y = pg8::pk_fp8x4(acc[4][g] * sg, acc[5][g] * sg, acc[6][g] * sg, acc[7][g] * sg);
                __builtin_nontemporal_store(w, (GAS v2u*)((GAS unsigned char*)att + (size_t)m_cur * 1024 + (4 * c_cur + g) * 128 + 8 * dl)); }
        }
        LDS_WAIT(); asm volatile("" ::: "memory");
        __builtin_amdgcn_sched_barrier(0);
    }
}

constexpr int SCH = 64, SCH_BYTES = SCH * SREC;
__device__ __forceinline__ void scan_phase(const unsigned char* scanin, float* ys, LAS unsigned char* lds, int tid, int lane, int wave, int G, int nunits) {
    for (int u = blockIdx.x; u < nunits; u += G) {
        const int bh = u >> 2, qtr = u & 3, b = bh >> 4, h = bh & 15;
        const unsigned char* src = scanin + (size_t)bh * SEQ * SREC;
        const int row = qtr * 16 + wave * 4 + (lane >> 4), k4 = (lane & 15) * 4;
        float S0 = 0.f, S1 = 0.f, S2 = 0.f, S3 = 0.f;
        v4u pre[7];
#pragma unroll
        for (int i = 0; i < 7; ++i) pre[i] = *(const v4u*)(src + (size_t)(i * 512 + tid) * 16);
#pragma unroll
        for (int i = 0; i < 7; ++i) *(LAS v4u*)(lds + (size_t)(i * 512 + tid) * 16) = pre[i];
        __syncthreads();
        for (int ck = 0; ck < SEQ / SCH; ++ck) {
            const LAS unsigned char* buf = lds + (ck & 1) * SCH_BYTES;
            if (ck + 1 < SEQ / SCH) {
#pragma unroll
                for (int i = 0; i < 7; ++i) pre[i] = *(const v4u*)(src + (size_t)(ck + 1) * SCH_BYTES + (size_t)(i * 512 + tid) * 16);
            }
            if (wave < 4) {
                float* yo = ys + ((size_t)(b * SEQ + ck * SCH)) * 1024 + h * 64 + row;
                for (int t = 0; t < SCH; ++t) {
                    const LAS unsigned char* sb = buf + t * SREC;
                    const f32x4 w = *(const LAS f32x4*)(sb + k4 * 4);
                    const v2u r2 = *(const LAS v2u*)(sb + 256 + k4 * 2), kt2 = *(const LAS v2u*)(sb + 384 + k4 * 2), kk2 = *(const LAS v2u*)(sb + 640 + k4 * 2), bb2 = *(const LAS v2u*)(sb + 768 + k4 * 2);
                    const float v = bf2f(*(const LAS unsigned short*)(sb + 512 + row * 2));
                    const float p = (S0 * bflo(kk2.x) + S1 * bfhi(kk2.x)) + (S2 * bflo(kk2.y) + S3 * bfhi(kk2.y));
                    const float sk = sum16(p);
                    S0 = S0 * w[0] + (v * bflo(kt2.x) - sk * bflo(bb2.x));
                    S1 = S1 * w[1] + (v * bfhi(kt2.x) - sk * bfhi(bb2.x));
                    S2 = S2 * w[2] + (v * bflo(kt2.y) - sk * bflo(bb2.y));
                    S3 = S3 * w[3] + (v * bfhi(kt2.y) - sk * bfhi(bb2.y));
                    const float yq = (S0 * bflo(r2.x) + S1 * bfhi(r2.x)) + (S2 * bflo(r2.y) + S3 * bfhi(r2.y));
                    const float y = sum16(yq);
                    if ((lane & 15) == 0) yo[(size_t)t * 1024] = y;
                }
            }
            if (ck + 1 < SEQ / SCH) {
                LAS unsigned char* nb = lds + ((ck + 1) & 1) * SCH_BYTES;
#pragma unroll
                for (int i = 0; i < 7; ++i) *(LAS v4u*)(nb + (size_t)(i * 512 + tid) * 16) = pre[i];
            }
            __syncthreads();
        }
    }
}

#ifndef PROBE_REPEAT
#define PROBE_REPEAT 0u
#endif
#define SREP(k) for (int rep_ = 0; rep_ < 1 + (int)(((PROBE_REPEAT) >> (k)) & 1u); ++rep_)
constexpr int CB_BYTES = 49152;
constexpr int MP = 144;
__device__ __forceinline__ int kperm(int k) { return (k & ~15) + 8 * ((k >> 2) & 1) + 4 * ((k >> 3) & 1) + (k & 3); }
__device__ __forceinline__ f32x16 mfma4(const LAS unsigned char* A, const LAS unsigned char* B, int lane, f32x16 acc) {
    const int off = (lane & 31) * MP + (lane >> 5) * 16;
#pragma unroll
    for (int ks = 0; ks < 4; ++ks) acc = __builtin_amdgcn_mfma_f32_32x32x16_bf16(*(const LAS bf16x8*)(A + off + ks * 32), *(const LAS bf16x8*)(B + off + ks * 32), acc, 0, 0, 0);
    return acc;
}
__device__ __forceinline__ void nfma(float& s, float a, float b) { asm volatile("v_fma_f32 %0, -%1, %2, %0" : "+v"(s) : "v"(a), "v"(b)); }
struct RwkvPar { const float* mu; const float* w0; const float* a0; const float* k_k; const float* k_a; };
__device__ __forceinline__ void scan_a_phase(const bf16* proj_, const bf16* lr_, const RwkvPar par, unsigned char* rkv, unsigned char* chk, LAS unsigned char* lds_in, int tid, int lane, int wave, int G) {
    const GAS bf16* proj = (const GAS bf16*)proj_; const GAS bf16* lr = (const GAS bf16*)lr_;
    const int hi = lane >> 5, r32 = lane & 31;
    for (int u = blockIdx.x; u < 32 * 128; u += G) {
        LAS unsigned char* lds_u = lds_in; asm volatile("" : "+s"(lds_u));
        LAS unsigned char* const lds = lds_u;
        LAS unsigned char* GB = lds;
        LAS unsigned char* KH = lds + 18432; LAS unsigned char* RH = KH + 9216; LAS unsigned char* BH = RH + 9216; LAS unsigned char* KHAT = BH + 9216;
        LAS unsigned char* NBT = KHAT + 9216; LAS unsigned char* KTT = NBT + 9216; LAS unsigned char* VT = KTT + 9216;
        LAS unsigned char* LS = lds + 82944;
        LAS unsigned char* DIAG = LS + 9216; LAS unsigned char* DINV = LS + 13312;
        LAS unsigned char* AKK = LS + 17408; LAS unsigned char* NABR = AKK + 9216; LAS unsigned char* AKR = NABR + 9216;
        LAS float* GC = (LAS float*)(lds + 128000);
        LAS float* WTOT = (LAS float*)(lds + 128256);
        const int bh = u >> 7, ck = u & 127;
        unsigned char* ob = chk + (size_t)u * CB_BYTES;
        SREP(25) {
            const int t = tid >> 3, k8 = (tid & 7) * 8;
            const int bq = bh >> 4, hq = bh & 15, tpos = ck * 64 + t, m = bq * SEQ + tpos, c = hq * 64 + k8;
            float w[8], r[8], kt[8], kk[8], bb[8]; unsigned short vraw[8];
            {
                const GAS bf16* pc = proj + O_SL + (size_t)m * SLAB_W + c;
                float rc[8], kc[8], vc[8], rp[8], kp[8], vp[8], dp[8], ap[8], pr[8];
                const v4u q_rc = *(const GAS v4u*)(pc + S_R), q_kc = *(const GAS v4u*)(pc + S_K), q_vc = *(const GAS v4u*)(pc + S_V);
                const bool hasp = tpos > 0; const GAS bf16* pp = hasp ? pc - SLAB_W : pc;
                const v4u q_rp = *(const GAS v4u*)(pp + S_R), q_kp = *(const GAS v4u*)(pp + S_K), q_vp = *(const GAS v4u*)(pp + S_V);
                const v4u q_dp = *(const GAS v4u*)(lr + (size_t)m * LRN + c), q_ap = *(const GAS v4u*)(lr + (size_t)m * LRN + 1024 + c);
                f32x4 pq[7][2];
                { const float* ps[3] = {par.mu + S_R + c, par.mu + S_K + c, par.mu + S_V + c};
#pragma unroll
                  for (int i = 0; i < 3; ++i) { pq[i][0] = *(const f32x4*)ps[i]; pq[i][1] = *(const f32x4*)(ps[i] + 4); } }
                __builtin_amdgcn_sched_barrier(0);
                unpack8(q_rc, rc); unpack8(q_kc, kc); unpack8(q_vc, vc);
                if (hasp) { unpack8(q_rp, rp); unpack8(q_kp, kp); unpack8(q_vp, vp); }
                else {
#pragma unroll
                    for (int j = 0; j < 8; ++j) { rp[j] = 0.f; kp[j] = 0.f; vp[j] = 0.f; } }
                unpack8(q_dp, dp); unpack8(q_ap, ap);
                float kx[8], av[8], vx[8]; float ss = 0.f;
#define PQ_(i) do { pr[0] = pq[i][0][0]; pr[1] = pq[i][0][1]; pr[2] = pq[i][0][2]; pr[3] = pq[i][0][3]; pr[4] = pq[i][1][0]; pr[5] = pq[i][1][1]; pr[6] = pq[i][1][2]; pr[7] = pq[i][1][3]; } while (0)
                PQ_(0);
#pragma unroll
                for (int j = 0; j < 8; ++j) r[j] = rc[j] + (rp[j] - rc[j]) * pr[j];
                PQ_(1);
#pragma unroll
                for (int j = 0; j < 8; ++j) kx[j] = kc[j] + (kp[j] - kc[j]) * pr[j];
                PQ_(2);
#pragma unroll
                for (int j = 0; j < 8; ++j) vx[j] = vc[j] + (vp[j] - vc[j]) * pr[j];
                __builtin_amdgcn_sched_barrier(0);
                { const float* ps[4] = {par.w0 + c, par.a0 + c, par.k_k + c, par.k_a + c};
#pragma unroll
                  for (int i = 0; i < 4; ++i) { pq[3 + i][0] = *(const f32x4*)ps[i]; pq[3 + i][1] = *(const f32x4*)(ps[i] + 4); } }
                __builtin_amdgcn_sched_barrier(0);
                PQ_(3);
#pragma unroll
                for (int j = 0; j < 8; ++j) w[j] = __expf(-0.6065306597126334f * sigm(pr[j] + dp[j]));
                PQ_(4);
#pragma unroll
                for (int j = 0; j < 8; ++j) av[j] = sigm(pr[j] + ap[j]);
                PQ_(5);
#pragma unroll
                for (int j = 0; j < 8; ++j) { kk[j] = kx[j] * pr[j]; ss += kk[j] * kk[j]; }
                PQ_(6);
#pragma unroll
                for (int j = 0; j < 8; ++j) kt[j] = kx[j] * (1.0f + (av[j] - 1.0f) * pr[j]);
#undef PQ_
                const float rn = rsqrtf(fmaxf(sum8(ss), 1e-24f));
#pragma unroll
                for (int j = 0; j < 8; ++j) { kk[j] *= rn; bb[j] = kk[j] * av[j]; }
                const v4u r4 = pack8(r), kt4 = pack8(kt), v4 = pack8(vx), kk4 = pack8(kk), bb4 = pack8(bb);
                unsigned char* rec = rkv + ((size_t)bh * SEQ + tpos) * 384;
                *(v4u*)(rec + k8 * 2) = r4; *(v4u*)(rec + 128 + k8 * 2) = kt4; *(v4u*)(rec + 256 + k8 * 2) = v4;
                unpack8(r4, r); unpack8(kt4, kt); unpack8(kk4, kk); unpack8(bb4, bb);
                vraw[0] = (unsigned short)(v4.x & 0xffffu); vraw[1] = (unsigned short)(v4.x >> 16); vraw[2] = (unsigned short)(v4.y & 0xffffu); vraw[3] = (unsigned short)(v4.y >> 16);
                vraw[4] = (unsigned short)(v4.z & 0xffffu); vraw[5] = (unsigned short)(v4.z >> 16); vraw[6] = (unsigned short)(v4.w & 0xffffu); vraw[7] = (unsigned short)(v4.w >> 16);
            }
            float g[8];
#pragma unroll
            for (int j = 0; j < 8; ++j) g[j] = w[j];
#pragma unroll
            for (int o = 8; o < 64; o <<= 1) {
#pragma unroll
                for (int j = 0; j < 8; ++j) { const float up = __shfl_up(g[j], o); if (lane >= o) g[j] *= up; }
            }
            if ((lane >> 3) == 7) {
#pragma unroll
                for (int j = 0; j < 8; ++j) WTOT[wave * 64 + k8 + j] = g[j];
            }
            __syncthreads();
            for (int ww = 0; ww < wave; ++ww) {
#pragma unroll
                for (int j = 0; j < 8; ++j) g[j] *= WTOT[ww * 64 + k8 + j];
            }
            if (t == 63) {
#pragma unroll
                for (int j = 0; j < 8; ++j) GC[k8 + j] = g[j];
            }
            __syncthreads();
            float kh[8], rh[8], bh_[8], kha[8];
#pragma unroll
            for (int j = 0; j < 8; ++j) { const float ig = 1.0f / g[j], gc = GC[k8 + j];
                kh[j] = (g[j] / w[j]) * kk[j]; rh[j] = g[j] * r[j]; bh_[j] = bb[j] * ig; kha[j] = kt[j] * ig;
                *(LAS unsigned short*)(NBT + (k8 + j) * MP + t * 2) = f2bf(-(bh_[j] * gc));
                *(LAS unsigned short*)(KTT + (k8 + j) * MP + t * 2) = f2bf(kha[j] * gc);
                *(LAS unsigned short*)(VT + (k8 + j) * MP + t * 2) = vraw[j]; }
            v4u o;
            o.x = cvt_pk_bf16(kh[0], kh[1]); o.y = cvt_pk_bf16(kh[2], kh[3]); o.z = cvt_pk_bf16(kh[4], kh[5]); o.w = cvt_pk_bf16(kh[6], kh[7]); *(LAS v4u*)(KH + t * MP + k8 * 2) = o;
            o.x = cvt_pk_bf16(rh[0], rh[1]); o.y = cvt_pk_bf16(rh[2], rh[3]); o.z = cvt_pk_bf16(rh[4], rh[5]); o.w = cvt_pk_bf16(rh[6], rh[7]); *(LAS v4u*)(RH + t * MP + k8 * 2) = o;
            o.x = cvt_pk_bf16(bh_[0], bh_[1]); o.y = cvt_pk_bf16(bh_[2], bh_[3]); o.z = cvt_pk_bf16(bh_[4], bh_[5]); o.w = cvt_pk_bf16(bh_[6], bh_[7]); *(LAS v4u*)(BH + t * MP + k8 * 2) = o;
            o.x = cvt_pk_bf16(kha[0], kha[1]); o.y = cvt_pk_bf16(kha[2], kha[3]); o.z = cvt_pk_bf16(kha[4], kha[5]); o.w = cvt_pk_bf16(kha[6], kha[7]); *(LAS v4u*)(KHAT + t * MP + k8 * 2) = o;
        }
        __syncthreads();
        {
            const int tr = wave >> 1; const LAS unsigned char* Am = (tr < 2 ? KH : RH) + 32 * (tr & 1) * MP;
#pragma unroll
            for (int q = 0; q < 2; ++q) {
                const int tc = 2 * (wave & 1) + q; const LAS unsigned char* Bm = (tc < 2 ? BH : KHAT) + 32 * (tc & 1) * MP;
                f32x16 acc = {0.f, 0.f, 0.f, 0.f, 0.f, 0.f, 0.f, 0.f, 0.f, 0.f, 0.f, 0.f, 0.f, 0.f, 0.f, 0.f};
                acc = mfma4(Am, Bm, lane, acc);
                const int i = 32 * (tc & 1) + r32;
#pragma unroll
                for (int reg = 0; reg < 16; ++reg) { const int t = 32 * (tr & 1) + (reg & 3) + 8 * (reg >> 2) + 4 * hi; const float v = acc[reg];
                    if (tr < 2) { if (tc < 2) { const float lv = (i < t) ? v : 0.f; *(LAS unsigned short*)(LS + t * MP + i * 2) = f2bf(-lv); if ((t >> 4) == (i >> 4)) *(LAS float*)(DIAG + ((t >> 4) * 256 + (t & 15) * 16 + (i & 15)) * 4) = lv; } else *(LAS unsigned short*)(AKK + t * MP + i * 2) = f2bf((i < t) ? v : 0.f); }
                    else { if (tc < 2) *(LAS unsigned short*)(NABR + t * MP + i * 2) = f2bf((i <= t) ? -v : 0.f); else *(LAS unsigned short*)(AKR + t * MP + i * 2) = f2bf((i <= t) ? v : 0.f); } }
            }
        }
        __syncthreads();
        if (wave < 4) {
            const int rt = wave >> 1, ct = wave & 1;
            f32x16 acc = {0.f, 0.f, 0.f, 0.f, 0.f, 0.f, 0.f, 0.f, 0.f, 0.f, 0.f, 0.f, 0.f, 0.f, 0.f, 0.f};
            acc = mfma4(AKK + 32 * rt * MP, VT + 32 * ct * MP, lane, acc);
#pragma unroll
            for (int reg = 0; reg < 16; ++reg) { const int t = 32 * rt + (reg & 3) + 8 * (reg >> 2) + 4 * hi; *(LAS float*)(GB + (t * 64 + 32 * ct + r32) * 4) = acc[reg]; }
        } else if (wave == 4) {
            const int b = lane >> 4, j = lane & 15;
            const LAS unsigned char* db = DIAG + b * 1024; asm volatile("" : "+v"(db));
            float z[16];
#pragma unroll
            for (int t = 0; t < 16; ++t) {
                float sacc = (t == j) ? 1.0f : 0.0f;
                f32x4 l[4];
#pragma unroll
                for (int i4 = 0; i4 < (t + 3) / 4; ++i4) l[i4] = *(const LAS f32x4*)(db + t * 64 + i4 * 16);
#pragma unroll
                for (int i = 0; i < t; ++i) nfma(sacc, l[i >> 2][i & 3], z[i]);
                z[t] = sacc;
            }
            { LAS unsigned char* dw = DINV + b * 512 + j * 2; asm volatile("" : "+v"(dw));
#pragma unroll
              for (int t = 0; t < 16; ++t) *(LAS unsigned short*)(dw + t * 32) = f2bf(z[t]); }
        }
        __syncthreads();
        {
            const int c = 16 * wave + (lane & 15), g = lane >> 4, tl = lane & 15;
            const LAS unsigned char* rbase = (wave < 4) ? (const LAS unsigned char*)(KH + 4 * g * MP + c * 2) : (const LAS unsigned char*)(GB + (4 * g * 64 + (c - 64)) * 4); asm volatile("" : "+v"(rbase));
            const LAS unsigned char* abase = LS + tl * MP + 8 * g; asm volatile("" : "+v"(abase));
            const LAS unsigned char* dbase = DINV + tl * 32 + g * 8; asm volatile("" : "+v"(dbase));
            LAS unsigned char* pbase = GB + c * MP + 8 * g; asm volatile("" : "+v"(pbase));
            float rv[4][4];
#pragma unroll
            for (int b = 0; b < 4; ++b)
#pragma unroll
                for (int r = 0; r < 4; ++r) rv[b][r] = (wave < 4) ? bf2f(*(const LAS unsigned short*)(rbase + (16 * b + r) * MP)) : *(const LAS float*)(rbase + (16 * b + r) * 256);
            asm volatile("s_waitcnt lgkmcnt(0)" ::: "memory");
            __syncthreads();
            typedef unsigned u32x2v __attribute__((ext_vector_type(2)));
            u32x2v xb[4];
            const pg8::u32x4 zero4 = {0u, 0u, 0u, 0u}; (void)zero4;
#pragma unroll
            for (int b = 0; b < 4; ++b) {
                f32x4 acc = {rv[b][0], rv[b][1], rv[b][2], rv[b][3]};
#pragma unroll
                for (int m = 0; m < b; m += 2) {
                    const u32x2v alo = *(const LAS u32x2v*)(abase + 16 * b * MP + 32 * m);
                    u32x2v ahi = {0u, 0u}, bhi = {0u, 0u};
                    if (m + 1 < b) { ahi = *(const LAS u32x2v*)(abase + 16 * b * MP + 32 * (m + 1)); bhi = xb[m + 1]; }
                    const pg8::u32x4 av = {alo.x, alo.y, ahi.x, ahi.y}, bv = {xb[m].x, xb[m].y, bhi.x, bhi.y};
                    acc = __builtin_amdgcn_mfma_f32_16x16x32_bf16(__builtin_bit_cast(bf16x8, av), __builtin_bit_cast(bf16x8, bv), acc, 0, 0, 0);
                }
                const u32x2v dlo = *(const LAS u32x2v*)(dbase + b * 512);
                const pg8::u32x4 av = {dlo.x, dlo.y, 0u, 0u}, bv = {cvt_pk_bf16(acc[0], acc[1]), cvt_pk_bf16(acc[2], acc[3]), 0u, 0u};
                f32x4 xz = {0.f, 0.f, 0.f, 0.f};
                xz = __builtin_amdgcn_mfma_f32_16x16x32_bf16(__builtin_bit_cast(bf16x8, av), __builtin_bit_cast(bf16x8, bv), xz, 0, 0, 0);
                xb[b] = (u32x2v){cvt_pk_bf16(xz[0], xz[1]), cvt_pk_bf16(xz[2], xz[3])};
                *(LAS u32x2v*)(pbase + 32 * b) = xb[b];
            }
        }
        __syncthreads();
        SREP(27) {
            const int tr = wave >> 1; const LAS unsigned char* A1 = (tr < 2 ? NABR : NBT) + 32 * (tr & 1) * MP; const LAS unsigned char* A2 = (tr < 2 ? AKR : KTT) + 32 * (tr & 1) * MP;
#pragma unroll
            for (int q = 0; q < 2; ++q) {
                const int tc = 2 * (wave & 1) + q;
                f32x16 acc = {0.f, 0.f, 0.f, 0.f, 0.f, 0.f, 0.f, 0.f, 0.f, 0.f, 0.f, 0.f, 0.f, 0.f, 0.f, 0.f};
                acc = mfma4(A1, GB + 32 * tc * MP, lane, acc);
                if (tc >= 2) {
                    acc = mfma4(A2, VT + 32 * (tc - 2) * MP, lane, acc);
                    unsigned char* dst = ob + (tr < 2 ? 32768 : 16384) + ((tr & 1) * 2 + (tc - 2)) * 4096 + lane * 16;
#pragma unroll
                    for (int q4 = 0; q4 < 4; ++q4) { const f32x4 v = {acc[4 * q4], acc[4 * q4 + 1], acc[4 * q4 + 2], acc[4 * q4 + 3]}; *(f32x4*)(dst + q4 * 1024) = v; }
                } else {
                    const int k = 32 * tc + r32; bf16* dst = (bf16*)(ob + (tr < 2 ? 8192 : 0)) + kperm(k);
#pragma unroll
                    for (int reg = 0; reg < 16; ++reg) { const int row = 32 * (tr & 1) + (reg & 3) + 8 * (reg >> 2) + 4 * hi;
                        float v = acc[reg];
                        if (tr < 2) v += bf2f(*(const LAS unsigned short*)(RH + row * MP + k * 2)); else v += (row == k) ? GC[k] : 0.f;
                        dst[row * 64] = f2bf(v); }
                }
            }
        }
        __syncthreads();
    }
}
constexpr int SB_BUF = 51200;
__device__ __forceinline__ f32x16 load_acc(const LAS unsigned char* p, int lane) {
    f32x16 a;
#pragma unroll
    for (int q4 = 0; q4 < 4; ++q4) { const f32x4 v = *(const LAS f32x4*)(p + q4 * 1024 + lane * 16); a[4 * q4] = v[0]; a[4 * q4 + 1] = v[1]; a[4 * q4 + 2] = v[2]; a[4 * q4 + 3] = v[3]; }
    return a;
}
__device__ __forceinline__ bf16x8 acc_to_frag(const f32x16& a, int s) {
    v4u o; o.x = cvt_pk_bf16(a[8 * s], a[8 * s + 1]); o.y = cvt_pk_bf16(a[8 * s + 2], a[8 * s + 3]); o.z = cvt_pk_bf16(a[8 * s + 4], a[8 * s + 5]); o.w = cvt_pk_bf16(a[8 * s + 6], a[8 * s + 7]);
    return __builtin_bit_cast(bf16x8, o);
}
__device__ __forceinline__ void scan_b_phase(const unsigned char* chk, float* ys, LAS unsigned char* lds, int tid, int lane, int wave, int G) {
    const int hi = lane >> 5, r32 = lane & 31;
    const int prow = tid >> 3, pc16 = tid & 7;
    for (int u = blockIdx.x; u < 32; u += G) {
        const int b = u >> 4, h = u & 15;
        const unsigned char* src = chk + (size_t)u * 128 * CB_BYTES;
        f32x16 T0 = {0.f, 0.f, 0.f, 0.f, 0.f, 0.f, 0.f, 0.f, 0.f, 0.f, 0.f, 0.f, 0.f, 0.f, 0.f, 0.f}, T1 = T0;
        v4u pre[6], pre2[6];
#pragma unroll
        for (int i = 0; i < 6; ++i) pre[i] = *(const GAS v4u*)((const GAS unsigned char*)src + (size_t)(i * 512 + tid) * 16);
#pragma unroll
        for (int i = 0; i < 6; ++i) pre2[i] = *(const GAS v4u*)((const GAS unsigned char*)src + (size_t)CB_BYTES + (size_t)(i * 512 + tid) * 16);
        for (int cc = 0; cc < 128; ++cc) {
            { LAS unsigned char* nb = lds + (cc & 1) * SB_BUF;
              *(LAS v4u*)(nb + prow * MP + pc16 * 16) = pre[0]; *(LAS v4u*)(nb + 9216 + prow * MP + pc16 * 16) = pre[1];
#pragma unroll
              for (int i = 2; i < 6; ++i) *(LAS v4u*)(nb + 18432 + (size_t)((i - 2) * 512 + tid) * 16) = pre[i]; }
            __syncthreads();
#pragma unroll
            for (int i = 0; i < 6; ++i) pre[i] = pre2[i];
            if (cc + 2 < 128) {
#pragma unroll
                for (int i = 0; i < 6; ++i) pre2[i] = *(const GAS v4u*)((const GAS unsigned char*)src + (size_t)(cc + 2) * CB_BYTES + (size_t)(i * 512 + tid) * 16);
            }
            if (wave < 2) {
                const int ct = wave; const LAS unsigned char* buf = lds + (cc & 1) * SB_BUF;
                const bf16x8 tb0 = acc_to_frag(T0, 0), tb1 = acc_to_frag(T0, 1), tb2 = acc_to_frag(T1, 0), tb3 = acc_to_frag(T1, 1);
                f32x16 N0 = load_acc(buf + 18432 + (0 * 2 + ct) * 4096, lane), N1 = load_acc(buf + 18432 + (1 * 2 + ct) * 4096, lane);
                f32x16 Y0 = load_acc(buf + 34816 + (0 * 2 + ct) * 4096, lane), Y1 = load_acc(buf + 34816 + (1 * 2 + ct) * 4096, lane);
                const LAS unsigned char* g0 = buf + r32 * MP + hi * 16; const LAS unsigned char* q0 = buf + 9216 + r32 * MP + hi * 16;
#define SB_STEP(ks, tb) do { \
                N0 = __builtin_amdgcn_mfma_f32_32x32x16_bf16(*(const LAS bf16x8*)(g0 + (ks) * 32), tb, N0, 0, 0, 0); \
                N1 = __builtin_amdgcn_mfma_f32_32x32x16_bf16(*(const LAS bf16x8*)(g0 + 32 * MP + (ks) * 32), tb, N1, 0, 0, 0); \
                Y0 = __builtin_amdgcn_mfma_f32_32x32x16_bf16(*(const LAS bf16x8*)(q0 + (ks) * 32), tb, Y0, 0, 0, 0); \
                Y1 = __builtin_amdgcn_mfma_f32_32x32x16_bf16(*(const LAS bf16x8*)(q0 + 32 * MP + (ks) * 32), tb, Y1, 0, 0, 0); } while (0)
                SB_STEP(0, tb0); SB_STEP(1, tb1); SB_STEP(2, tb2); SB_STEP(3, tb3);
#undef SB_STEP
                T0 = N0; T1 = N1;
                float* yo = ys + ((size_t)(b * SEQ + cc * 64)) * 1024 + h * 64 + 32 * ct + r32;
#pragma unroll
                for (int reg = 0; reg < 16; ++reg) { const int t = (reg & 3) + 8 * (reg >> 2) + 4 * hi; yo[(size_t)t * 1024] = Y0[reg]; yo[(size_t)(t + 32) * 1024] = Y1[reg]; }
            }
        }
        __syncthreads();
    }
}

constexpr int NPL = 18, PH_FINAL = 1 + DEPTH * NPL, NPH = PH_FINAL + 1;
#ifndef SCAN_CHECK
#define SCAN_CHECK 0
#endif
#ifndef ATT_CHECK
#define ATT_CHECK 0
#endif
#ifndef SCAN_CHECK_TOL
#define SCAN_CHECK_TOL 1e-3f
#endif
#define PG8_SP2 true
#define PG8_ALIGN true
__global__ void __launch_bounds__(512, 2) trunk_fwd(Args args) {
    extern __shared__ __attribute__((aligned(16))) unsigned char lds_raw[];
    LAS unsigned char* lds = (LAS unsigned char*)lds_raw;
    const int G = gridDim.x;
    unsigned* ctl = (unsigned*)(args.ws + WS_CTL);
    volatile LAS unsigned* MISC = (volatile LAS unsigned*)(lds + MISC_OFF);
    LAS int* tab = (LAS int*)(lds + MISC_OFF + 64);
    for (int u = threadIdx.x; u < (LDS_BYTES - MISC_OFF) / 4; u += 512) ((LAS unsigned*)(lds + MISC_OFF))[u] = 0u;
    __syncthreads();
    const int lo = args.ph_lo, hi = args.ph_hi;
    const bool multi = (hi - lo) > 1;
    XcdBarrier bar; bar.bar = ctl + CW_BAR; bar.x = 0; bar.st = nullptr;
    if (multi) bar = xcd_barrier_post(ctl + CW_BAR, MISC);
#ifndef PHASE_MASK
#define PHASE_MASK 0xFFFFFFFFu
#endif
#define KIND_ON(kind) (((PHASE_MASK) >> (kind)) & 1u)
#ifndef PROBE_REPEAT
#define PROBE_REPEAT 0u
#endif
#define REP(kind) for (int rep_ = 0; rep_ < 1 + (int)(((PROBE_REPEAT) >> (kind)) & 1u); ++rep_)
#define IN(k) (lo <= (k) && (k) < hi)
#define SEAM(k) do { if ((k) + 1 < hi) xcd_barrier(bar); } while (0)

#define PH_LOCALS int tid = threadIdx.x; asm volatile("" : "+v"(tid)); const int lane = tid & 63, wave = __builtin_amdgcn_readfirstlane(tid >> 6); unsigned char* ws = args.ws; asm volatile("" : "+s"(ws)); (void)lane; (void)wave; \
    bf16* XN = (bf16*)(ws + WS_XN); bf16* PROJ = (bf16*)(ws + WS_PROJ); bf16* LRA = (bf16*)(ws + WS_LRA); bf16* LR = (bf16*)(ws + WS_LR); \
    unsigned char* SCANIN = ws + WS_SCANIN; float* YS = (float*)(ws + WS_YS); bf16* ATT = (bf16*)(ws + WS_ATT); bf16* RW = (bf16*)(ws + WS_RW); bf16* M1 = (bf16*)(ws + WS_M1); \
    unsigned short* IDX = (unsigned short*)(ws + WS_IDX); int* ROUTE = (int*)(ws + WS_ROUTE); \
    bf16* UD = (bf16*)(ws + WS_UD); bf16* XG = (bf16*)(ws + WS_XG); bf16* UM = (bf16*)(ws + WS_UM); bf16* YM = (bf16*)(ws + WS_YM); bf16* PP = (bf16*)(ws + WS_PP); \
    (void)XN; (void)PROJ; (void)LRA; (void)LR; (void)SCANIN; (void)YS; (void)ATT; (void)RW; (void)M1; (void)IDX; (void)ROUTE; (void)UD; (void)XG; (void)UM; (void)YM; (void)PP;
    float* H = args.out;

#if (PROBE_REPEAT >> 17) & 1
    if (IN(0)) { float x = (float)threadIdx.x; for (int i = 0; i < 25000; ++i) { asm volatile("v_fma_f32 %0, %0, %0, %0\n v_fma_f32 %0, %0, %0, %0\n v_fma_f32 %0, %0, %0, %0\n v_fma_f32 %0, %0, %0, %0" : "+v"(x)); } if (x == 12345.678f) args.out[0] = x; }
#endif
#if (PROBE_REPEAT >> 19) & 1
    if (IN(0)) { float x = (float)threadIdx.x; for (int i = 0; i < 25000; ++i) { asm volatile("v_cmp_le_f32 vcc, 1.0, %0\n v_cndmask_b32 %0, 0, %0, vcc\n v_cmp_le_f32 vcc, 2.0, %0\n v_cndmask_b32 %0, 0, %0, vcc" : "+v"(x) : : "vcc"); } if (x == 12345.678f) args.out[0] = x; }
#endif
#if (PROBE_REPEAT >> 18) & 1
    if (IN(0)) { unsigned c = 0; for (int i = 0; i < 25000; ++i) { unsigned long long m; asm volatile("v_cmp_le_f32_e64 %0, 0, %1\n s_bcnt1_i32_b64 s20, %0\n s_add_i32 %2, %2, s20\n v_cmp_le_f32_e64 %0, 1.0, %1\n s_bcnt1_i32_b64 s20, %0\n s_add_i32 %2, %2, s20" : "=&s"(m), "+v"(*(float*)&i), "+s"(c) : : "s20"); } if (c == 12345u) args.out[0] = 1.f; }
#endif
    if (KIND_ON(0) && IN(0)) { PH_LOCALS REP(0) { p0_prologue(args, lds, tid, lane, wave, G); __syncthreads(); }
        norm_phase<0>(args.in[I_X], nullptr, args.in[I_NMIX], XN, nullptr, nullptr, nullptr, nullptr, nullptr, lane, wave, G);
        SEAM(0); }

    for (int l = 0; l < DEPTH; ++l) {
        const int pb = 1 + l * NPL;
        const float* hin = (l == 0) ? args.in[I_X] : H;
        if (l > 0 && KIND_ON(1) && IN(pb + 0)) { PH_LOCALS norm_phase<0>(hin, nullptr, args.in[I_NMIX] + l * D, XN, nullptr, nullptr, nullptr, nullptr, nullptr, lane, wave, G); SEAM(pb + 0); }
        if (KIND_ON(2) && IN(pb + 1)) { PH_LOCALS
            pg8::Gemm g{XN, (const bf16*)(ws + WS_WIN) + (size_t)l * PW * D, T, PW, D}; pg8::StaticOrder S; S.init(T, PW, G, (int)blockIdx.x);
            pg8::EpiProj E{PROJ, T, SEQ};
            REP(23) { pg8::gemm_phase<pg8::EpiProj, pg8::StaticOrder, PG8_ALIGN, PG8_SP2>(lds, g, S, E); }
            if (KIND_ON(17)) {
                const int nun = (T / 256) * (PW / 256), rounds = (nun + G - 1) / G, nbusy = nun - (rounds - 1) * G, nidle = G - nbusy;
                const bool part = nidle >= 32;
                if (!part || (int)blockIdx.x >= nbusy) {
                    pg8::Gemm g2{(const bf16*)(ws + WS_PB) + (size_t)l * T * 256, (const bf16*)(ws + WS_PLEP) + (size_t)l * D * 256, T, D, 256};
                    pg8::StaticOrder S2; S2.init(T, D, part ? nidle : G, part ? (int)blockIdx.x - nbusy : (int)blockIdx.x);
                    pg8::EpiStoreBf16 E2{PP, D};
                    pg8::gemm_phase<pg8::EpiStoreBf16, pg8::StaticOrder, PG8_ALIGN, PG8_SP2>(lds, g2, S2, E2);
                }
            }
            SEAM(pb + 1);
        }
        if (KIND_ON(3) && IN(pb + 2)) { PH_LOCALS
            REP(3) { select_phase(PROJ, IDX, (unsigned short*)(ws + WS_CHK), lds, tid, lane, wave, G, ctl);
            rwkv_prep_a(PROJ, args.in[I_MU] + l * SLAB_W, LRA, tid, G); }
            SEAM(pb + 2);
        }
        if (KIND_ON(4) && IN(pb + 3)) { PH_LOCALS
            pg8::Gemm g{LRA, (const bf16*)(ws + WS_LRT + (size_t)l * LRT_BYTES), T, LRN, LRK}; pg8::StaticOrder S; S.init(T, LRN, G, (int)blockIdx.x);
            pg8::EpiStoreBf16 E{LR, LRN};
            pg8::gemm_phase<pg8::EpiStoreBf16, pg8::StaticOrder, PG8_ALIGN, PG8_SP2>(lds, g, S, E);
            SEAM(pb + 3);
        }
#if SCAN_CHECK
        if (KIND_ON(5) && IN(pb + 4)) { PH_LOCALS
            rwkv_prep_b(PROJ, LR, args.in[I_MU] + l * SLAB_W, args.in[I_W0] + l * 1024, args.in[I_A0] + l * 1024, args.in[I_KK] + l * 1024, args.in[I_KA] + l * 1024, SCANIN + 96 * MiB, tid, G, T / 2);
            SEAM(pb + 4);
        }
#endif
        if (KIND_ON(6) && IN(pb + 5)) { PH_LOCALS const RwkvPar par{args.in[I_MU] + l * SLAB_W, args.in[I_W0] + l * 1024, args.in[I_A0] + l * 1024, args.in[I_KK] + l * 1024, args.in[I_KA] + l * 1024};
            REP(10) { scan_a_phase(PROJ, LR, par, SCANIN, ws + WS_CHK, lds, tid, lane, wave, G); } SEAM(pb + 5); }
        if (KIND_ON(7) && IN(pb + 6)) { PH_LOCALS
            REP(11) { scan_b_phase(ws + WS_CHK, YS, lds, tid, lane, wave, G); }
#if SCAN_CHECK
            if (l == 0) scan_phase(SCANIN + 96 * MiB, args.out, lds, tid, lane, wave, G, 64);
#endif
            attn_phase(PROJ, IDX, args.in[I_RELB], ATT, lds, tid, lane, wave, G, ctl + CW_ATTQ + 2048 * l); __syncthreads();
#if (PROBE_REPEAT >> 5) & 1
            attn_phase(PROJ, IDX, args.in[I_RELB], ATT, lds, tid, lane, wave, G, ctl + CW_ATTQ + 2048 * l + 1024); __syncthreads();
#endif
#if ATT_CHECK
            if (l == 0) { attn_phase_ref(PROJ, IDX, args.in[I_RELB], (bf16*)args.out, lds, tid, lane, wave, G); __syncthreads(); }
#endif
            SEAM(pb + 6);
        }
        if (KIND_ON(8) && IN(pb + 7)) { PH_LOCALS
#if ATT_CHECK
            if (l == 0) { float e2 = 0.f, r2 = 0.f; const bf16* ar = (const bf16*)args.out; for (size_t i = (size_t)blockIdx.x * 512 + tid; i < (size_t)T * 1024; i += (size_t)G * 512) { const float a = bf2f(ATT[i]), b = bf2f(ar[i]), d = a - b; e2 += d * d; r2 += b * b; }
                e2 = wave_sum(e2); r2 = wave_sum(r2); if (lane == 0) { atomicAdd((float*)(ctl + 32), e2); atomicAdd((float*)(ctl + 33), r2); } }
#endif
#if SCAN_CHECK
            if (l == 0) { float e2 = 0.f, r2 = 0.f; for (size_t i = (size_t)blockIdx.x * 512 + tid; i < (size_t)(T / 2) * 1024; i += (size_t)G * 512) { const float a = YS[i], b = args.out[i], d = a - b; e2 += d * d; r2 += b * b; }
                e2 = wave_sum(e2); r2 = wave_sum(r2); if (lane == 0) { atomicAdd((float*)(ctl + 32), e2); atomicAdd((float*)(ctl + 33), r2); } }
#endif
            REP(12) rwkv_post<384>(YS, SCANIN, LR, args.in[I_RK] + l * 1024, args.in[I_GNW] + l * 1024, args.in[I_GNB] + l * 1024, RW, tid, G); }
        if (KIND_ON(9) && IN(pb + 7)) { PH_LOCALS
            pg8::Gemm g{ATT, (const bf16*)(ws + WS_UATT) + (size_t)l * D * 1024, T, D, 512}; pg8::StaticOrder S; S.init(T, D, G, (int)blockIdx.x);
            pg8::EpiGate<false> E{M1, D, PROJ + O_GA, D, nullptr, 1.0f, 1.0f / (MOE_AS * PLE_WS)};
            pg8::gemm_phase<pg8::EpiGate<false>, pg8::StaticOrder, PG8_ALIGN, PG8_SP2, true>(lds, g, S, E);
            SEAM(pb + 7);
        }
        if (KIND_ON(10) && IN(pb + 9)) { PH_LOCALS
            pg8::Gemm g{RW, (const bf16*)(ws + WS_URW) + (size_t)l * D * 1024, T, D, 512}; pg8::StaticOrder S; S.init(T, D, G, (int)blockIdx.x);
            pg8::EpiGate<true> E{M1, D, PROJ + O_GB, D, (unsigned char*)XN, MOE_AS, 1.0f / (MOE_AS * PLE_WS)};
            pg8::gemm_phase<pg8::EpiGate<true>, pg8::StaticOrder, PG8_ALIGN, PG8_SP2, true>(lds, g, S, E);
            SEAM(pb + 9);
        }
        if (KIND_ON(11) && IN(pb + 10)) { PH_LOCALS
            pg8::Gemm g{XN, (const bf16*)(ws + WS_WOUT) + (size_t)l * D * D, T, D, D / 2}; pg8::StaticOrder S; S.init(T, D, G, (int)blockIdx.x);
            pg8::EpiResid E{hin, H, D, 1.0f / (MOE_AS * PLE_WS)};
            pg8::gemm_phase<pg8::EpiResid, pg8::StaticOrder, PG8_ALIGN, PG8_SP2, true>(lds, g, S, E);
            SEAM(pb + 10);
        }
        if (KIND_ON(12) && IN(pb + 11)) { PH_LOCALS
            if (l & 1) norm_phase<1, true>(H, nullptr, args.in[I_NFFN] + l * D, XN, args.in[I_ROUT] + (size_t)(l >> 1) * D * NE, ctl, ROUTE, nullptr, nullptr, lane, wave, G);
            else norm_phase<0>(H, nullptr, args.in[I_NFFN] + l * D, XN, nullptr, nullptr, nullptr, nullptr, nullptr, lane, wave, G);
            SEAM(pb + 11);
        }
        if (l & 1) {
            if (KIND_ON(13) && IN(pb + 12)) { PH_LOCALS moe_table(ctl, tab, 2 * DFE / 256, tid); moe_gather((const unsigned char*)XN, (unsigned char*)XG, ROUTE, tab, lane, wave, G); SEAM(pb + 12); }
            if (KIND_ON(14) && IN(pb + 13)) { PH_LOCALS
                moe_table(ctl, tab, 2 * DFE / 256, tid);
                pg8::Gemm g{XG, (const bf16*)(ws + WS_M13), MOE_ROWS, 2 * DFE, D / 2, XGP / 2, XGP / 2}; pg8::MoeOrder S{tab, 2 * DFE / 256, G, (int)blockIdx.x};
                pg8::EpiSwigluF8 E{(unsigned char*)UM, DFE, 1.0f / (MOE_AS * MOE_WS13), MOE_AS};
                REP(21) { pg8::gemm_phase<pg8::EpiSwigluF8, pg8::MoeOrder, PG8_ALIGN, PG8_SP2, true>(lds, g, S, E); }
                SEAM(pb + 13);
            }
            if (KIND_ON(15) && IN(pb + 14)) { PH_LOCALS
                moe_table(ctl, tab, D / 256, tid);
                pg8::Gemm g{UM, (const bf16*)(ws + WS_M2), MOE_ROWS, D, DFE / 2}; pg8::MoeOrder S{tab, D / 256, G, (int)blockIdx.x};
                pg8::EpiStoreBf16 E{YM, D, 1.0f / (MOE_AS * MOE_WS2)};
                REP(22) { pg8::gemm_phase<pg8::EpiStoreBf16, pg8::MoeOrder, PG8_ALIGN, PG8_SP2, true>(lds, g, S, E); }
                SEAM(pb + 14);
            }
            if (KIND_ON(16) && IN(pb + 15)) { PH_LOCALS moe_table(ctl, tab, D / 256, tid); if (l == DEPTH - 1) norm_phase<2, true>(H, H, args.in[I_NPLE] + l * D, XN, nullptr, nullptr, ROUTE, YM, tab, lane, wave, G); else norm_phase<2>(H, H, args.in[I_NPLE] + l * D, XN, nullptr, nullptr, ROUTE, YM, tab, lane, wave, G); }
        } else {
            if (KIND_ON(14) && IN(pb + 13)) { PH_LOCALS
                pg8::Gemm g{XN, (const bf16*)(ws + WS_F13), T, 2 * DFF, D}; pg8::StaticOrder S; S.init(T, 2 * DFF, G, (int)blockIdx.x);
                pg8::EpiSwigluF8 E{(unsigned char*)UD, DFF, 1.0f, MOE_AS};
                REP(24) { pg8::gemm_phase<pg8::EpiSwigluF8, pg8::StaticOrder, PG8_ALIGN, PG8_SP2>(lds, g, S, E); }
                SEAM(pb + 13);
            }
            if (KIND_ON(15) && IN(pb + 14)) { PH_LOCALS
                pg8::Gemm g{UD, (const bf16*)(ws + WS_F2), T, D, DFF / 2}; pg8::StaticOrder S; S.init(T, D, G, (int)blockIdx.x);
                pg8::EpiResid E{H, H, D, 1.0f / (MOE_AS * MOE_WS2)};
                pg8::gemm_phase<pg8::EpiResid, pg8::StaticOrder, PG8_ALIGN, PG8_SP2, true>(lds, g, S, E);
                SEAM(pb + 14);
            }
            if (KIND_ON(16) && IN(pb + 15)) { PH_LOCALS norm_phase<0>(H, nullptr, args.in[I_NPLE] + l * D, XN, nullptr, nullptr, nullptr, nullptr, nullptr, lane, wave, G); }
        }
        if (KIND_ON(17) && IN(pb + 15)) { PH_LOCALS
            SEAM(pb + 15);
        }
        if (KIND_ON(18) && IN(pb + 17)) { PH_LOCALS
            pg8::StaticOrder S; S.init(T, D, G, (int)blockIdx.x);
            if (l == DEPTH - 1 && (l & 1)) {
                pg8::Gemm g{XN, (const bf16*)(ws + WS_PLEG) + (size_t)l * D * D, T, D, D / 2};
                pg8::EpiPle E{H, PP, D, 1.0f / (PLE_AS * PLE_WS)};
                pg8::gemm_phase<pg8::EpiPle, pg8::StaticOrder, PG8_ALIGN, PG8_SP2, true>(lds, g, S, E);
            } else {
                pg8::Gemm g{XN, (const bf16*)(ws + WS_PLEG) + (size_t)l * D * D, T, D, D};
                pg8::EpiPle E{H, PP, D};
                pg8::gemm_phase<pg8::EpiPle, pg8::StaticOrder, PG8_ALIGN, PG8_SP2>(lds, g, S, E);
            }
            SEAM(pb + 17);
        }
    }
    if (KIND_ON(19) && IN(PH_FINAL)) { PH_LOCALS norm_phase<3>(H, H, args.in[I_FIN], nullptr, nullptr, nullptr, nullptr, nullptr, nullptr, lane, wave, G);
#if SEL_CHECK
        __syncthreads(); if (blockIdx.x == 0 && tid == 0) { const unsigned nb = ((volatile unsigned*)ctl)[34], nr = ((volatile unsigned*)ctl)[35]; if (nb != 0u || nr != 2u * (unsigned)(T - 2 * NSEL) || ((volatile unsigned*)ctl)[36] > 2000u) H[12345] = __builtin_nanf(""); }
#endif
#if SCAN_CHECK || ATT_CHECK
        __syncthreads(); if (blockIdx.x == 0 && tid == 0) { const float e2 = ((volatile float*)(ctl + 32))[0], r2 = ((volatile float*)(ctl + 33))[0]; if (!(e2 <= SCAN_CHECK_TOL * r2) || !(r2 > 0.f)) H[12345] = __builtin_nanf(""); }
#endif
    }
#undef IN
#undef SEAM
}

extern "C" void kernel_launch(void* const* d_in, const int* in_sizes, int n_in, void* d_out, int out_size, void* d_ws, size_t ws_size, hipStream_t stream) {
    static int grid = 0;
    if (grid == 0) {
        if (n_in != 31 || out_size != T * D || ws_size < WS_END) { fprintf(stderr, "kernel_launch: unexpected problem: n_in %d out %d ws %zu (need %zu)\n", n_in, out_size, ws_size, (size_t)WS_END); grid = -1; return; }
        int dev = 0, cus = 0, per_cu = 0;
        if (hipGetDevice(&dev) != hipSuccess || hipDeviceGetAttribute(&cus, hipDeviceAttributeMultiprocessorCount, dev) != hipSuccess) { grid = -1; return; }
        if (hipFuncSetAttribute((const void*)trunk_fwd, hipFuncAttributeMaxDynamicSharedMemorySize, LDS_BYTES) != hipSuccess) { fprintf(stderr, "kernel_launch: hipFuncSetAttribute failed\n"); grid = -1; return; }
        if (hipOccupancyMaxActiveBlocksPerMultiprocessor(&per_cu, (const void*)trunk_fwd, 512, LDS_BYTES) != hipSuccess || per_cu < 1) { fprintf(stderr, "kernel_launch: occupancy query says %d\n", per_cu); }
        (void)hipGetLastError();
        grid = cus;
    }
    if (grid < 0) return;
    (void)hipMemsetAsync((char*)d_ws + WS_CTL, 0, CTL_ZERO_BYTES, stream);
    Args a{};
    for (int i = 0; i < 31; ++i) a.in[i] = (const float*)d_in[i];
    a.out = (float*)d_out; a.ws = (unsigned char*)d_ws;
#if MK_ONE_LAUNCH
    a.ph_lo = 0; a.ph_hi = NPH;
    hipLaunchKernelGGL(trunk_fwd, dim3(grid), dim3(512), LDS_BYTES, stream, a);
#else
    for (int ph = 0; ph < NPH; ++ph) {
        if (ph >= 1 && ph < PH_FINAL && ((ph - 1) % NPL) == 12 && (((ph - 1) / NPL) & 1) == 0) continue;
        a.ph_lo = ph; a.ph_hi = ph + 1;
        hipLaunchKernelGGL(trunk_fwd, dim3(grid), dim3(512), LDS_BYTES, stream, a);
    }
#endif
}
```
